# Optimizing an MI355X kernel written in HIP

```python
import numpy as np
import jax
import jax.numpy as jnp
from jax import lax

D_MODEL = 1024
BATCH = 2
SEQ = 8192
DEPTH = 1

NSA_HEADS = 8
NSA_KV_GROUPS = 2
NSA_HPG = NSA_HEADS // NSA_KV_GROUPS
NSA_HEAD_DIM = 64
N_NSA_BRANCH = 3
CMP_LEN = 32
CMP_STRIDE = 16
CMP_HIDDEN = 128
SLC_LEN = 64
SLC_TOPK = 16
WINDOW = 512
Q_BLOCK = 128
FORCE_SCORE = 1.0e4

GLA_HEADS = 4
GLA_DK = 64
GLA_DV = 128
GLA_GATE_RANK = 16
GLA_GATE_TAU = 16.0
GLA_CHUNK = 64

ROPE_THETA = 500000.0
ROPE_DIM = NSA_HEAD_DIM // 4

D_FF = (8 * D_MODEL + 3 * 256 - 1) // (3 * 256) * 256

EPS = 1e-6
NEG_INF = -1e30

NSA_Q_COLS = NSA_HEADS * NSA_HEAD_DIM
NSA_KV_COLS = N_NSA_BRANCH * 2 * NSA_KV_GROUPS * NSA_HEAD_DIM
NSA_GATE_COLS = NSA_HEADS * N_NSA_BRANCH
GLA_QK_COLS = GLA_HEADS * GLA_DK
GLA_V_COLS = GLA_HEADS * GLA_DV
MERGE_COLS = 2 * D_MODEL
IN_COLS = NSA_Q_COLS + NSA_KV_COLS + NSA_GATE_COLS + 2 * GLA_QK_COLS + 2 * GLA_V_COLS + GLA_GATE_RANK + MERGE_COLS

kernel_name = 'hybrid_nsa_gla_gated_merge_block'


def rmsnorm(x, gain):
    xf = x.astype(jnp.float32)
    y = xf * lax.rsqrt(jnp.mean(xf * xf, axis=-1, keepdims=True) + EPS)
    return (y * gain.astype(jnp.float32)).astype(x.dtype)


def partial_rope(x, pos):
    half = ROPE_DIM // 2
    inv_freq = ROPE_THETA ** (-jnp.arange(half, dtype=jnp.float32) / half)
    ang = pos.astype(jnp.float32)[:, None] * inv_freq[None, :]
    cos = jnp.cos(ang).astype(x.dtype)
    sin = jnp.sin(ang).astype(x.dtype)
    x1 = x[..., :half]
    x2 = x[..., half:ROPE_DIM]
    return jnp.concatenate([x1 * cos - x2 * sin, x2 * cos + x1 * sin, x[..., ROPE_DIM:]], axis=-1)


def masked_softmax(scores, mask):
    p = jax.nn.softmax(jnp.where(mask, scores, NEG_INF), axis=-1)
    return p * mask


def compress_blocks(kv, pe, w1, w2):
    b, g, t, d = kv.shape
    ratio = CMP_LEN // CMP_STRIDE
    n_sub = t // CMP_STRIDE
    n_cmp = n_sub - ratio + 1
    sub = kv.reshape(b, g, n_sub, CMP_STRIDE, d)
    blocks = jnp.concatenate([sub[:, :, r:r + n_cmp] for r in range(ratio)], axis=3)
    blocks = (blocks + pe).reshape(b, g, n_cmp, CMP_LEN * d)
    return jax.nn.silu(blocks @ w1) @ w2


def selection_overlap(n_cmp, n_slc):
    c_start = np.arange(n_cmp)[:, None] * CMP_STRIDE
    s_start = np.arange(n_slc)[None, :] * SLC_LEN
    ov = (c_start < s_start + SLC_LEN) & (c_start + CMP_LEN > s_start)
    return jnp.asarray(ov, dtype=jnp.float32)


def nsa_attention(q, k_cmp, v_cmp, k_slc, v_slc, k_win, v_win, gates):
    b, g, hg, t_len, d = q.shape
    pos = jnp.arange(t_len)
    scale = NSA_HEAD_DIM ** -0.5
    q_rot = partial_rope(q, pos)
    k_slc = partial_rope(k_slc, pos)
    k_win = partial_rope(k_win, pos)
    n_cmp = k_cmp.shape[2]
    cmp_end = jnp.arange(n_cmp) * CMP_STRIDE + CMP_LEN - 1
    n_slc = t_len // SLC_LEN
    topk = min(SLC_TOPK, n_slc)
    overlap = selection_overlap(n_cmp, n_slc)
    kb = k_slc.reshape(b, g, n_slc, SLC_LEN, d)
    vb = v_slc.reshape(b, g, n_slc, SLC_LEN, d)
    kw = jnp.pad(k_win, ((0, 0), (0, 0), (WINDOW, 0), (0, 0)))
    vw = jnp.pad(v_win, ((0, 0), (0, 0), (WINDOW, 0), (0, 0)))
    bi = jnp.arange(b)[:, None, None, None]
    gi = jnp.arange(g)[None, :, None, None]
    blk_ids = jnp.arange(n_slc)

    def query_block(i):
        s = i * Q_BLOCK
        t = s + jnp.arange(Q_BLOCK)
        q_raw = lax.dynamic_slice_in_dim(q, s, Q_BLOCK, axis=3) * scale
        q_pos = lax.dynamic_slice_in_dim(q_rot, s, Q_BLOCK, axis=3) * scale
        sc = jnp.einsum('bghqd,bgnd->bghqn', q_raw, k_cmp, preferred_element_type=jnp.float32)
        p_c = masked_softmax(sc, cmp_end[None, :] <= t[:, None])
        o_c = jnp.einsum('bghqn,bgnd->bghqd', p_c.astype(v_cmp.dtype), v_cmp)
        imp = jnp.einsum('bgqn,nj->bgqj', p_c.sum(axis=2), overlap)
        cur = t[:, None] // SLC_LEN
        valid = blk_ids[None, :] * SLC_LEN <= t[:, None]
        forced = (blk_ids[None, :] == 0) | (blk_ids[None, :] == cur) | (blk_ids[None, :] == cur - 1)
        score = jnp.where(valid, jnp.where(forced, FORCE_SCORE, imp), -jnp.inf)
        top_v, idx = lax.top_k(score, topk)
        ks = kb[bi, gi, idx]
        vs = vb[bi, gi, idx].reshape(b, g, Q_BLOCK, topk * SLC_LEN, d)
        ss = jnp.einsum('bghqd,bgqnld->bghqnl', q_pos, ks, preferred_element_type=jnp.float32)
        ss = ss.reshape(b, g, hg, Q_BLOCK, topk * SLC_LEN)
        tok = idx[..., None] * SLC_LEN + jnp.arange(SLC_LEN)
        m_s = (jnp.isfinite(top_v)[..., None] & (tok <= t[None, None, :, None, None]))
        m_s = m_s.reshape(b, g, 1, Q_BLOCK, topk * SLC_LEN)
        p_s = masked_softmax(ss, m_s)
        o_s = jnp.einsum('bghqm,bgqmd->bghqd', p_s.astype(vs.dtype), vs)
        kwin = lax.dynamic_slice_in_dim(kw, s, WINDOW + Q_BLOCK, axis=2)
        vwin = lax.dynamic_slice_in_dim(vw, s, WINDOW + Q_BLOCK, axis=2)
        kpos = s - WINDOW + jnp.arange(WINDOW + Q_BLOCK)
        dist = t[:, None] - kpos[None, :]
        m_w = (kpos[None, :] >= 0) & (dist >= 0) & (dist < WINDOW)
        sw = jnp.einsum('bghqd,bgkd->bghqk', q_pos, kwin, preferred_element_type=jnp.float32)
        p_w = masked_softmax(sw, m_w)
        o_w = jnp.einsum('bghqk,bgkd->bghqd', p_w.astype(vwin.dtype), vwin)
        gt = lax.dynamic_slice_in_dim(gates, s, Q_BLOCK, axis=3)
        return gt[..., 0:1] * o_c + gt[..., 1:2] * o_s + gt[..., 2:3] * o_w

    out = lax.map(query_block, jnp.arange(t_len // Q_BLOCK))
    return out.transpose(1, 0, 4, 2, 3, 5).reshape(b, t_len, g * hg * d)


def gla_chunked(q, k, v, log_a):
    b, h, t_len, dk = q.shape
    dv = v.shape[-1]
    n_chunk = t_len // GLA_CHUNK

    def to_chunks(a):
        return jnp.moveaxis(a.astype(jnp.float32).reshape(b, h, n_chunk, GLA_CHUNK, a.shape[-1]), 2, 0)

    causal = jnp.tril(jnp.ones((GLA_CHUNK, GLA_CHUNK), dtype=bool))

    def step(state, inp):
        qc, kc, vc, gc = inp
        cum = jnp.cumsum(gc, axis=2)
        last = cum[:, :, -1:, :]
        inter = jnp.einsum('bhtd,bhdv->bhtv', qc * jnp.exp(cum), state)
        diff = jnp.where(causal[:, :, None], cum[:, :, :, None, :] - cum[:, :, None, :, :], -jnp.inf)
        attn = jnp.einsum('bhtd,bhsd,bhtsd->bhts', qc, kc, jnp.exp(diff))
        out = inter + jnp.einsum('bhts,bhsv->bhtv', attn, vc)
        state = jnp.exp(last)[:, :, 0, :, None] * state + jnp.einsum('bhsd,bhsv->bhdv', kc * jnp.exp(last - cum), vc)
        return state, out

    s0 = jnp.zeros((b, h, dk, dv), jnp.float32)
    _, o = lax.scan(step, s0, (to_chunks(q), to_chunks(k), to_chunks(v), to_chunks(log_a)))
    return jnp.moveaxis(o, 0, 2).reshape(b, h, t_len, dv)


def split_in_proj(proj):
    widths = [NSA_Q_COLS, NSA_KV_COLS, NSA_GATE_COLS, GLA_QK_COLS, GLA_QK_COLS, GLA_V_COLS,
              GLA_GATE_RANK, GLA_V_COLS, MERGE_COLS]
    cuts = [int(c) for c in np.cumsum(widths)[:-1]]
    return jnp.split(proj, cuts, axis=-1)


def setup_inputs(seed: int = 0) -> dict:
    key = jax.random.key(seed)
    ks = jax.random.split(key, 20)
    L = DEPTH

    def nrm(k, shape, scale):
        return jax.random.normal(k, shape, jnp.float32) * scale

    flat_blk = CMP_LEN * NSA_HEAD_DIM
    return {
        'x': nrm(ks[0], (BATCH, SEQ, D_MODEL), 1.0),
        'norm_mix': 1.0 + nrm(ks[1], (L, D_MODEL), 0.02),
        'w_in': nrm(ks[2], (L, D_MODEL, IN_COLS), D_MODEL ** -0.5),
        'cmp_pe_k': nrm(ks[3], (L, CMP_LEN, NSA_HEAD_DIM), 0.1),
        'cmp_pe_v': nrm(ks[4], (L, CMP_LEN, NSA_HEAD_DIM), 0.1),
        'cmp_k_w1': nrm(ks[5], (L, flat_blk, CMP_HIDDEN), flat_blk ** -0.5),
        'cmp_k_w2': nrm(ks[6], (L, CMP_HIDDEN, NSA_HEAD_DIM), CMP_HIDDEN ** -0.5),
        'cmp_v_w1': nrm(ks[7], (L, flat_blk, CMP_HIDDEN), flat_blk ** -0.5),
        'cmp_v_w2': nrm(ks[8], (L, CMP_HIDDEN, NSA_HEAD_DIM), CMP_HIDDEN ** -0.5),
        'gla_gate_w2': nrm(ks[9], (L, GLA_GATE_RANK, GLA_QK_COLS), GLA_GATE_RANK ** -0.5),
        'gla_gate_b': nrm(ks[10], (L, GLA_QK_COLS), 0.1),
        'gla_norm': 1.0 + nrm(ks[11], (L, GLA_DV), 0.02),
        'w_up_nsa': nrm(ks[12], (L, NSA_Q_COLS, D_MODEL), NSA_Q_COLS ** -0.5),
        'w_up_gla': nrm(ks[13], (L, GLA_V_COLS, D_MODEL), GLA_V_COLS ** -0.5),
        'w_out': nrm(ks[14], (L, D_MODEL, D_MODEL), D_MODEL ** -0.5),
        'norm_ffn': 1.0 + nrm(ks[15], (L, D_MODEL), 0.02),
        'w_ffn_gate': nrm(ks[16], (L, D_MODEL, D_FF), D_MODEL ** -0.5),
        'w_ffn_up': nrm(ks[17], (L, D_MODEL, D_FF), D_MODEL ** -0.5),
        'w_ffn_down': nrm(ks[18], (L, D_FF, D_MODEL), D_FF ** -0.5),
        'norm_final': 1.0 + nrm(ks[19], (D_MODEL,), 0.02),
    }


def reference(x, norm_mix, w_in, cmp_pe_k, cmp_pe_v, cmp_k_w1, cmp_k_w2, cmp_v_w1, cmp_v_w2,
              gla_gate_w2, gla_gate_b, gla_norm, w_up_nsa, w_up_gla, w_out, norm_ffn,
              w_ffn_gate, w_ffn_up, w_ffn_down, norm_final):
    b, t_len, _ = x.shape
    for layer in range(DEPTH):
        h = rmsnorm(x, norm_mix[layer])
        proj = h @ w_in[layer]
        q_nsa, kv_nsa, g_nsa, q_gla, k_gla, v_gla, lr_gla, r_gla, g_merge = split_in_proj(proj)
        q_a = q_nsa.reshape(b, t_len, NSA_KV_GROUPS, NSA_HPG, NSA_HEAD_DIM).transpose(0, 2, 3, 1, 4)
        kv = kv_nsa.reshape(b, t_len, 2 * N_NSA_BRANCH, NSA_KV_GROUPS, NSA_HEAD_DIM).transpose(2, 0, 3, 1, 4)
        k_cmp = compress_blocks(kv[0], cmp_pe_k[layer], cmp_k_w1[layer], cmp_k_w2[layer])
        v_cmp = compress_blocks(kv[1], cmp_pe_v[layer], cmp_v_w1[layer], cmp_v_w2[layer])
        gates_a = jax.nn.sigmoid(g_nsa).reshape(b, t_len, NSA_KV_GROUPS, NSA_HPG, N_NSA_BRANCH).transpose(0, 2, 3, 1, 4)
        o_a = nsa_attention(q_a, k_cmp, v_cmp, kv[2], kv[3], kv[4], kv[5], gates_a)
        log_a = jax.nn.log_sigmoid((lr_gla @ gla_gate_w2[layer] + gla_gate_b[layer]).astype(jnp.float32)) / GLA_GATE_TAU
        heads = lambda a, dh: a.reshape(b, t_len, GLA_HEADS, dh).transpose(0, 2, 1, 3)
        o_b = gla_chunked(heads(q_gla * GLA_DK ** -0.5, GLA_DK), heads(k_gla, GLA_DK),
                          heads(v_gla, GLA_DV), heads(log_a, GLA_DK))
        o_b = rmsnorm(o_b.transpose(0, 2, 1, 3).astype(x.dtype), gla_norm[layer])
        o_b = (o_b * jax.nn.silu(r_gla.reshape(b, t_len, GLA_HEADS, GLA_DV))).reshape(b, t_len, GLA_V_COLS)
        gate_a, gate_b = jnp.split(jax.nn.sigmoid(g_merge), 2, axis=-1)
        merged = gate_a * (o_a @ w_up_nsa[layer]) + gate_b * (o_b @ w_up_gla[layer])
        x = x + merged @ w_out[layer]
        h = rmsnorm(x, norm_ffn[layer])
        x = x + (jax.nn.silu(h @ w_ffn_gate[layer]) * (h @ w_ffn_up[layer])) @ w_ffn_down[layer]
    return rmsnorm(x, norm_final)
```

```cpp
#include <hip/hip_runtime.h>
#include <hip/hip_cooperative_groups.h>
#include <cstdio>
#include <cstdint>
namespace cg = cooperative_groups;
namespace pg8 {
#define PG8_LAS __attribute__((address_space(3)))
typedef unsigned short bf16_t;
typedef short bf16x8 __attribute__((ext_vector_type(8)));
typedef float f32x4 __attribute__((ext_vector_type(4)));
typedef unsigned u32x4 __attribute__((ext_vector_type(4)));
constexpr int BM = 256, BK = 64, HALF = 128, HTB = HALF * BK * 2  , STAGE_BYTES = 8 * HTB, NXCD = 8, WGM = 8;

__host__ __device__ __forceinline__ int lds_byte(int r, int c) { const int st = (r >> 4) * 2 + (c >> 5), rr = r & 15, cc = c & 31, ob = rr * 64 + cc * 2; return st * 1024 + (ob ^ (((ob >> 9) & 1) << 5)); }
__host__ __device__ __forceinline__ void stage_rc(int b, int& R, int& C) { const int st = b / 1024, sb = b % 1024, swz = sb ^ (((sb >> 9) & 1) << 5); R = (st >> 1) * 16 + swz / 64; C = (st & 1) * 32 + (swz % 64) / 2; }
__host__ __device__ __forceinline__ int perm32(int rho) { const int n = rho >> 4, i = rho & 15; return 8 * (i >> 2) + 4 * n + (i & 3); }

struct Unit { int pm, pn; };
struct Gemm { const bf16_t* A; const bf16_t* Bt; int M, N, K, lda; };

struct StaticOrder {
    int nM, nN, nwg, G, c;
    __host__ __device__ void init(int M, int N, int G_, int c_) { nM = M / BM; nN = N / BM; nwg = nM * nN; G = G_; c = c_; }
    __host__ __device__ bool next(int i, Unit& u) const {
        const long L = (long)i * G + c; if (L >= nwg) return false;
        int wgid = (int)L; { const int q = nwg / NXCD, r = nwg % NXCD, xcd = wgid % NXCD, off = wgid / NXCD; wgid = (xcd < r ? xcd * (q + 1) : r * (q + 1) + (xcd - r) * q) + off; }
        const int nig = WGM * nN, gid = wgid / nig, fm = gid * WGM, gsz = (nM - fm) < WGM ? (nM - fm) : WGM;
        u.pm = fm + ((wgid % nig) % gsz); u.pn = (wgid % nig) / gsz; return true;
    }
    __device__ __forceinline__ void a_ready(const Unit&) const {}
    __device__ __forceinline__ void done(const Unit&) const {}
};

__device__ __forceinline__ unsigned cvt_pk_bf16(float lo, float hi) { unsigned r; asm volatile("v_cvt_pk_bf16_f32 %0, %1, %2" : "=v"(r) : "v"(lo), "v"(hi)); return r; }
template <class Epi, class Sched, bool ALIGN_EPI = false, bool SP2 = false>
__device__ __forceinline__ void gemm_phase(PG8_LAS unsigned char* lds, const Gemm g, const Sched& S, const Epi& E) {
    int tid_ = threadIdx.x; asm volatile("" : "+v"(tid_));
    const int tid = tid_, wid = __builtin_amdgcn_readfirstlane(tid >> 6), lane = tid & 63, wr = wid >> 2, wc = wid & 3, fr = lane & 15, fq = lane >> 4;
    const int K = g.K, nt = K / BK;
    unsigned voffA[2], voffB[2];
#pragma unroll
    for (int i = 0; i < 2; ++i) { int R, C; stage_rc(tid * 16 + i * 8192, R, C); const int Rb = Epi::PERM ? ((R & ~31) + perm32(R & 31)) : R;
        voffA[i] = (unsigned)(R * g.lda + C) * 2u; voffB[i] = (unsigned)(Rb * K + C) * 2u; }
    const size_t kstep = (size_t)(BK * 2);
    const size_t hstep = (size_t)HALF * K * 2;
    const size_t tstep = 2 * hstep; const size_t hstepA = (size_t)HALF * g.lda * 2, tstepA = 2 * hstepA;
    const unsigned ldsw = (unsigned)wid * 1024u;
    const int aoff = lds_byte(wr * 64 + fr, fq * 8), boff = lds_byte(wc * 32 + fr, fq * 8);
#define PG8_SA(b, h) (((b) * 2 + (h)) * HTB)
#define PG8_SB(b, h) ((4 + (b) * 2 + (h)) * HTB)
#define PG8_STAGE(bufoff, gbase, voff) do { _Pragma("unroll") for (int _i = 0; _i < 2; ++_i) \
        __builtin_amdgcn_global_load_lds((const unsigned*)((const char*)(gbase) + (voff)[_i]), (PG8_LAS unsigned*)(lds + (bufoff) + ldsw + _i * 8192), 16, 0, 0); } while (0)
#define PG8_LDA(dst, b, h) do { _Pragma("unroll") for (int m = 0; m < 4; ++m) _Pragma("unroll") for (int k = 0; k < 2; ++k) dst[m][k] = *(const PG8_LAS bf16x8*)(lds + PG8_SA(b, h) + aoff + m * 2048 + k * 1024); } while (0)
#define PG8_LDB(dst, b, h) do { _Pragma("unroll") for (int n = 0; n < 2; ++n) _Pragma("unroll") for (int k = 0; k < 2; ++k) dst[n][k] = *(const PG8_LAS bf16x8*)(lds + PG8_SB(b, h) + boff + n * 2048 + k * 1024); } while (0)
#define PG8_MMA(ai, bj, At, Bt) do { __builtin_amdgcn_s_setprio(1); _Pragma("unroll") for (int m = 0; m < 4; ++m) _Pragma("unroll") for (int n = 0; n < 2; ++n) _Pragma("unroll") for (int k = 0; k < 2; ++k) \
        acc[ai][bj][m][n] = __builtin_amdgcn_mfma_f32_16x16x32_bf16(Bt[n][k], At[m][k], acc[ai][bj][m][n], 0, 0, 0); __builtin_amdgcn_s_setprio(0); } while (0)
#define PG8_WAIT_V(n) asm volatile("s_waitcnt vmcnt(" #n ")" ::: "memory")
#define PG8_WAIT_L(n) asm volatile("s_waitcnt lgkmcnt(" #n ")" ::: "memory")
#define PG8_BAR __builtin_amdgcn_s_barrier()
#define PG8_SCHED __builtin_amdgcn_sched_barrier(0)
    Unit cur, nxt; int ui = 0;
    if (!S.next(0, cur)) return;
    f32x4 acc[2][2][4][2];
#pragma unroll
    for (int a = 0; a < 2; ++a)
#pragma unroll
        for (int b = 0; b < 2; ++b)
#pragma unroll
            for (int m = 0; m < 4; ++m)
#pragma unroll
                for (int n = 0; n < 2; ++n) acc[a][b][m][n] = (f32x4){0.f, 0.f, 0.f, 0.f};
    bf16x8 At[4][2], B0[2][2], B1[2][2];
    const char* cA = (const char*)g.A + (size_t)cur.pm * tstepA; const char* cB = (const char*)g.Bt + (size_t)cur.pn * tstep;
    S.a_ready(cur);
    if constexpr (SP2) {
        PG8_STAGE(PG8_SB(0, 0), cB, voffB); PG8_STAGE(PG8_SB(0, 1), cB + hstep, voffB); PG8_STAGE(PG8_SA(0, 0), cA, voffA); PG8_STAGE(PG8_SA(0, 1), cA + hstepA, voffA);
        if (wr == 1) PG8_BAR;
        PG8_WAIT_V(2); PG8_BAR;
        PG8_STAGE(PG8_SB(1, 0), cB + kstep, voffB); PG8_STAGE(PG8_SA(1, 0), cA + kstep, voffA); PG8_STAGE(PG8_SB(1, 1), cB + hstep + kstep, voffB);
        PG8_WAIT_V(6); PG8_BAR;
    } else {
        PG8_STAGE(PG8_SB(0, 0), cB, voffB); PG8_STAGE(PG8_SA(0, 0), cA, voffA); PG8_STAGE(PG8_SB(0, 1), cB + hstep, voffB); PG8_STAGE(PG8_SA(0, 1), cA + hstepA, voffA);
        if (wr == 1) PG8_BAR;
        PG8_WAIT_V(4); PG8_BAR;
        PG8_STAGE(PG8_SB(1, 0), cB + kstep, voffB); PG8_STAGE(PG8_SA(1, 0), cA + kstep, voffA); PG8_STAGE(PG8_SB(1, 1), cB + hstep + kstep, voffB);
        PG8_WAIT_V(6); PG8_BAR;
    }
    for (;;) {
        const bool has_next = S.next(ui + 1, nxt);
        const char* nA = has_next ? (const char*)g.A + (size_t)nxt.pm * tstepA : cA; const char* nB = has_next ? (const char*)g.Bt + (size_t)nxt.pn * tstep : cB;
        for (int t = 0; t < nt; t += 2) {
            const bool last = (t == nt - 2);
            const char* a1 = cA + (size_t)(t + 1) * kstep;
            const char* a2 = last ? nA : cA + (size_t)(t + 2) * kstep; const char* b2 = last ? nB : cB + (size_t)(t + 2) * kstep;
            const char* a3 = a2 + kstep; const char* b3 = b2 + kstep;
            if (last && has_next) S.a_ready(nxt);
            if constexpr (SP2) {
            PG8_LDB(B0, 0, 0); PG8_LDB(B1, 0, 1); PG8_SCHED; PG8_LDA(At, 0, 0); PG8_STAGE(PG8_SA(1, 1), a1 + hstepA, voffA);
            PG8_WAIT_V(8); PG8_WAIT_L(0); PG8_BAR; PG8_MMA(0, 0, At, B0); PG8_MMA(0, 1, At, B1); PG8_BAR; PG8_SCHED;
            PG8_LDA(At, 0, 1); PG8_STAGE(PG8_SB(0, 0), b2, voffB); PG8_STAGE(PG8_SB(0, 1), b2 + hstep, voffB); PG8_STAGE(PG8_SA(0, 0), a2, voffA);
            PG8_WAIT_V(8); PG8_WAIT_L(0); PG8_BAR; PG8_MMA(1, 0, At, B0); PG8_MMA(1, 1, At, B1); PG8_BAR; PG8_SCHED;
            PG8_LDB(B0, 1, 0); PG8_LDB(B1, 1, 1); PG8_SCHED; PG8_LDA(At, 1, 0); PG8_STAGE(PG8_SA(0, 1), a2 + hstepA, voffA);
            PG8_WAIT_V(8); PG8_WAIT_L(0); PG8_BAR; PG8_MMA(0, 0, At, B0); PG8_MMA(0, 1, At, B1); PG8_BAR; PG8_SCHED;
            PG8_LDA(At, 1, 1); PG8_STAGE(PG8_SB(1, 0), b3, voffB); PG8_STAGE(PG8_SB(1, 1), b3 + hstep, voffB); PG8_STAGE(PG8_SA(1, 0), a3, voffA);
            PG8_WAIT_V(8); PG8_WAIT_L(0); PG8_BAR; PG8_MMA(1, 0, At, B0); PG8_MMA(1, 1, At, B1); PG8_BAR; PG8_SCHED;
            } else {
            PG8_LDB(B0, 0, 0); PG8_SCHED; PG8_LDA(At, 0, 0); PG8_STAGE(PG8_SA(1, 1), a1 + hstepA, voffA);
            PG8_WAIT_L(8); PG8_BAR; PG8_WAIT_L(0); PG8_MMA(0, 0, At, B0); PG8_BAR; PG8_SCHED;
            PG8_LDB(B1, 0, 1); PG8_STAGE(PG8_SB(0, 0), b2, voffB);
            PG8_BAR; PG8_WAIT_L(0); PG8_MMA(0, 1, At, B1); PG8_BAR;
            PG8_LDA(At, 0, 1); PG8_STAGE(PG8_SA(0, 0), a2, voffA);
            PG8_BAR; PG8_WAIT_L(0); PG8_MMA(1, 0, At, B0); PG8_BAR; PG8_SCHED;
            PG8_STAGE(PG8_SB(0, 1), b2 + hstep, voffB);
            PG8_WAIT_V(6); PG8_BAR; PG8_MMA(1, 1, At, B1); PG8_BAR;
            PG8_LDB(B0, 1, 0); PG8_SCHED; PG8_LDA(At, 1, 0); PG8_STAGE(PG8_SA(0, 1), a2 + hstepA, voffA);
            PG8_WAIT_L(8); PG8_BAR; PG8_WAIT_L(0); PG8_MMA(0, 0, At, B0); PG8_BAR; PG8_SCHED;
            PG8_LDB(B1, 1, 1); PG8_STAGE(PG8_SB(1, 0), b3, voffB);
            PG8_BAR; PG8_WAIT_L(0); PG8_MMA(0, 1, At, B1); PG8_BAR;
            PG8_LDA(At, 1, 1); PG8_STAGE(PG8_SA(1, 0), a3, voffA);
            PG8_BAR; PG8_WAIT_L(0); PG8_MMA(1, 0, At, B0); PG8_BAR; PG8_SCHED;
            PG8_STAGE(PG8_SB(1, 1), b3 + hstep, voffB);
            PG8_WAIT_V(6); PG8_BAR; PG8_MMA(1, 1, At, B1); PG8_BAR;
            }
        }
        if constexpr (ALIGN_EPI) { if (wr == 0) PG8_BAR; }
        if constexpr (!Epi::AFTER_DRAIN) { E(acc, cur, wr, wc, fr, fq); S.done(cur); }
        if (!has_next) break;
#pragma unroll
        for (int a = 0; a < 2; ++a)
#pragma unroll
            for (int b = 0; b < 2; ++b)
#pragma unroll
                for (int m = 0; m < 4; ++m)
#pragma unroll
                    for (int n = 0; n < 2; ++n) acc[a][b][m][n] = (f32x4){0.f, 0.f, 0.f, 0.f};
        cur = nxt; cA = nA; cB = nB; ++ui;
        if constexpr (ALIGN_EPI) { if (wr == 1) PG8_BAR; }
    }
    PG8_WAIT_V(0);
    if constexpr (!ALIGN_EPI) { if (wr == 0) PG8_BAR; }
    PG8_BAR;
    if constexpr (Epi::AFTER_DRAIN) { E.fused(acc, cur, wr, wc, fr, fq, lds, wid, lane); S.done(cur); }
#undef PG8_SA
#undef PG8_SB
#undef PG8_STAGE
#undef PG8_LDA
#undef PG8_LDB
#undef PG8_MMA
#undef PG8_WAIT_V
#undef PG8_WAIT_L
#undef PG8_BAR
#undef PG8_SCHED
}
}

#define LAS __attribute__((address_space(3)))
typedef unsigned short bf16;
typedef short bf16x8 __attribute__((ext_vector_type(8)));
typedef float f32x4 __attribute__((ext_vector_type(4)));
typedef unsigned u32x4 __attribute__((ext_vector_type(4)));
typedef unsigned u32x2 __attribute__((ext_vector_type(2)));
constexpr int NWAVES = 8, NTHR = 512;
constexpr int BATCH = 2, T = 8192, D = 1024, M = BATCH * T, DFF = 2816;
constexpr int PLD = 4864;
constexpr int PC_QN = 0, PC_KV = 512, PC_QG = 1280, PC_KG = 1536, PC_VG = 1792, PC_RG = 2304, PC_GM = 2816;
constexpr int NIN = 5120, NGU = 5632;
constexpr float EPS = 1e-6f, NEGB = -1e30f;
constexpr size_t MiB = 1u << 20;
constexpr size_t WS_CTL = 0, CTL_BYTES = 1 * MiB;
constexpr size_t WS_WIN = 1 * MiB, WS_WGU = 11 * MiB, WS_WDN = 22 * MiB, WS_WOUT = 28 * MiB, WS_WUPA = 30 * MiB, WS_WUPB = 31 * MiB;
constexpr size_t WS_CW1K = 32 * MiB, WS_CW1V = 32 * MiB + 512 * 1024, WS_CW2K = 33 * MiB, WS_CW2V = 33 * MiB + 16384;
constexpr size_t WS_KCMP = 33 * MiB + 65536, WS_VCMPT = 33 * MiB + 65536 + 262144;
constexpr size_t WS_ROPE = 34 * MiB, WS_SMALL = 35 * MiB, WS_DEC = 39 * MiB, WS_RSQ1 = 39 * MiB + 262144, WS_RSQ2 = 39 * MiB + 524288;
constexpr size_t WS_XN = 40 * MiB, WS_XB = 40 * MiB;
constexpr size_t WS_PROJ = 72 * MiB, WS_H = 72 * MiB;
constexpr size_t WS_QROT = 224 * MiB, WS_CSRC = 228 * MiB, WS_KROT = 240 * MiB, WS_VTS = 248 * MiB, WS_VTW = 252 * MiB, WS_END = 256 * MiB;
constexpr size_t DO_L = 0, DO_S = 16 * MiB, DO_OA = 32 * MiB, DO_OB = 48 * MiB;
constexpr int LDS_BYTES = 147456;

__device__ __forceinline__ unsigned pk2(float lo, float hi) { return pg8::cvt_pk_bf16(lo, hi); }
__device__ __forceinline__ float bflo(unsigned w) { return __uint_as_float(w << 16); }
__device__ __forceinline__ float bfhi(unsigned w) { return __uint_as_float(w & 0xffff0000u); }
__device__ __forceinline__ float bf2f(short s) { return __uint_as_float(((unsigned)(unsigned short)s) << 16); }
__device__ __forceinline__ unsigned short f2bf(float f) { return (unsigned short)(pk2(f, 0.f) & 0xffffu); }
__device__ __forceinline__ float sigmoidf_(float x) { return __builtin_amdgcn_rcpf(1.f + __expf(-x)); }
__device__ __forceinline__ float siluf_(float x) { return x * __builtin_amdgcn_rcpf(1.f + __expf(-x)); }
__device__ __forceinline__ float wave_sum(float v) {
#pragma unroll
    for (int o = 1; o < 64; o <<= 1) v += __shfl_xor(v, o);
    return v;
}
#define LDS_WAIT() asm volatile("s_waitcnt lgkmcnt(0)" ::: "memory")
__device__ __forceinline__ float max3f_(float a, float b, float c) { float r; asm("v_max3_f32 %0, %1, %2, %3" : "=v"(r) : "v"(a), "v"(b), "v"(c)); return r; }
__device__ __forceinline__ float max16f_(const f32x4 (&s)[4]) {
    const float m1 = max3f_(s[0][0], s[0][1], s[0][2]), m2 = max3f_(s[0][3], s[1][0], s[1][1]), m3 = max3f_(s[1][2], s[1][3], s[2][0]), m4 = max3f_(s[2][1], s[2][2], s[2][3]), m5 = max3f_(s[3][0], s[3][1], s[3][2]);
    return max3f_(max3f_(m1, m2, s[3][3]), max3f_(m3, m4, m5), m1); }
__device__ __forceinline__ int perm32k(int w) { return 8 * ((w >> 2) & 3) + 4 * (w >> 4) + (w & 3); }
#define MFMA16(a, b, c) __builtin_amdgcn_mfma_f32_16x16x32_bf16((a), (b), (c), 0, 0, 0)

struct EpiProj {
    static constexpr bool PERM = true, AFTER_DRAIN = false; bf16* P; float* S; bf16* C;
    __device__ __forceinline__ void operator()(const f32x4 (&acc)[2][2][4][2], const pg8::Unit& u, int wr, int wc, int fr, int fq) const {
        const int row0 = u.pm * 256 + wr * 64 + fr;
        if (u.pn < 19) {
            const float sc = u.pn < 2 ? 0.125f * 1.44269504f : u.pn == 5 ? 0.125f : 1.f;     const int col0 = u.pn * 256 + wc * 32 + 8 * fq;
#pragma unroll
            for (int ai = 0; ai < 2; ++ai)
#pragma unroll
                for (int m = 0; m < 4; ++m) { bf16* rowp = P + (size_t)(row0 + ai * 128 + m * 16) * PLD + col0;
#pragma unroll
                    for (int bj = 0; bj < 2; ++bj) { const f32x4 v0 = acc[ai][bj][m][0] * sc, v1 = acc[ai][bj][m][1] * sc; u32x4 w;
                        w.x = pk2(v0[0], v0[1]); w.y = pk2(v0[2], v0[3]); w.z = pk2(v1[0], v1[1]); w.w = pk2(v1[2], v1[3]);
                        if (u.pn == 2) *(u32x4*)(C + ((size_t)(bj * 2 + (wc >> 1)) * M + (row0 + ai * 128 + m * 16)) * 64 + (wc & 1) * 32 + 8 * fq) = w;
                        else *(u32x4*)(rowp + bj * 128) = w; } }
        } else if (wc < 2) {
#pragma unroll
            for (int ai = 0; ai < 2; ++ai)
#pragma unroll
                for (int m = 0; m < 4; ++m) { float* rp = S + (size_t)(row0 + ai * 128 + m * 16) * 64 + wc * 32 + 8 * fq; *(f32x4*)rp = acc[ai][0][m][0]; *(f32x4*)(rp + 4) = acc[ai][0][m][1]; }
        }
    }
};
template <bool SECOND> struct EpiUp {
    static constexpr bool PERM = true, AFTER_DRAIN = false; const bf16* P; bf16* O; int ldo;
    __device__ __forceinline__ void operator()(const f32x4 (&acc)[2][2][4][2], const pg8::Unit& u, int wr, int wc, int fr, int fq) const {
        const int row0 = u.pm * 256 + wr * 64 + fr, col0 = u.pn * 256 + wc * 32 + 8 * fq;
#pragma unroll
        for (int ai = 0; ai < 2; ++ai)
#pragma unroll
            for (int m = 0; m < 4; ++m) { const size_t row = (size_t)(row0 + ai * 128 + m * 16);
#pragma unroll
                for (int bj = 0; bj < 2; ++bj) { const int col = col0 + bj * 128;
                    const u32x4 gw = *(const u32x4*)(P + row * PLD + PC_GM + (SECOND ? 1024 : 0) + col);
                    const f32x4 a0 = acc[ai][bj][m][0], a1 = acc[ai][bj][m][1];
                    float o[8] = { a0[0] * sigmoidf_(bflo(gw.x)), a0[1] * sigmoidf_(bfhi(gw.x)), a0[2] * sigmoidf_(bflo(gw.y)), a0[3] * sigmoidf_(bfhi(gw.y)),
                                   a1[0] * sigmoidf_(bflo(gw.z)), a1[1] * sigmoidf_(bfhi(gw.z)), a1[2] * sigmoidf_(bflo(gw.w)), a1[3] * sigmoidf_(bfhi(gw.w)) };
                    if (SECOND) { const u32x4 pw = *(const u32x4*)(O + row * ldo + col);
                        o[0] += bflo(pw.x); o[1] += bfhi(pw.x); o[2] += bflo(pw.y); o[3] += bfhi(pw.y); o[4] += bflo(pw.z); o[5] += bfhi(pw.z); o[6] += bflo(pw.w); o[7] += bfhi(pw.w); }
                    u32x4 w; w.x = pk2(o[0], o[1]); w.y = pk2(o[2], o[3]); w.z = pk2(o[4], o[5]); w.w = pk2(o[6], o[7]); *(u32x4*)(O + row * ldo + col) = w; } }
    }
};
struct UpOrder { pg8::StaticOrder so;
    __device__ bool next(int i, pg8::Unit& u) const { if (i > 1) return false; pg8::Unit b; if (!so.next(0, b)) return false; u.pm = b.pm + (i ? 64 : 0); u.pn = b.pn + (i ? 4 : 0); return true; }
    __device__ __forceinline__ void a_ready(const pg8::Unit&) const {}
    __device__ __forceinline__ void done(const pg8::Unit&) const {}
};
struct EpiUp2 { static constexpr bool PERM = true, AFTER_DRAIN = false; const bf16* P; bf16* O; int ldo;
    __device__ __forceinline__ void operator()(const f32x4 (&acc)[2][2][4][2], const pg8::Unit& u, int wr, int wc, int fr, int fq) const {
        if (u.pm < 64) { EpiUp<false> e{P, O, ldo}; e(acc, u, wr, wc, fr, fq); }
        else { EpiUp<true> e{P, O, ldo}; pg8::Unit v; v.pm = u.pm - 64; v.pn = u.pn - 4; e(acc, v, wr, wc, fr, fq); }
    }
};
template <bool WRITE_XB> struct EpiRes {
    static constexpr bool PERM = true, AFTER_DRAIN = true; const float* base; float* out; bf16* XB; float* rsq;
    __device__ __forceinline__ void fused(f32x4 (&acc)[2][2][4][2], const pg8::Unit& u, int wr, int wc, int fr, int fq, PG8_LAS unsigned char* lds, int wid, int lane) const {
        const int row0 = u.pm * 256 + wr * 64 + fr, col0 = u.pn * 256 + wc * 32 + 8 * fq;
        PG8_LAS float* rs = (PG8_LAS float*)lds;
#pragma unroll
        for (int ai = 0; ai < 2; ++ai) { f32x4 bb[4][2][2];
#pragma unroll
            for (int m = 0; m < 4; ++m)
#pragma unroll
                for (int bj = 0; bj < 2; ++bj) { const size_t off = (size_t)(row0 + ai * 128 + m * 16) * D + col0 + bj * 128; bb[m][bj][0] = *(const f32x4*)(base + off); bb[m][bj][1] = *(const f32x4*)(base + off + 4); }
#pragma unroll
            for (int m = 0; m < 4; ++m) { const size_t row = (size_t)(row0 + ai * 128 + m * 16); float ss = 0.f;
#pragma unroll
                for (int bj = 0; bj < 2; ++bj) { const size_t off = row * D + col0 + bj * 128;
                    const f32x4 v0 = bb[m][bj][0] + acc[ai][bj][m][0], v1 = bb[m][bj][1] + acc[ai][bj][m][1];
                    if (!WRITE_XB) { *(f32x4*)(out + off) = v0; *(f32x4*)(out + off + 4) = v1; }
                    ss += (v0[0] * v0[0] + v0[1] * v0[1]) + (v0[2] * v0[2] + v0[3] * v0[3]) + (v1[0] * v1[0] + v1[1] * v1[1]) + (v1[2] * v1[2] + v1[3] * v1[3]);
                    if (WRITE_XB) { u32x4 w; w.x = pk2(v0[0], v0[1]); w.y = pk2(v0[2], v0[3]); w.z = pk2(v1[0], v1[1]); w.w = pk2(v1[2], v1[3]); *(u32x4*)(XB + off) = w; } }
                ss += __shfl_xor(ss, 16); ss += __shfl_xor(ss, 32);
                if (fq == 0) rs[(ai * 128 + wr * 64 + m * 16 + fr) * 4 + wc] = ss; } }
        __syncthreads();
        const int t = wid * 64 + lane;
        if (t < 256) rsq[(size_t)u.pn * M + u.pm * 256 + t] = (rs[t * 4] + rs[t * 4 + 1]) + (rs[t * 4 + 2] + rs[t * 4 + 3]);
        __syncthreads();
    }
};
struct EpiFinal {
    static constexpr bool PERM = true, AFTER_DRAIN = true; const bf16* base; float* out; float* rsq; unsigned* cnt; const float* gain;
    __device__ __forceinline__ void fused(f32x4 (&acc)[2][2][4][2], const pg8::Unit& u, int wr, int wc, int fr, int fq, PG8_LAS unsigned char* lds, int wid, int lane) const {
        const int row0 = u.pm * 256 + wr * 64 + fr, col0 = u.pn * 256 + wc * 32 + 8 * fq;
        PG8_LAS float* rs = (PG8_LAS float*)lds;
        u32x4 bw[2][4][2];
#pragma unroll
        for (int ai = 0; ai < 2; ++ai)
#pragma unroll
            for (int m = 0; m < 4; ++m)
#pragma unroll
                for (int bj = 0; bj < 2; ++bj) bw[ai][m][bj] = *(const u32x4*)(base + (size_t)(row0 + ai * 128 + m * 16) * D + col0 + bj * 128);
#pragma unroll
        for (int ai = 0; ai < 2; ++ai)
#pragma unroll
            for (int m = 0; m < 4; ++m) { float ss = 0.f;
#pragma unroll
                for (int bj = 0; bj < 2; ++bj) { const u32x4 w = bw[ai][m][bj]; const f32x4 b0 = {bflo(w.x), bfhi(w.x), bflo(w.y), bfhi(w.y)}, b1 = {bflo(w.z), bfhi(w.z), bflo(w.w), bfhi(w.w)};
                    const f32x4 v0 = b0 + acc[ai][bj][m][0], v1 = b1 + acc[ai][bj][m][1]; acc[ai][bj][m][0] = v0; acc[ai][bj][m][1] = v1;
                    ss += (v0[0] * v0[0] + v0[1] * v0[1]) + (v0[2] * v0[2] + v0[3] * v0[3]) + (v1[0] * v1[0] + v1[1] * v1[1]) + (v1[2] * v1[2] + v1[3] * v1[3]); }
                ss += __shfl_xor(ss, 16); ss += __shfl_xor(ss, 32);
                if (fq == 0) rs[(ai * 128 + wr * 64 + m * 16 + fr) * 4 + wc] = ss; }
        __syncthreads();
        const int t = wid * 64 + lane;
        if (t < 256) rsq[(size_t)u.pn * M + u.pm * 256 + t] = (rs[t * 4] + rs[t * 4 + 1]) + (rs[t * 4 + 2] + rs[t * 4 + 3]);
        asm volatile("s_waitcnt vmcnt(0)" ::: "memory");
        __syncthreads();
        if (t == 0) { __builtin_amdgcn_fence(__ATOMIC_RELEASE, "agent"); asm volatile("s_waitcnt vmcnt(0)" ::: "memory");
            unsigned* c = cnt + 64 * u.pm; __hip_atomic_fetch_add(c, 1u, __ATOMIC_RELAXED, __HIP_MEMORY_SCOPE_AGENT);
            while (__hip_atomic_load(c, __ATOMIC_RELAXED, __HIP_MEMORY_SCOPE_AGENT) < 4u) __builtin_amdgcn_s_sleep(2);
            __builtin_amdgcn_fence(__ATOMIC_ACQUIRE, "agent"); asm volatile("s_waitcnt vmcnt(0)" ::: "memory"); }
        __syncthreads();
        PG8_LAS float* rstd = (PG8_LAS float*)(lds + 4096);
        if (t < 256) { const size_t row = (size_t)u.pm * 256 + t; rstd[t] = rsqrtf(((rsq[row] + rsq[(size_t)M + row]) + (rsq[(size_t)2 * M + row] + rsq[(size_t)3 * M + row])) * (1.f / D) + EPS); }
        __syncthreads();
#pragma unroll
        for (int ai = 0; ai < 2; ++ai)
#pragma unroll
            for (int m = 0; m < 4; ++m) { const int rl = ai * 128 + wr * 64 + m * 16 + fr; const float r = rstd[rl]; const size_t row = (size_t)u.pm * 256 + rl;
#pragma unroll
                for (int bj = 0; bj < 2; ++bj) { const size_t off = row * D + col0 + bj * 128; const f32x4 g0 = *(const f32x4*)(gain + col0 + bj * 128), g1 = *(const f32x4*)(gain + col0 + bj * 128 + 4); *(f32x4*)(out + off) = acc[ai][bj][m][0] * r * g0; *(f32x4*)(out + off + 4) = acc[ai][bj][m][1] * r * g1; } }
        __syncthreads();
    }
};
struct EpiFfn {
    static constexpr bool PERM = true, AFTER_DRAIN = false; bf16* H; const float* rsq;
    __device__ __forceinline__ void operator()(const f32x4 (&acc)[2][2][4][2], const pg8::Unit& u, int wr, int wc, int fr, int fq) const {
        const int row0 = u.pm * 256 + wr * 64 + fr, f0 = u.pn * 128 + wc * 16 + 4 * fq;
#pragma unroll
        for (int ai = 0; ai < 2; ++ai)
#pragma unroll
            for (int m = 0; m < 4; ++m) { const size_t row = (size_t)(row0 + ai * 128 + m * 16); const float rstd = rsqrtf(((rsq[row] + rsq[(size_t)M + row]) + (rsq[(size_t)2 * M + row] + rsq[(size_t)3 * M + row])) * (1.f / D) + EPS);
#pragma unroll
                for (int bj = 0; bj < 2; ++bj) { const f32x4 gv = acc[ai][bj][m][0] * rstd, uv = acc[ai][bj][m][1] * rstd;
                    u32x2 w; w.x = pk2(siluf_(gv[0]) * uv[0], siluf_(gv[1]) * uv[1]); w.y = pk2(siluf_(gv[2]) * uv[2], siluf_(gv[3]) * uv[3]);
                    *(u32x2*)(H + row * DFF + f0 + bj * 64) = w; } }
    }
};

template <int MODE> __device__ __forceinline__ void tr_item(const float* W0, const float* W1, int K, int Nsrc, bf16* WT, int item, int nblk, const float* kscale, LAS float* scr, int lane) {
    const int kb = item / nblk, nb = item % nblk, k0 = 64 * kb, n0 = 32 * nb, nn = n0 + (lane & 31);
    const float* src = W0; int sc = nn;
    if (MODE == 1) sc = nn < 1280 ? nn : nn < 2304 ? nn + 24 : nn < 4864 ? nn + 40 : nn < 4888 ? nn - 4864 + 1280 : nn < 4904 ? nn - 4888 + 2328 : -1;
    if (MODE == 2) { const int q = nn >> 3, e = nn & 7; src = (e < 4) ? W0 : W1; sc = 4 * q + (e & 3); }
    float tv[32];
#pragma unroll
    for (int i = 0; i < 32; ++i) { const int kk = 2 * i + (lane >> 5); tv[i] = sc >= 0 ? src[(size_t)(k0 + kk) * Nsrc + sc] : 0.f; }
#pragma unroll
    for (int i = 0; i < 32; ++i) { const int kk = 2 * i + (lane >> 5); float v = tv[i]; if (kscale) v *= kscale[k0 + kk]; scr[kk * 33 + (lane & 31)] = v; }
    LDS_WAIT();
    const int c = lane & 7;
#pragma unroll
    for (int j = 0; j < 4; ++j) { const int n = (lane >> 3) + 8 * j; const LAS float* s = scr + (8 * c) * 33 + n;
        u32x4 o; o.x = pk2(s[0 * 33], s[1 * 33]); o.y = pk2(s[2 * 33], s[3 * 33]); o.z = pk2(s[4 * 33], s[5 * 33]); o.w = pk2(s[6 * 33], s[7 * 33]);
        *(u32x4*)(WT + (size_t)(n0 + n) * K + k0 + 8 * c) = o; }
    LDS_WAIT();
}
__device__ __forceinline__ void rms_row_to_bf16(const float* xrow, const float* gain, bf16* orow, int lane) {
    const f32x4* xr = (const f32x4*)xrow + lane; const f32x4* gr = (const f32x4*)gain + lane;
    f32x4 v[4]; float s = 0.f;
#pragma unroll
    for (int j = 0; j < 4; ++j) { v[j] = xr[64 * j]; s += (v[j].x * v[j].x + v[j].y * v[j].y) + (v[j].z * v[j].z + v[j].w * v[j].w); }
    const float rstd = rsqrtf(wave_sum(s) * (1.f / D) + EPS);
    u32x2* o8 = (u32x2*)orow + lane;
#pragma unroll
    for (int j = 0; j < 4; ++j) { const f32x4 g = gr[64 * j]; u32x2 w; w.x = pk2(v[j].x * rstd * g.x, v[j].y * rstd * g.y); w.y = pk2(v[j].z * rstd * g.z, v[j].w * rstd * g.w); o8[64 * j] = w; }
}
struct Args { const float* in[20]; float* out; unsigned char* ws; };

__device__ __forceinline__ void p0_prologue(const Args& a, LAS unsigned char* lds, int wave, int lane) {
    unsigned char* ws = a.ws;
    LAS float* scr = (LAS float*)(lds + wave * 16384);
    const int gw = blockIdx.x * NWAVES + wave, NGW = gridDim.x * NWAVES;
    constexpr int I_IN = 16 * (NIN / 32), I_GU = 16 * (NGU / 32), I_DN = 44 * 32, I_OUT = 16 * 32, I_UP = 8 * 32, I_C1 = 32 * 4, I_C2 = 2 * 2;
    constexpr int NITEMS = I_IN + I_GU + I_DN + I_OUT + 2 * I_UP + 2 * I_C1 + 2 * I_C2;
    for (int it = gw; it < NITEMS; it += NGW) {
        int r = it;
        if (r < I_IN) { tr_item<1>(a.in[2], nullptr, 1024, 4904, (bf16*)(ws + WS_WIN), r, NIN / 32, nullptr, scr, lane); continue; } r -= I_IN;
        if (r < I_GU) { tr_item<2>(a.in[16], a.in[17], 1024, DFF, (bf16*)(ws + WS_WGU), r, NGU / 32, a.in[15], scr, lane); continue; } r -= I_GU;
        if (r < I_DN) { tr_item<0>(a.in[18], nullptr, DFF, 1024, (bf16*)(ws + WS_WDN), r, 32, nullptr, scr, lane); continue; } r -= I_DN;
        if (r < I_OUT) { tr_item<0>(a.in[14], nullptr, 1024, 1024, (bf16*)(ws + WS_WOUT), r, 32, nullptr, scr, lane); continue; } r -= I_OUT;
        if (r < I_UP) { tr_item<0>(a.in[12], nullptr, 512, 1024, (bf16*)(ws + WS_WUPA), r, 32, nullptr, scr, lane); continue; } r -= I_UP;
        if (r < I_UP) { tr_item<0>(a.in[13], nullptr, 512, 1024, (bf16*)(ws + WS_WUPB), r, 32, nullptr, scr, lane); continue; } r -= I_UP;
        if (r < I_C1) { tr_item<0>(a.in[5], nullptr, 2048, 128, (bf16*)(ws + WS_CW1K), r, 4, nullptr, scr, lane); continue; } r -= I_C1;
        if (r < I_C1) { tr_item<0>(a.in[7], nullptr, 2048, 128, (bf16*)(ws + WS_CW1V), r, 4, nullptr, scr, lane); continue; } r -= I_C1;
        if (r < I_C2) { tr_item<0>(a.in[6], nullptr, 128, 64, (bf16*)(ws + WS_CW2K), r, 2, nullptr, scr, lane); continue; } r -= I_C2;
        tr_item<0>(a.in[8], nullptr, 128, 64, (bf16*)(ws + WS_CW2V), r, 2, nullptr, scr, lane);
    }
    for (int m0 = gw; m0 < M; m0 += 4 * NGW) {
        f32x4 v[4][4]; float ss[4];
#pragma unroll
        for (int r = 0; r < 4; ++r) { const int m = m0 + r * NGW < M ? m0 + r * NGW : m0; const f32x4* xr = (const f32x4*)(a.in[0] + (size_t)m * D) + lane;
#pragma unroll
            for (int j = 0; j < 4; ++j) v[r][j] = xr[64 * j]; }
#pragma unroll
        for (int r = 0; r < 4; ++r) { float s_ = 0.f;
#pragma unroll
            for (int j = 0; j < 4; ++j) s_ += (v[r][j].x * v[r][j].x + v[r][j].y * v[r][j].y) + (v[r][j].z * v[r][j].z + v[r][j].w * v[r][j].w);
            ss[r] = rsqrtf(wave_sum(s_) * (1.f / D) + EPS); }
#pragma unroll
        for (int r = 0; r < 4; ++r) { const int m = m0 + r * NGW; if (m < M) { u32x2* o8 = (u32x2*)((bf16*)(ws + WS_XN) + (size_t)m * D) + lane; const f32x4* gr = (const f32x4*)a.in[1] + lane;
#pragma unroll
            for (int j = 0; j < 4; ++j) { const f32x4 g = gr[64 * j]; u32x2 w; w.x = pk2(v[r][j].x * ss[r] * g.x, v[r][j].y * ss[r] * g.y); w.y = pk2(v[r][j].z * ss[r] * g.z, v[r][j].w * ss[r] * g.w); o8[64 * j] = w; } } } }
    for (int e = blockIdx.x * NTHR + threadIdx.x; e < T * 8; e += gridDim.x * NTHR) {
        const int t = e >> 3, i = e & 7;
        const float f = i == 0 ? 1.0f : i == 1 ? 0.19392274f : i == 2 ? 0.03760603f : i == 3 ? 0.0072926646f : i == 4 ? 0.0014142136f : i == 5 ? 0.0002742482f : i == 6 ? 5.3182957e-05f : 1.0313385e-05f;
        const float ang = (float)t * f;
        const float p = ang * 0.15915494f; const float er = fmaf(ang, 0.15915494f, -p) + ang * 6.4206382e-09f; const float fr = (p - rintf(p)) + er;
        ((float*)(ws + WS_ROPE))[e] = __builtin_amdgcn_cosf(fr); ((float*)(ws + WS_ROPE))[T * 8 + e] = __builtin_amdgcn_sinf(fr);
    }
    if (gw >= NGW - 32) { const int g2 = gw - (NGW - 32), kv = g2 >> 4, q = g2 & 15; const float* pe = a.in[3 + kv] + 128 * q; const float* w1 = a.in[kv ? 7 : 5] + (size_t)(128 * q) * 128;
        float s0 = 0.f, s1 = 0.f;
#pragma unroll 32
        for (int k = 0; k < 128; ++k) { const float p = pe[k]; s0 += p * w1[k * 128 + lane]; s1 += p * w1[k * 128 + 64 + lane]; }
        float* b1 = (float*)(ws + WS_CTL) + 2048 + (kv * 16 + q) * 128; b1[lane] = s0; b1[64 + lane] = s1; }
}

__device__ __forceinline__ u32x4 rope_unit(u32x4 x, const u32x4 y, const float* RC, const float* RS, int t, float sg) {
    const f32x4 c0 = *(const f32x4*)(RC + t * 8), c1 = *(const f32x4*)(RC + t * 8 + 4), s0 = *(const f32x4*)(RS + t * 8), s1 = *(const f32x4*)(RS + t * 8 + 4);
    x.x = pk2(bflo(x.x) * c0[0] + sg * bflo(y.x) * s0[0], bfhi(x.x) * c0[1] + sg * bfhi(y.x) * s0[1]); x.y = pk2(bflo(x.y) * c0[2] + sg * bflo(y.y) * s0[2], bfhi(x.y) * c0[3] + sg * bfhi(y.y) * s0[3]);
    x.z = pk2(bflo(x.z) * c1[0] + sg * bflo(y.z) * s1[0], bfhi(x.z) * c1[1] + sg * bfhi(y.z) * s1[1]); x.w = pk2(bflo(x.w) * c1[2] + sg * bflo(y.w) * s1[2], bfhi(x.w) * c1[3] + sg * bfhi(y.w) * s1[3]);
    return x;
}
__device__ __forceinline__ void rope_item(int item, unsigned char* ws, int lane) {
    const bf16* PROJ = (const bf16*)(ws + WS_PROJ); const float* RC = (const float*)(ws + WS_ROPE); const float* RS = RC + T * 8; bf16* QROT = (bf16*)(ws + WS_QROT); bf16* KROT = (bf16*)(ws + WS_KROT);
    const size_t row0 = (size_t)item * 8; const int tq0 = (int)(row0 & (T - 1));
    { const int sub = lane & 7; const float sg = sub == 0 ? -1.f : 1.f; u32x4 x[8], y[8];
#pragma unroll
      for (int tt = 0; tt < 8; ++tt) { const bf16* src = PROJ + (row0 + tt) * PLD + PC_QN; x[tt] = *(const u32x4*)(src + 8 * lane); y[tt] = *(const u32x4*)(src + 8 * (lane ^ 1)); }
#pragma unroll
      for (int tt = 0; tt < 8; ++tt) { if (sub < 2) { x[tt] = rope_unit(x[tt], y[tt], RC, RS, tq0 + tt, sg); *(u32x4*)(QROT + (row0 + tt) * 128 + (lane >> 3) * 16 + 8 * sub) = x[tt]; } } }
    { u32x4 x[4], y[4];
#pragma unroll
      for (int it = 0; it < 4; ++it) { const int id = it * 64 + lane, tt = id >> 5, w = id & 31, tensor = w >> 4, g = (w >> 3) & 1, u8 = w & 7;
          const bf16* p = PROJ + (row0 + tt) * PLD + PC_KV + (2 + 2 * tensor) * 128 + g * 64; x[it] = *(const u32x4*)(p + 8 * u8); y[it] = *(const u32x4*)(p + 8 * (u8 ^ 1)); }
#pragma unroll
      for (int it = 0; it < 4; ++it) { const int id = it * 64 + lane, tt = id >> 5, w = id & 31, u8 = w & 7;
          if (u8 < 2) x[it] = rope_unit(x[it], y[it], RC, RS, tq0 + tt, u8 == 0 ? -1.f : 1.f);
          *(u32x4*)(KROT + ((size_t)(w >> 3) * M + row0 + tt) * 64 + 8 * u8) = x[it]; } }
}
__device__ __forceinline__ void p2a_item(int item, unsigned char* ws, LAS unsigned char* wl, int lane) {
    const bf16* PROJ = (const bf16*)(ws + WS_PROJ);
    const int part = item & 1, tile = item >> 1, b = tile >> 7, t0 = (tile & 127) * 64;
    int csrc; bf16* dst; int nc, cdst;
    if (part == 0) { csrc = PC_KV + 3 * 128; dst = (bf16*)(ws + WS_VTS); nc = 128; cdst = 0; }
    else { csrc = PC_KV + 5 * 128; dst = (bf16*)(ws + WS_VTW); nc = 128; cdst = 0; }
    LAS unsigned char* tb = wl;
#pragma unroll
    for (int it = 0; it < 16; ++it) { const int id = it * 64 + lane, tt = id >> 4, uu = id & 15;
        const u32x4 v = *(const u32x4*)(PROJ + ((size_t)b * T + t0 + tt) * PLD + csrc + 8 * uu);
        *(LAS u32x2*)(tb + tt * 264 + uu * 16) = (u32x2){v.x, v.y}; *(LAS u32x2*)(tb + tt * 264 + uu * 16 + 8) = (u32x2){v.z, v.w}; }
    LDS_WAIT();
#pragma unroll
    for (int pass = 0; pass < 2; ++pass) { const int c = pass * 64 + lane;
        bf16* dp = dst + ((((size_t)(b * 2 + pass)) * 128 + (t0 >> 6)) * 64 + lane) * 64;
#pragma unroll
        for (int hb = 0; hb < 2; ++hb) { unsigned wv[16];
#pragma unroll
            for (int p2 = 0; p2 < 16; ++p2) { unsigned lo, hi;
                { const int p = 2 * p2, fqq = p >> 3, e = p & 7, key = 32 * hb + (e < 4 ? 4 * fqq + e : 16 + 4 * fqq + (e - 4)); lo = *(const LAS unsigned short*)(tb + key * 264 + c * 2); }
                { const int p = 2 * p2 + 1, fqq = p >> 3, e = p & 7, key = 32 * hb + (e < 4 ? 4 * fqq + e : 16 + 4 * fqq + (e - 4)); hi = *(const LAS unsigned short*)(tb + key * 264 + c * 2); }
                wv[p2] = lo | (hi << 16); }
#pragma unroll
            for (int q = 0; q < 4; ++q) *(u32x4*)(dp + 32 * hb + 8 * q) = (u32x4){wv[4 * q], wv[4 * q + 1], wv[4 * q + 2], wv[4 * q + 3]}; } }
    LDS_WAIT();
}

__device__ __forceinline__ void compress_item(int item, int sub, unsigned char* ws, LAS unsigned char* lds, int wave, int lane) {
    const int kv = item >> 5, g = (item >> 4) & 1, rt = item & 15, fr = lane & 15, fq = lane >> 4;
    const int rbase = rt * 64 + sub * 16;
    const bf16* Ap; { const int rowidx = rbase + fr, b = rowidx >> 9, ii = rowidx & 511; int tok0 = b * T + 16 * ii; if (tok0 > M - 32) tok0 = M - 32;
        Ap = (const bf16*)(ws + WS_CSRC) + ((size_t)(kv * 2 + g) * M + tok0) * 64 + 8 * fq; }
    const bf16* Bp = (const bf16*)(ws + (kv ? WS_CW1V : WS_CW1K)) + (size_t)(16 * wave + fr) * 2048 + 8 * fq;
    f32x4 acc = {0.f, 0.f, 0.f, 0.f};
    for (int kb = 0; kb < 64; kb += 16) {
        bf16x8 bv[16], av[16];
#pragma unroll
        for (int k2 = 0; k2 < 16; ++k2) { bv[k2] = *(const bf16x8*)(Bp + 32 * (kb + k2)); av[k2] = *(const bf16x8*)(Ap + 32 * (kb + k2)); }
#pragma unroll
        for (int k2 = 0; k2 < 16; ++k2) acc = MFMA16(av[k2], bv[k2], acc); }
    float bias = 0.f;
#pragma unroll
    for (int q = 0; q < 16; ++q) bias += ((const float*)(ws + WS_CTL))[2048 + (kv * 16 + q) * 128 + 16 * wave + fr];
    LAS bf16* H1 = (LAS bf16*)lds;
#pragma unroll
    for (int i = 0; i < 4; ++i) H1[(4 * fq + i) * 136 + 16 * wave + fr] = f2bf(siluf_(acc[i] + bias));
    __syncthreads();
    if (wave < 4) { const int ct = wave; const bf16* W2 = (const bf16*)(ws + (kv ? WS_CW2V : WS_CW2K)) + (size_t)(16 * ct + fr) * 128 + 8 * fq; f32x4 a2 = {0.f, 0.f, 0.f, 0.f};
#pragma unroll
        for (int ks = 0; ks < 4; ++ks) { const bf16x8 av = *(const LAS bf16x8*)(H1 + fr * 136 + 32 * ks + 8 * fq); const bf16x8 bv = *(const bf16x8*)(W2 + 32 * ks); a2 = MFMA16(av, bv, a2); }
        const int c = 16 * ct + fr;
        float vv[4];
#pragma unroll
        for (int i = 0; i < 4; ++i) { const int i2 = (rbase + 4 * fq + i) & 511; vv[i] = (i2 == 511) ? 0.f : a2[i]; }
        const int r0 = rbase + 4 * fq, b2 = r0 >> 9, i20 = r0 & 511;
        if (kv == 0) {
#pragma unroll
            for (int i = 0; i < 4; ++i) { const float nb = __shfl_xor(vv[i], 1); if (!(fr & 1)) *(unsigned*)((bf16*)(ws + WS_KCMP) + ((size_t)(b2 * 2 + g) * 512 + i20 + i) * 64 + c) = pk2(vv[i], nb); }
        } else { u32x2 w; w.x = pk2(vv[0], vv[1]); w.y = pk2(vv[2], vv[3]);
            *(u32x2*)((bf16*)(ws + WS_VCMPT) + ((size_t)(b2 * 2 + g) * 64 + c) * 512 + (i20 & ~31) + perm32k(i20 & 31)) = w; } }
    __syncthreads();
}

__device__ __forceinline__ void gla_cum(LAS float* cum, LAS float* tot, const float* SM, const float* w2, const float* gb, int b, int h, int c, int tid) {
    const int dk = tid & 63, tg = __builtin_amdgcn_readfirstlane(tid >> 6);
    float wcol[16];
#pragma unroll
    for (int r = 0; r < 16; ++r) wcol[r] = w2[r * 256 + h * 64 + dk];
    const float bias = gb[h * 64 + dk]; float run = 0.f, vals[8];
    LAS float* lrs = tot + 7680;
    if (tid < 256) *(LAS f32x4*)(lrs + (tid >> 2) * 16 + 4 * (tid & 3)) = *(const f32x4*)(SM + ((size_t)b * T + 64 * c + (tid >> 2)) * 64 + 24 + 4 * (tid & 3));
    __syncthreads();
#pragma unroll
    for (int j = 0; j < 8; ++j) { const LAS float* lr = lrs + (8 * tg + j) * 16; float z = bias;
#pragma unroll
        for (int r4 = 0; r4 < 4; ++r4) { const f32x4 v = *(const LAS f32x4*)(lr + 4 * r4); z += v[0] * wcol[4 * r4] + v[1] * wcol[4 * r4 + 1] + v[2] * wcol[4 * r4 + 2] + v[3] * wcol[4 * r4 + 3]; }
        const float la = (fminf(z, 0.f) - __logf(1.f + __expf(-fabsf(z)))) * (1.f / 16.f); run += la; vals[j] = run; }
    tot[tg * 64 + dk] = run;
    __syncthreads();
    float pre = 0.f;
#pragma unroll
    for (int g2 = 0; g2 < 7; ++g2) pre += (g2 < tg) ? tot[g2 * 64 + dk] : 0.f;
#pragma unroll
    for (int j = 0; j < 8; ++j) cum[(8 * tg + j) * 65 + dk] = vals[j] + pre;
    __syncthreads();
}
constexpr int GL_CUM = 0, GL_TOT = 16640, GL_KT = 18688, GL_VT = 27904, GL_SSQ = 46336;
__device__ __forceinline__ void gla_local_item(int item, const Args& a, LAS unsigned char* lds, int tid, int wave, int lane) {
    unsigned char* ws = a.ws; const bf16* PROJ = (const bf16*)(ws + WS_PROJ);
    const int b = item >> 9, h = (item >> 7) & 3, c = item & 127, fr = lane & 15, fq = lane >> 4;
    LAS float* cum = (LAS float*)(lds + GL_CUM); LAS float* tot = (LAS float*)(lds + GL_TOT); LAS bf16* KT = (LAS bf16*)(lds + GL_KT); LAS bf16* VT = (LAS bf16*)(lds + GL_VT);
    gla_cum(cum, tot, (const float*)(ws + WS_SMALL), a.in[9], a.in[10], b, h, c, tid);
    { const int s = tid >> 3, u = tid & 7; const size_t row = (size_t)b * T + 64 * c + s; const bf16x8 kr = *(const bf16x8*)(PROJ + row * PLD + PC_KG + h * 64 + 8 * u);
      const int pos = (s & 32) + perm32k(s & 31);
#pragma unroll
      for (int e = 0; e < 8; ++e) { const int dk = 8 * u + e; KT[dk * 72 + pos] = f2bf(bf2f(kr[e]) * __expf(cum[63 * 65 + dk] - cum[s * 65 + dk])); } }
#pragma unroll
    for (int it = 0; it < 2; ++it) { const int id = tid + 512 * it, s = id >> 4, u = id & 15; const size_t row = (size_t)b * T + 64 * c + s;
        const bf16x8 vr = *(const bf16x8*)(PROJ + row * PLD + PC_VG + h * 128 + 8 * u); const int pos = (s & 32) + perm32k(s & 31);
#pragma unroll
        for (int e = 0; e < 8; ++e) VT[(8 * u + e) * 72 + pos] = (bf16)vr[e]; }
    if (tid < 64) ((float*)(ws + WS_DEC))[(size_t)item * 64 + tid] = __expf(cum[63 * 65 + tid]);
    __syncthreads();
    bf16* LS = (bf16*)((unsigned char*)a.out + DO_L);
#pragma unroll
    for (int dkt = 0; dkt < 4; ++dkt) { f32x4 acc = {0.f, 0.f, 0.f, 0.f};
#pragma unroll
        for (int ks = 0; ks < 2; ++ks) { const bf16x8 av = *(const LAS bf16x8*)(VT + (16 * wave + fr) * 72 + 32 * ks + 8 * fq); const bf16x8 bv = *(const LAS bf16x8*)(KT + (16 * dkt + fr) * 72 + 32 * ks + 8 * fq); acc = MFMA16(av, bv, acc); }
#pragma unroll
        for (int i = 0; i < 4; ++i) { const float nb = __shfl_xor(acc[i], 1); if (!(fr & 1)) *(unsigned*)(LS + ((size_t)item * 128 + 16 * wave + 4 * fq + i) * 64 + 16 * dkt + fr) = pk2(acc[i], nb); } }
    __syncthreads();
}
__device__ __forceinline__ void gla_out_item(int item, const Args& a, LAS unsigned char* lds, int tid, int wave, int lane) {
    unsigned char* ws = a.ws; const bf16* PROJ = (const bf16*)(ws + WS_PROJ);
    const int b = item >> 9, h = (item >> 7) & 3, c = item & 127, fr = lane & 15, fq = lane >> 4, tt = wave & 3, hh = wave >> 2;
    LAS bf16* VT = (LAS bf16*)(lds + GL_VT);
    LAS float* cum = (LAS float*)(lds + GL_CUM); LAS float* tot = (LAS float*)(lds + GL_TOT); LAS float* ssqb = (LAS float*)(lds + GL_SSQ);
    gla_cum(cum, tot, (const float*)(ws + WS_SMALL), a.in[9], a.in[10], b, h, c, tid);
#pragma unroll
    for (int it = 0; it < 2; ++it) { const int id = tid + 512 * it, s = id >> 4, u = id & 15; const size_t row = (size_t)b * T + 64 * c + s;
        const bf16x8 vr = *(const bf16x8*)(PROJ + row * PLD + PC_VG + h * 128 + 8 * u); const int pos = (s & 32) + perm32k(s & 31);
#pragma unroll
        for (int e = 0; e < 8; ++e) VT[(8 * u + e) * 72 + pos] = (bf16)vr[e]; }
    __syncthreads();
    const int tokq = 16 * tt + fr; const size_t rowq = (size_t)b * T + 64 * c + tokq;
    bf16x8 qf[2];
#pragma unroll
    for (int ks = 0; ks < 2; ++ks) { const bf16x8 raw = *(const bf16x8*)(PROJ + rowq * PLD + PC_QG + h * 64 + 32 * ks + 8 * fq);
#pragma unroll
        for (int e = 0; e < 8; ++e) qf[ks][e] = (short)f2bf(bf2f(raw[e]) * __expf(cum[tokq * 65 + 32 * ks + 8 * fq + e])); }
    f32x4 at[4];
#pragma unroll
    for (int st = 0; st < 4; ++st) { at[st] = (f32x4){0.f, 0.f, 0.f, 0.f};
        if (st <= tt) { const int s = 16 * st + fr; const size_t rows = (size_t)b * T + 64 * c + s; bf16x8 kf[2];
#pragma unroll
            for (int ks = 0; ks < 2; ++ks) { const bf16x8 raw = *(const bf16x8*)(PROJ + rows * PLD + PC_KG + h * 64 + 32 * ks + 8 * fq);
#pragma unroll
                for (int e = 0; e < 8; ++e) kf[ks][e] = (short)f2bf(bf2f(raw[e]) * __expf(-cum[s * 65 + 32 * ks + 8 * fq + e])); }
            at[st] = MFMA16(kf[0], qf[0], at[st]); at[st] = MFMA16(kf[1], qf[1], at[st]);
            if (st == tt) {
#pragma unroll
                for (int i = 0; i < 4; ++i) if (4 * fq + i > fr) at[st][i] = 0.f; } } }
    bf16x8 pf[2];
#pragma unroll
    for (int k2 = 0; k2 < 2; ++k2) { const u32x4 w = {pk2(at[2 * k2][0], at[2 * k2][1]), pk2(at[2 * k2][2], at[2 * k2][3]), pk2(at[2 * k2 + 1][0], at[2 * k2 + 1][1]), pk2(at[2 * k2 + 1][2], at[2 * k2 + 1][3])}; pf[k2] = __builtin_bit_cast(bf16x8, w); }
    const bf16* LS = (const bf16*)((const unsigned char*)a.out + DO_S);
    f32x4 o[4]; float ssq = 0.f;
#pragma unroll
    for (int j = 0; j < 4; ++j) { const int dv0 = 64 * hh + 16 * j; f32x4 acc = {0.f, 0.f, 0.f, 0.f};
#pragma unroll
        for (int ks = 0; ks < 2; ++ks) { const bf16x8 sf = *(const bf16x8*)(LS + ((size_t)item * 128 + dv0 + fr) * 64 + 32 * ks + 8 * fq); acc = MFMA16(sf, qf[ks], acc); }
#pragma unroll
        for (int k2 = 0; k2 < 2; ++k2) { const bf16x8 vf = *(const LAS bf16x8*)(VT + (dv0 + fr) * 72 + 32 * k2 + 8 * fq); acc = MFMA16(vf, pf[k2], acc); }
        o[j] = acc; ssq += (acc[0] * acc[0] + acc[1] * acc[1]) + (acc[2] * acc[2] + acc[3] * acc[3]); }
    ssq += __shfl_xor(ssq, 16); ssq += __shfl_xor(ssq, 32);
    if (fq == 0) ssqb[hh * 64 + tokq] = ssq;
    __syncthreads();
    const float rstd = rsqrtf((ssqb[tokq] + ssqb[64 + tokq]) * (1.f / 128.f) + EPS);
#pragma unroll
    for (int j = 0; j < 4; ++j) { const int dvb = 64 * hh + 16 * j + 4 * fq; const f32x4 gn = *(const f32x4*)(a.in[11] + dvb); const bf16* rp = PROJ + rowq * PLD + PC_RG + h * 128 + dvb; bf16* op = (bf16*)((unsigned char*)a.out + DO_OB) + rowq * 512 + h * 128 + dvb;
        const u32x2 rw = *(const u32x2*)rp; const float r0 = bflo(rw.x), r1 = bfhi(rw.x), r2 = bflo(rw.y), r3 = bfhi(rw.y);
        u32x2 w; w.x = pk2(o[j][0] * rstd * gn[0] * siluf_(r0), o[j][1] * rstd * gn[1] * siluf_(r1)); w.y = pk2(o[j][2] * rstd * gn[2] * siluf_(r2), o[j][3] * rstd * gn[3] * siluf_(r3));
        *(u32x2*)op = w; }
    __syncthreads();
}

constexpr int GL2_STRIDE = 53248;
__device__ __forceinline__ void gla_cum2(LAS float* cum, LAS float* tot, LAS float* lrs, const float* SM, const float* w2, const float* gb, int b, int h, int c, int th) {
    const int dk = th & 63, tg = __builtin_amdgcn_readfirstlane(th >> 6);
    float wcol[16];
#pragma unroll
    for (int r = 0; r < 16; ++r) wcol[r] = w2[r * 256 + h * 64 + dk];
    const float bias = gb[h * 64 + dk]; float run = 0.f, vals[16];
    *(LAS f32x4*)(lrs + (th >> 2) * 16 + 4 * (th & 3)) = *(const f32x4*)(SM + ((size_t)b * T + 64 * c + (th >> 2)) * 64 + 24 + 4 * (th & 3));
    __syncthreads();
#pragma unroll
    for (int j = 0; j < 16; ++j) { const LAS float* lr = lrs + (16 * tg + j) * 16; float z = bias;
#pragma unroll
        for (int r4 = 0; r4 < 4; ++r4) { const f32x4 v = *(const LAS f32x4*)(lr + 4 * r4); z += v[0] * wcol[4 * r4] + v[1] * wcol[4 * r4 + 1] + v[2] * wcol[4 * r4 + 2] + v[3] * wcol[4 * r4 + 3]; }
        const float la = (fminf(z, 0.f) - __logf(1.f + __expf(-fabsf(z)))) * (1.f / 16.f); run += la; vals[j] = run; }
    tot[tg * 64 + dk] = run;
    __syncthreads();
    float pre = 0.f;
#pragma unroll
    for (int g2 = 0; g2 < 3; ++g2) pre += (g2 < tg) ? tot[g2 * 64 + dk] : 0.f;
#pragma unroll
    for (int j = 0; j < 16; ++j) cum[(16 * tg + j) * 65 + dk] = vals[j] + pre;
    __syncthreads();
}
__device__ __forceinline__ void gla_local_pair(int pair, const Args& a, LAS unsigned char* lds0, int tid, int wave, int lane) {
    unsigned char* ws = a.ws; const bf16* PROJ = (const bf16*)(ws + WS_PROJ);
    const int half = tid >> 8, th = tid & 255, wv = wave & 3, item = 2 * pair + half;
    LAS unsigned char* lds = lds0 + half * GL2_STRIDE;
    const int b = item >> 9, h = (item >> 7) & 3, c = item & 127, fr = lane & 15, fq = lane >> 4;
    LAS float* cum = (LAS float*)(lds + GL_CUM); LAS float* tot = (LAS float*)(lds + GL_TOT); LAS bf16* KT = (LAS bf16*)(lds + GL_KT); LAS bf16* VT = (LAS bf16*)(lds + GL_VT);
    gla_cum2(cum, tot, (LAS float*)(lds + 47360), (const float*)(ws + WS_SMALL), a.in[9], a.in[10], b, h, c, th);
#pragma unroll
    for (int it = 0; it < 2; ++it) { const int id = th + 256 * it, s = id >> 3, u = id & 7; const size_t row = (size_t)b * T + 64 * c + s; const bf16x8 kr = *(const bf16x8*)(PROJ + row * PLD + PC_KG + h * 64 + 8 * u);
        const int pos = (s & 32) + perm32k(s & 31);
#pragma unroll
        for (int e = 0; e < 8; ++e) { const int dk = 8 * u + e; KT[dk * 72 + pos] = f2bf(bf2f(kr[e]) * __expf(cum[63 * 65 + dk] - cum[s * 65 + dk])); } }
#pragma unroll
    for (int it = 0; it < 4; ++it) { const int id = th + 256 * it, s = id >> 4, u = id & 15; const size_t row = (size_t)b * T + 64 * c + s;
        const bf16x8 vr = *(const bf16x8*)(PROJ + row * PLD + PC_VG + h * 128 + 8 * u); const int pos = (s & 32) + perm32k(s & 31);
#pragma unroll
        for (int e = 0; e < 8; ++e) VT[(8 * u + e) * 72 + pos] = (bf16)vr[e]; }
    if (th < 64) ((float*)(ws + WS_DEC))[(size_t)item * 64 + th] = __expf(cum[63 * 65 + th]);
    __syncthreads();
    bf16* LS = (bf16*)((unsigned char*)a.out + DO_L);
#pragma unroll
    for (int q2 = 0; q2 < 2; ++q2) { const int dvt = 2 * wv + q2;
#pragma unroll
      for (int dkt = 0; dkt < 4; ++dkt) { f32x4 acc = {0.f, 0.f, 0.f, 0.f};
#pragma unroll
        for (int ks = 0; ks < 2; ++ks) { const bf16x8 av = *(const LAS bf16x8*)(VT + (16 * dvt + fr) * 72 + 32 * ks + 8 * fq); const bf16x8 bv = *(const LAS bf16x8*)(KT + (16 * dkt + fr) * 72 + 32 * ks + 8 * fq); acc = MFMA16(av, bv, acc); }
#pragma unroll
        for (int i = 0; i < 4; ++i) { const float nb = __shfl_xor(acc[i], 1); if (!(fr & 1)) *(unsigned*)(LS + ((size_t)item * 128 + 16 * dvt + 4 * fq + i) * 64 + 16 * dkt + fr) = pk2(acc[i], nb); } } }
    __syncthreads();
}
__device__ __forceinline__ void gla_out_pair(int pair, const Args& a, LAS unsigned char* lds0, int tid, int wave, int lane) {
    unsigned char* ws = a.ws; const bf16* PROJ = (const bf16*)(ws + WS_PROJ);
    const int half = tid >> 8, th = tid & 255, tt = wave & 3, item = 2 * pair + half;
    LAS unsigned char* lds = lds0 + half * GL2_STRIDE;
    const int b = item >> 9, h = (item >> 7) & 3, c = item & 127, fr = lane & 15, fq = lane >> 4;
    LAS bf16* VT = (LAS bf16*)(lds + GL_VT); LAS float* cum = (LAS float*)(lds + GL_CUM); LAS float* tot = (LAS float*)(lds + GL_TOT);
    const bf16* LSp = (const bf16*)((const unsigned char*)a.out + DO_S); bf16x8 sfr[8][2];
#pragma unroll
    for (int j = 0; j < 8; ++j)
#pragma unroll
        for (int ks = 0; ks < 2; ++ks) sfr[j][ks] = *(const bf16x8*)(LSp + ((size_t)item * 128 + 16 * j + fr) * 64 + 32 * ks + 8 * fq);
    bf16x8 vrr[4], qrw[2]; u32x2 rwv[8];
#pragma unroll
    for (int it = 0; it < 4; ++it) { const int id = th + 256 * it; vrr[it] = *(const bf16x8*)(PROJ + ((size_t)b * T + 64 * c + (id >> 4)) * PLD + PC_VG + h * 128 + 8 * (id & 15)); }
    { const size_t rq_ = (size_t)b * T + 64 * c + 16 * tt + fr;
#pragma unroll
      for (int ks = 0; ks < 2; ++ks) qrw[ks] = *(const bf16x8*)(PROJ + rq_ * PLD + PC_QG + h * 64 + 32 * ks + 8 * fq);
#pragma unroll
      for (int j = 0; j < 8; ++j) rwv[j] = *(const u32x2*)(PROJ + rq_ * PLD + PC_RG + h * 128 + 16 * j + 4 * fq); }
    gla_cum2(cum, tot, (LAS float*)(lds + 47360), (const float*)(ws + WS_SMALL), a.in[9], a.in[10], b, h, c, th);
#pragma unroll
    for (int it = 0; it < 4; ++it) { const int id = th + 256 * it, s = id >> 4, u = id & 15; const bf16x8 vr = vrr[it]; const int pos = (s & 32) + perm32k(s & 31);
#pragma unroll
        for (int e = 0; e < 8; ++e) VT[(8 * u + e) * 72 + pos] = (bf16)vr[e]; }
    LAS bf16* KE = (LAS bf16*)(lds + GL_KT);
    { const int s = th >> 2, qd = th & 3; const bf16* kp = PROJ + ((size_t)b * T + 64 * c + s) * PLD + PC_KG + h * 64 + 16 * qd; const bf16x8 r0 = *(const bf16x8*)kp, r1 = *(const bf16x8*)(kp + 8);
      float f[16];
#pragma unroll
      for (int e = 0; e < 8; ++e) { f[e] = bf2f(r0[e]) * __expf(-cum[s * 65 + 16 * qd + e]); f[8 + e] = bf2f(r1[e]) * __expf(-cum[s * 65 + 16 * qd + 8 + e]); }
      *(LAS u32x4*)(KE + s * 72 + 16 * qd) = (u32x4){pk2(f[0], f[1]), pk2(f[2], f[3]), pk2(f[4], f[5]), pk2(f[6], f[7])};
      *(LAS u32x4*)(KE + s * 72 + 16 * qd + 8) = (u32x4){pk2(f[8], f[9]), pk2(f[10], f[11]), pk2(f[12], f[13]), pk2(f[14], f[15])}; }
    __syncthreads();
    const int tokq = 16 * tt + fr; const size_t rowq = (size_t)b * T + 64 * c + tokq;
    bf16x8 qf[2];
#pragma unroll
    for (int ks = 0; ks < 2; ++ks) { const bf16x8 raw = qrw[ks];
#pragma unroll
        for (int e = 0; e < 8; ++e) qf[ks][e] = (short)f2bf(bf2f(raw[e]) * __expf(cum[tokq * 65 + 32 * ks + 8 * fq + e])); }
    f32x4 at[4];
#pragma unroll
    for (int st = 0; st < 4; ++st) { at[st] = (f32x4){0.f, 0.f, 0.f, 0.f};
        if (st <= tt) { const int s = 16 * st + fr; bf16x8 kf[2];
#pragma unroll
            for (int ks = 0; ks < 2; ++ks) kf[ks] = *(const LAS bf16x8*)(KE + s * 72 + 32 * ks + 8 * fq);
            at[st] = MFMA16(kf[0], qf[0], at[st]); at[st] = MFMA16(kf[1], qf[1], at[st]);
            if (st == tt) {
#pragma unroll
                for (int i = 0; i < 4; ++i) if (4 * fq + i > fr) at[st][i] = 0.f; } } }
    bf16x8 pf[2];
#pragma unroll
    for (int k2 = 0; k2 < 2; ++k2) { const u32x4 w = {pk2(at[2 * k2][0], at[2 * k2][1]), pk2(at[2 * k2][2], at[2 * k2][3]), pk2(at[2 * k2 + 1][0], at[2 * k2 + 1][1]), pk2(at[2 * k2 + 1][2], at[2 * k2 + 1][3])}; pf[k2] = __builtin_bit_cast(bf16x8, w); }
    f32x4 o[8]; float ssq = 0.f;
#pragma unroll
    for (int j = 0; j < 8; ++j) { const int dv0 = 16 * j; f32x4 acc = {0.f, 0.f, 0.f, 0.f};
#pragma unroll
        for (int ks = 0; ks < 2; ++ks) acc = MFMA16(sfr[j][ks], qf[ks], acc);
#pragma unroll
        for (int k2 = 0; k2 < 2; ++k2) { const bf16x8 vf = *(const LAS bf16x8*)(VT + (dv0 + fr) * 72 + 32 * k2 + 8 * fq); acc = MFMA16(vf, pf[k2], acc); }
        o[j] = acc; ssq += (acc[0] * acc[0] + acc[1] * acc[1]) + (acc[2] * acc[2] + acc[3] * acc[3]); }
    ssq += __shfl_xor(ssq, 16); ssq += __shfl_xor(ssq, 32);
    const float rstd = rsqrtf(ssq * (1.f / 128.f) + EPS);
#pragma unroll
    for (int j = 0; j < 8; ++j) { const int dvb = 16 * j + 4 * fq; const f32x4 gn = *(const f32x4*)(a.in[11] + dvb); const bf16* rp = PROJ + rowq * PLD + PC_RG + h * 128 + dvb; bf16* op = (bf16*)((unsigned char*)a.out + DO_OB) + rowq * 512 + h * 128 + dvb;
        const u32x2 rw = rwv[j]; (void)rp; const float r0 = bflo(rw.x), r1 = bfhi(rw.x), r2 = bflo(rw.y), r3 = bfhi(rw.y);
        u32x2 w; w.x = pk2(o[j][0] * rstd * gn[0] * siluf_(r0), o[j][1] * rstd * gn[1] * siluf_(r1)); w.y = pk2(o[j][2] * rstd * gn[2] * siluf_(r2), o[j][3] * rstd * gn[3] * siluf_(r3));
        *(u32x2*)op = w; }
    __syncthreads();
}

__device__ __forceinline__ void gla_scan(unsigned char* ws, unsigned char* dout, LAS unsigned char* lds, int tid) {
    LAS float* sx = (LAS float*)lds;
    const int seg = tid >> 7, el = tid & 127;
    for (int e0 = blockIdx.x * 128; e0 < 8 * 128 * 32; e0 += gridDim.x * 128) { const int e = e0 + el;
        const int bh = e >> 12, dv = (e >> 5) & 127, dkp = e & 31;
        const size_t eo = (((size_t)bh * 128 * 128 + dv) * 64) / 2 + dkp; const unsigned* p = (const unsigned*)(dout + DO_L) + eo + (size_t)(32 * seg) * 4096; unsigned* ps = (unsigned*)(dout + DO_S) + eo + (size_t)(32 * seg) * 4096;
        const float* dp = (const float*)(ws + WS_DEC) + (size_t)bh * 128 * 64 + 2 * dkp + (32 * seg) * 64;
        float r0 = 0.f, r1 = 0.f, D0 = 1.f, D1 = 1.f;
#pragma unroll 16
        for (int c = 0; c < 32; ++c) { const unsigned w = p[(size_t)c * 4096]; const float d0 = dp[c * 64], d1 = dp[c * 64 + 1]; r0 = d0 * r0 + bflo(w); r1 = d1 * r1 + bfhi(w); D0 *= d0; D1 *= d1; }
        *(LAS f32x4*)(sx + (seg * 128 + el) * 4) = (f32x4){r0, r1, D0, D1};
        __syncthreads();
        r0 = 0.f; r1 = 0.f;
        for (int k = 0; k < seg; ++k) { const f32x4 v = *(const LAS f32x4*)(sx + (k * 128 + el) * 4); r0 = v[2] * r0 + v[0]; r1 = v[3] * r1 + v[1]; }
#pragma unroll 16
        for (int c = 0; c < 32; ++c) { const unsigned w = p[(size_t)c * 4096]; const float d0 = dp[c * 64], d1 = dp[c * 64 + 1]; ps[(size_t)c * 4096] = pk2(r0, r1); r0 = d0 * r0 + bflo(w); r1 = d1 * r1 + bfhi(w); }
        __syncthreads();
    }
}
constexpr int NT_TILE = 16384, NT_V = 8192, NT_TPS = 3, NT_R = 2 * NT_TPS, NS_WAVE = NT_R * NT_TILE, NS_WSZ = 2176, NS_UX = NS_WAVE + 8 * NS_WSZ, NS_JL = NS_UX + 128;
template <bool LOADV, class DescF, class CompF>
__device__ __forceinline__ void tile_loop(int n, DescF desc, CompF comp, LAS unsigned char* tb, int tid) {
    if (n <= 0) return;
#define NT_BAR() asm volatile("s_waitcnt lgkmcnt(0)\n\ts_barrier" ::: "memory")
    const int row = tid >> 3, unit = tid & 7, ns = (n + NT_TPS - 1) / NT_TPS;
    u32x4 kr[NT_TPS], vr[NT_TPS];
#define NT_GL(j) do { _Pragma("unroll") for (int u_ = 0; u_ < NT_TPS; ++u_) { int i_ = NT_TPS * (j) + u_; i_ = i_ < n ? i_ : n - 1; const bf16 *Kg_, *Vg_; int kp_, vp_; desc(i_, Kg_, kp_, Vg_, vp_); \
        kr[u_] = *(const u32x4*)(Kg_ + (size_t)row * kp_ + unit * 8); if (LOADV) vr[u_] = *(const u32x4*)(Vg_ + (size_t)row * vp_ + unit * 8); else vr[u_] = (u32x4){0u, 0u, 0u, 0u}; } } while (0)
#define NT_LS(half) do { _Pragma("unroll") for (int u_ = 0; u_ < NT_TPS; ++u_) { LAS unsigned char* p_ = tb + ((half) * NT_TPS + u_) * NT_TILE + row * 128 + ((unit ^ (row & 7)) * 16); \
        *(LAS u32x4*)p_ = kr[u_]; if (LOADV) *(LAS u32x4*)(p_ + NT_V) = vr[u_]; } } while (0)
    NT_GL(0); NT_LS(0);
    NT_BAR();
    for (int j = 0; j < ns; ++j) {
        if (j + 1 < ns) NT_GL(j + 1);
#pragma unroll
        for (int u = 0; u < NT_TPS; ++u) { const int i = NT_TPS * j + u; if (i < n) comp(i, tb + ((j & 1) * NT_TPS + u) * NT_TILE); }
        if (j + 1 < ns) NT_LS((j + 1) & 1);
        NT_BAR();
    }
#undef NT_GL
#undef NT_BAR
#undef NT_LS
}
__device__ __forceinline__ void lds_scores(f32x4 (&s)[4], const LAS unsigned char* buf, const bf16x8 (&q)[2], int fr, int fq, float cinit = 0.f) {
    const f32x4 c4 = {cinit, cinit, cinit, cinit};
#pragma unroll
    for (int h2 = 0; h2 < 2; ++h2) { bf16x8 kf[2][2];
#pragma unroll
        for (int t2 = 0; t2 < 2; ++t2) { const LAS unsigned char* kp = buf + (16 * (2 * h2 + t2) + fr) * 128; kf[t2][0] = *(const LAS bf16x8*)(kp + ((fq ^ (fr & 7)) * 16)); kf[t2][1] = *(const LAS bf16x8*)(kp + (((fq + 4) ^ (fr & 7)) * 16)); }
        asm volatile("" ::: "memory");
        __builtin_amdgcn_s_setprio(1);
#pragma unroll
        for (int t2 = 0; t2 < 2; ++t2) { s[2 * h2 + t2] = MFMA16(kf[t2][0], q[0], c4); s[2 * h2 + t2] = MFMA16(kf[t2][1], q[1], s[2 * h2 + t2]); }
        __builtin_amdgcn_s_setprio(0); }
}
__device__ __forceinline__ void lds_pv(f32x4 (&O)[4], const LAS unsigned char* buf, const f32x4 (&p)[4], int fr, int fq) {
    bf16x8 pf[2];
#pragma unroll
    for (int k2 = 0; k2 < 2; ++k2) { const u32x4 w = {pk2(p[2 * k2][0], p[2 * k2][1]), pk2(p[2 * k2][2], p[2 * k2][3]), pk2(p[2 * k2 + 1][0], p[2 * k2 + 1][1]), pk2(p[2 * k2 + 1][2], p[2 * k2 + 1][3])}; pf[k2] = __builtin_bit_cast(bf16x8, w); }
#pragma unroll
    for (int h2 = 0; h2 < 2; ++h2) { bf16x8 vf[2][2];
#pragma unroll
        for (int d2 = 0; d2 < 2; ++d2) { const LAS unsigned char* vp = buf + NT_V + (16 * (2 * h2 + d2) + fr) * 128; vf[d2][0] = *(const LAS bf16x8*)(vp + ((fq ^ (fr & 7)) * 16)); vf[d2][1] = *(const LAS bf16x8*)(vp + (((fq + 4) ^ (fr & 7)) * 16)); }
        asm volatile("" ::: "memory");
        __builtin_amdgcn_s_setprio(1);
#pragma unroll
        for (int d2 = 0; d2 < 2; ++d2) { O[2 * h2 + d2] = MFMA16(vf[d2][0], pf[0], O[2 * h2 + d2]); O[2 * h2 + d2] = MFMA16(vf[d2][1], pf[1], O[2 * h2 + d2]); }
        __builtin_amdgcn_s_setprio(0); }
}
template <int MODE, class MaskF>
__device__ __forceinline__ void attn_tile(const LAS unsigned char* buf, const bf16x8 (&q)[2], float& m, bool& st, float& l, f32x4 (&O)[4], bool rowsel, MaskF mask, int fr, int fq) {
    f32x4 s[4]; lds_scores(s, buf, q, fr, fq, (MODE == 1 && !rowsel) ? -INFINITY : -m);
    if (MODE == 2) {
#pragma unroll
        for (int t = 0; t < 4; ++t)
#pragma unroll
            for (int i = 0; i < 4; ++i) s[t][i] = mask(16 * t + 4 * fq + i) ? s[t][i] : -INFINITY; }
    float mx = max16f_(s);
    if (__builtin_amdgcn_ballot_w64(mx > 8.f || (!st && mx > -INFINITY)) != 0ull) {
        mx = fmaxf(mx, __shfl_xor(mx, 16)); mx = fmaxf(mx, __shfl_xor(mx, 32));
        const float dl = st ? fmaxf(mx, 0.f) : (mx > -INFINITY ? mx : 0.f), alpha = st ? __builtin_amdgcn_exp2f(-dl) : 1.f; st = st || (mx > -INFINITY); m += dl; l *= alpha;
#pragma unroll
        for (int dt = 0; dt < 4; ++dt) O[dt] = O[dt] * alpha;
#pragma unroll
        for (int t = 0; t < 4; ++t)
#pragma unroll
            for (int i = 0; i < 4; ++i) s[t][i] -= dl; }
    float rs = 0.f;
#pragma unroll
    for (int t = 0; t < 4; ++t)
#pragma unroll
        for (int i = 0; i < 4; ++i) { const float p = __builtin_amdgcn_exp2f(s[t][i]); s[t][i] = p; rs += p; }
    l += rs;
    lds_pv(O, buf, s, fr, fq);
}
__device__ __forceinline__ void nsa_block_item(int idx, unsigned char* ws, bf16* OA, LAS unsigned char* lds, int tid, int wave, int lane) {
    const bf16* PROJ = (const bf16*)(ws + WS_PROJ); const bf16* KROT = (const bf16*)(ws + WS_KROT);
    const int fr = lane & 15, fq = lane >> 4;
    const int ti = 255 - (idx >> 2), bg = idx & 3, b = bg >> 1, g = bg & 1, tb0 = 32 * ti, t0 = tb0 + 4 * wave;
    const int tokj = fr >> 2, hh = fr & 3, trow = t0 + tokj; const size_t grow = (size_t)b * T + trow;
    LAS unsigned char* wl = lds + NS_WAVE + wave * NS_WSZ;
    LAS float* imp = (LAS float*)wl; LAS unsigned* selw = (LAS unsigned*)(wl + 2112);
    LAS unsigned* ux = (LAS unsigned*)(lds + NS_UX); LAS unsigned char* jl = lds + NS_JL;
    bf16x8 qraw[2], qrot[2];
#pragma unroll
    for (int ks = 0; ks < 2; ++ks) { qraw[ks] = *(const bf16x8*)(PROJ + grow * PLD + PC_QN + (g * 4 + hh) * 64 + 32 * ks + 8 * fq);
        qrot[ks] = qraw[ks]; }
    if (fq < 2) qrot[0] = *(const bf16x8*)((const bf16*)(ws + WS_QROT) + grow * 128 + (g * 4 + hh) * 16 + 8 * fq);
    for (int i = lane; i < 528; i += 64) imp[i] = 0.f;
    f32x4 Ot[4];
#pragma unroll
    for (int dt = 0; dt < 4; ++dt) Ot[dt] = (f32x4){0.f, 0.f, 0.f, 0.f};
    const float* gp = (const float*)(ws + WS_SMALL) + grow * 64 + (g * 4 + hh) * 3;
    {
        const int nvr = trow >= 31 ? ((trow - 31) >> 4) + 1 : 0; const int nv0 = t0 >= 31 ? ((t0 - 31) >> 4) + 1 : 0; const int tl = tb0 + 31; const int nvm = tl >= 31 ? ((tl - 31) >> 4) + 1 : 0; const int ntile = (nvm + 63) >> 6;
        const bf16* Kc = (const bf16*)(ws + WS_KCMP) + (size_t)bg * 512 * 64; const bf16* Vc = (const bf16*)(ws + WS_VCMPT) + (size_t)bg * 64 * 512;
        auto desc = [&](int i, const bf16*& Kg, int& kp, const bf16*& Vg, int& vp) { Kg = Kc + (size_t)(64 * i) * 64; kp = 64; Vg = Vc + 64 * i; vp = 512; };
        float m = NEGB, l = 0.f;
        tile_loop<false>(ntile, desc, [&](int kt, const LAS unsigned char* buf) {
            f32x4 s[4]; lds_scores(s, buf, qraw, fr, fq);
            if (64 * kt + 64 > nv0) {
#pragma unroll
                for (int t = 0; t < 4; ++t)
#pragma unroll
                    for (int i = 0; i < 4; ++i) s[t][i] = (64 * kt + 16 * t + 4 * fq + i) < nvr ? s[t][i] : -INFINITY; }
            float mx = max16f_(s);
            if (__builtin_amdgcn_ballot_w64(mx > m + 8.f) != 0ull) { mx = fmaxf(mx, __shfl_xor(mx, 16)); mx = fmaxf(mx, __shfl_xor(mx, 32)); const float mn = fmaxf(m, mx); l *= __builtin_amdgcn_exp2f(m - mn); m = mn; }
            float rs = 0.f;
#pragma unroll
            for (int t = 0; t < 4; ++t)
#pragma unroll
                for (int i = 0; i < 4; ++i) rs += __builtin_amdgcn_exp2f(s[t][i] - m);
            l += rs; }, lds, tid);
        l += __shfl_xor(l, 16); l += __shfl_xor(l, 32);
        const float invl = l > 0.f ? 1.f / l : 0.f;
        f32x4 Oc[4];
#pragma unroll
        for (int dt = 0; dt < 4; ++dt) Oc[dt] = (f32x4){0.f, 0.f, 0.f, 0.f};
        tile_loop<true>(ntile, desc, [&](int kt, const LAS unsigned char* buf) {
            f32x4 s[4]; lds_scores(s, buf, qraw, fr, fq);
#pragma unroll
            for (int t = 0; t < 4; ++t)
#pragma unroll
                for (int i = 0; i < 4; ++i) { const bool okk = (64 * kt + 16 * t + 4 * fq + i) < nvr; s[t][i] = okk ? __builtin_amdgcn_exp2f(s[t][i] - m) * invl : 0.f; }
            lds_pv(Oc, buf, s, fr, fq);
#pragma unroll
            for (int t = 0; t < 4; ++t) { float s3 = (s[t][0] + s[t][1]) + (s[t][2] + s[t][3]), p3 = s[t][3];
                s3 += __shfl_xor(s3, 1); s3 += __shfl_xor(s3, 2); p3 += __shfl_xor(p3, 1); p3 += __shfl_xor(p3, 2);
                const int q = 16 * kt + 4 * t + fq;
                if (hh == 0) imp[tokj * 132 + q] += s3;
                asm volatile("s_waitcnt lgkmcnt(0)" ::: "memory");
                if (hh == 0) imp[tokj * 132 + q + 1] += p3;
                asm volatile("s_waitcnt lgkmcnt(0)" ::: "memory"); } }, lds, tid);
        const float gc = sigmoidf_(gp[0]);
#pragma unroll
        for (int dt = 0; dt < 4; ++dt) Ot[dt] = Oc[dt] * gc;
    }
    const int cur = tb0 >> 6;
    { const int tok = lane >> 4, sub = lane & 15; unsigned key[8]; bool cand[8];
#define ROW_SUM(x) do { x += __builtin_amdgcn_update_dpp(0, x, 0xB1, 0xF, 0xF, true); x += __builtin_amdgcn_update_dpp(0, x, 0x4E, 0xF, 0xF, true); \
        x += __builtin_amdgcn_update_dpp(0, x, 0x141, 0xF, 0xF, true); x += __builtin_amdgcn_update_dpp(0, x, 0x140, 0xF, 0xF, true); } while (0)
#pragma unroll
        for (int e = 0; e < 8; ++e) { const int j = 8 * sub + e; cand[e] = (j >= 1 && j <= cur - 2); key[e] = cand[e] ? __float_as_uint(imp[tok * 132 + j]) : 0u; }
        unsigned selb = 0;
        if (cur - 2 > 13) {
            unsigned tau = 0u;
            for (int bit = 30; bit >= 0; --bit) { const unsigned t = tau | (1u << bit); int c = 0;
#pragma unroll
                for (int e = 0; e < 8; ++e) c += (key[e] >= t) ? 1 : 0;
                ROW_SUM(c); tau = (c >= 13) ? t : tau; }
            int cg = 0, tc = 0;
#pragma unroll
            for (int e = 0; e < 8; ++e) { cg += (cand[e] && key[e] > tau) ? 1 : 0; tc += (cand[e] && key[e] == tau) ? 1 : 0; }
            ROW_SUM(cg); const int need = 13 - cg;
            int inc = tc; inc += __builtin_amdgcn_update_dpp(0, inc, 0x111, 0xF, 0xF, true); inc += __builtin_amdgcn_update_dpp(0, inc, 0x112, 0xF, 0xF, true);
            inc += __builtin_amdgcn_update_dpp(0, inc, 0x114, 0xF, 0xF, true); inc += __builtin_amdgcn_update_dpp(0, inc, 0x118, 0xF, 0xF, true);
            int before = inc - tc;
#pragma unroll
            for (int e = 0; e < 8; ++e) { const bool tie = cand[e] && key[e] == tau; const bool sl = cand[e] && (key[e] > tau || (tie && before < need)); before += tie ? 1 : 0; selb |= sl ? (1u << e) : 0u; }
        } else {
#pragma unroll
            for (int e = 0; e < 8; ++e) selb |= cand[e] ? (1u << e) : 0u; }
#undef ROW_SUM
        unsigned bits = 0;
#pragma unroll
        for (int e = 0; e < 8; ++e) { const int j = 8 * sub + e; const bool sel = (j <= cur) && (j == 0 || j >= cur - 1 || ((selb >> e) & 1u)); bits |= sel ? (1u << e) : 0u; }
        ((LAS unsigned char*)selw)[tok * 16 + sub] = (unsigned char)bits; }
    asm volatile("s_waitcnt lgkmcnt(0)" ::: "memory");
    unsigned sw[4], un[4];
#pragma unroll
    for (int w = 0; w < 4; ++w) { sw[w] = selw[tokj * 4 + w]; un[w] = __builtin_amdgcn_readfirstlane(selw[w] | selw[4 + w] | selw[8 + w] | selw[12 + w]); }
    if (lane == 0) { ux[wave * 4 + 0] = un[0]; ux[wave * 4 + 1] = un[1]; ux[wave * 4 + 2] = un[2]; ux[wave * 4 + 3] = un[3]; }
    __syncthreads();
    unsigned U[4];
#pragma unroll
    for (int w = 0; w < 4; ++w) { unsigned u = 0;
#pragma unroll
        for (int v2 = 0; v2 < 8; ++v2) u |= ux[v2 * 4 + w];
        U[w] = __builtin_amdgcn_readfirstlane(u); }
    const int nsl = __builtin_popcount(U[0]) + __builtin_popcount(U[1]) + __builtin_popcount(U[2]) + __builtin_popcount(U[3]);
    if (tid < 128) { const int w = tid >> 5, bit = tid & 31; const unsigned uw = w == 0 ? U[0] : w == 1 ? U[1] : w == 2 ? U[2] : U[3];
        if ((uw >> bit) & 1u) { int pos = __builtin_popcount(uw & ((1u << bit) - 1u)); if (w > 0) pos += __builtin_popcount(U[0]); if (w > 1) pos += __builtin_popcount(U[1]); if (w > 2) pos += __builtin_popcount(U[2]); jl[pos] = (unsigned char)tid; } }
    __syncthreads();
    {
        const bf16* Ks = KROT + ((size_t)g * M + (size_t)b * T) * 64; const bf16* Vs = (const bf16*)(ws + WS_VTS) + (size_t)bg * 128 * 4096;
        float m = 0.f, l = 0.f; bool st = false; f32x4 Os[4];
#pragma unroll
        for (int dt = 0; dt < 4; ++dt) Os[dt] = (f32x4){0.f, 0.f, 0.f, 0.f};
        tile_loop<true>(nsl, [&](int i, const bf16*& Kg, int& kp, const bf16*& Vg, int& vp) { const int j = jl[i]; Kg = Ks + (size_t)(64 * j) * 64; kp = 64; Vg = Vs + (size_t)j * 4096; vp = 64; },
            [&](int i, const LAS unsigned char* buf) { const int j = __builtin_amdgcn_readfirstlane((int)jl[i]); const int w = j >> 5, bit = j & 31;
                const unsigned uw = w == 0 ? un[0] : w == 1 ? un[1] : w == 2 ? un[2] : un[3];
                if (!((uw >> bit) & 1u)) return;
                const unsigned swv = w == 0 ? sw[0] : w == 1 ? sw[1] : w == 2 ? sw[2] : sw[3]; const bool rowsel = (swv >> bit) & 1u;
                if (j < cur) attn_tile<1>(buf, qrot, m, st, l, Os, rowsel, [&](int) { return true; }, fr, fq);
                else attn_tile<2>(buf, qrot, m, st, l, Os, rowsel, [&](int kk) { return rowsel && (64 * j + kk <= trow); }, fr, fq); }, lds, tid);
        l += __shfl_xor(l, 16); l += __shfl_xor(l, 32);
        const float gs = sigmoidf_(gp[1]) * (l > 0.f ? 1.f / l : 0.f);
#pragma unroll
        for (int dt = 0; dt < 4; ++dt) Ot[dt] += Os[dt] * gs;
    }
    {
        const bf16* Kw = KROT + ((size_t)(2 + g) * M + (size_t)b * T) * 64; const bf16* Vw = (const bf16*)(ws + WS_VTW) + (size_t)bg * 128 * 4096;
        float m = 0.f, l = 0.f; bool st = false; f32x4 Ow[4];
#pragma unroll
        for (int dt = 0; dt < 4; ++dt) Ow[dt] = (f32x4){0.f, 0.f, 0.f, 0.f};
        const int jlo = (tb0 > 511 ? tb0 - 511 : 0) >> 6, jhi = (tb0 + 31) >> 6;
        tile_loop<true>(jhi - jlo + 1, [&](int i, const bf16*& Kg, int& kp, const bf16*& Vg, int& vp) { const int j = jlo + i; Kg = Kw + (size_t)(64 * j) * 64; kp = 64; Vg = Vw + (size_t)j * 4096; vp = 64; },
            [&](int i, const LAS unsigned char* buf) { const int j = jlo + i;
                if (64 * j + 63 + 511 < t0 || 64 * j > t0 + 3) return;
                if (64 * j + 511 >= t0 + 3 && 64 * j + 63 <= t0) attn_tile<0>(buf, qrot, m, st, l, Ow, true, [&](int) { return true; }, fr, fq);
                else attn_tile<2>(buf, qrot, m, st, l, Ow, true, [&](int kk) { const int key = 64 * j + kk; return key <= trow && key + 511 >= trow; }, fr, fq); }, lds, tid);
        l += __shfl_xor(l, 16); l += __shfl_xor(l, 32);
        const float gw = sigmoidf_(gp[2]) * (l > 0.f ? 1.f / l : 0.f);
#pragma unroll
        for (int dt = 0; dt < 4; ++dt) Ot[dt] += Ow[dt] * gw;
    }
#pragma unroll
    for (int dt = 0; dt < 4; ++dt) { u32x2 w; w.x = pk2(Ot[dt][0], Ot[dt][1]); w.y = pk2(Ot[dt][2], Ot[dt][3]); *(u32x2*)(OA + grow * 512 + (g * 4 + hh) * 64 + 16 * dt + 4 * fq) = w; }
    __syncthreads();
}

#define XB_TMO      128
#define XB_XCNT(j)  (256  + 64 * (j))
#define XB_XSUB(j)  (1280 + 64 * (j))
#define XB_XGEN(j)  (2304 + 64 * (j))
#define XB_TOP      3328
#define XB_TOPGEN   3392
#define XCD_BAR_WORDS 3456
#define XB_SPIN_CAP (1u << 18)

__device__ __forceinline__ unsigned xb_ld(unsigned* p)              { return __hip_atomic_load(p, __ATOMIC_RELAXED, __HIP_MEMORY_SCOPE_AGENT); }
__device__ __forceinline__ unsigned xb_add(unsigned* p, unsigned v) { return __hip_atomic_fetch_add(p, v, __ATOMIC_RELAXED, __HIP_MEMORY_SCOPE_AGENT); }
__device__ __forceinline__ unsigned xb_xcc_id() { return (unsigned)__builtin_amdgcn_s_getreg((3 << 11) | 20) & 0xFu; }
#define XB_SPIN(cond, bar) do { unsigned _sp = 0; while (cond) { __builtin_amdgcn_s_sleep(1); \
    if ((++_sp & 255u) == 0u) { if (xb_ld(&(bar)[XB_TMO])) break; if (_sp > XB_SPIN_CAP) { atomicAdd(&(bar)[XB_TMO], 1u); break; } } } } while (0)

struct XcdBarrier {
    unsigned* bar; unsigned x;
    volatile LAS unsigned* st;
};

__device__ __forceinline__ XcdBarrier xcd_barrier_post(unsigned* bar, volatile LAS unsigned* st) {
    XcdBarrier b; b.bar = bar; b.x = xb_xcc_id(); b.st = st;
    if (threadIdx.x == 0) (void)xb_add(&bar[XB_XCNT(b.x)], 1u);
    return b;
}
__device__ __forceinline__ void xcd_barrier_complete(unsigned* bar, unsigned x, unsigned& nloc, unsigned& nx) {
    const unsigned G = gridDim.x * gridDim.y * gridDim.z;
    unsigned sum, cnt, mine, sp = 0u;
    for (;;) {
        sum = 0u; cnt = 0u; mine = 0u;
#pragma unroll
        for (unsigned j = 0; j < 16; ++j) { const unsigned c = xb_ld(&bar[XB_XCNT(j)]); sum += c; cnt += (c > 0u) ? 1u : 0u; mine = (j == x) ? c : mine; }
        if (sum == G) break;
        __builtin_amdgcn_s_sleep(1);
        if ((++sp & 255u) == 0u) { if (xb_ld(&bar[XB_TMO])) break; if (sp > XB_SPIN_CAP) { atomicAdd(&bar[XB_TMO], 1u); break; } }
    }
    nloc = mine > 0u ? mine : 1u; nx = cnt > 0u ? cnt : 1u;
}

__device__ __forceinline__ void xcd_barrier(const XcdBarrier& b) {
    asm volatile("s_waitcnt vmcnt(0)" ::: "memory");
    __syncthreads();
    if (threadIdx.x == 0) {
        unsigned* bar = b.bar;
        __builtin_amdgcn_s_waitcnt(0);
        unsigned nloc = b.st[0], nx = b.st[1];
        if (nloc == 0u) { xcd_barrier_complete(bar, b.x, nloc, nx); b.st[0] = nloc; b.st[1] = nx; }
        const unsigned old = xb_add(&bar[XB_XSUB(b.x)], 1u);
        const unsigned gen = old / nloc;
        if (old + 1u == (gen + 1u) * nloc) {
            __builtin_amdgcn_fence(__ATOMIC_RELEASE, "agent");
            asm volatile("s_waitcnt vmcnt(0)" ::: "memory");
            const unsigned og = xb_add(&bar[XB_TOP], 1u);
            const unsigned tg = og / nx;
            if (og + 1u == (tg + 1u) * nx) xb_add(&bar[XB_TOPGEN], 1u);
            else XB_SPIN(xb_ld(&bar[XB_TOPGEN]) == tg, bar);
            __builtin_amdgcn_fence(__ATOMIC_ACQUIRE, "agent");
            xb_add(&bar[XB_XGEN(b.x)], 1u);
            asm volatile("s_waitcnt vmcnt(0)" ::: "memory");
        } else {
            XB_SPIN(xb_ld(&bar[XB_XGEN(b.x)]) == gen, bar);
            __builtin_amdgcn_fence(__ATOMIC_ACQUIRE, "agent");
            asm volatile("s_waitcnt vmcnt(0)" ::: "memory");
        }
    }
    __syncthreads();
}

__global__ void __launch_bounds__(NTHR, 2) fwd_megakernel(Args a) {
    extern __shared__ __attribute__((aligned(16))) unsigned char lds_raw[];
    cg::grid_group grid = cg::this_grid();
    unsigned bar_k_ = 0;
#define GRID_SYNC() do { asm volatile("s_waitcnt vmcnt(0) lgkmcnt(0)" ::: "memory"); __syncthreads(); \
    if (threadIdx.x == 0) { unsigned* bw_ = (unsigned*)(a.ws + WS_CTL) + 16384; const unsigned G_ = gridDim.x, k1_ = bar_k_ + 1u; \
        __builtin_amdgcn_fence(__ATOMIC_RELEASE, "agent"); asm volatile("s_waitcnt vmcnt(0)" ::: "memory"); \
        if (G_ % 16u) { __hip_atomic_fetch_add(bw_, 1u, __ATOMIC_RELAXED, __HIP_MEMORY_SCOPE_AGENT); while (__hip_atomic_load(bw_, __ATOMIC_RELAXED, __HIP_MEMORY_SCOPE_AGENT) < k1_ * G_) __builtin_amdgcn_s_sleep(1); } \
        else { const unsigned grp_ = blockIdx.x >> 4; unsigned* gc_ = bw_ + 64u * (1u + grp_); unsigned* gr_ = bw_ + 64u * (33u + grp_); \
            if (__hip_atomic_fetch_add(gc_, 1u, __ATOMIC_RELAXED, __HIP_MEMORY_SCOPE_AGENT) == k1_ * 16u - 1u) { __hip_atomic_fetch_add(bw_, 1u, __ATOMIC_RELAXED, __HIP_MEMORY_SCOPE_AGENT); \
                while (__hip_atomic_load(bw_, __ATOMIC_RELAXED, __HIP_MEMORY_SCOPE_AGENT) < k1_ * (G_ >> 4)) __builtin_amdgcn_s_sleep(1); \
                __hip_atomic_store(gr_, k1_, __ATOMIC_RELAXED, __HIP_MEMORY_SCOPE_AGENT); } \
            else { while (__hip_atomic_load(gr_, __ATOMIC_RELAXED, __HIP_MEMORY_SCOPE_AGENT) < k1_) __builtin_amdgcn_s_sleep(1); } } \
        __builtin_amdgcn_fence(__ATOMIC_ACQUIRE, "agent"); asm volatile("s_waitcnt vmcnt(0)" ::: "memory"); } \
    ++bar_k_; __syncthreads(); } while (0)
    grid.sync();
    LAS unsigned char* lds = (LAS unsigned char*)lds_raw;
    unsigned char* ws = a.ws;
    const int tid = threadIdx.x, lane = tid & 63, wave = __builtin_amdgcn_readfirstlane(tid >> 6);
    const int G = gridDim.x, bx = blockIdx.x;
    bf16* PROJ = (bf16*)(ws + WS_PROJ);
    float* ROWSQ1 = (float*)(ws + WS_RSQ1); float* ROWSQ2 = (float*)(ws + WS_RSQ2);

    { LAS unsigned* z_ = (LAS unsigned*)(lds + 131072 + 64); if (tid < 2) z_[tid] = 0u; }
    __syncthreads();
    int vb = bx;
    { LAS unsigned* cw = (LAS unsigned*)(lds + 131072);
      if (tid == 0) { const unsigned x = (unsigned)__builtin_amdgcn_s_getreg((3 << 11) | 20) & 0xFu; const unsigned r = __hip_atomic_fetch_add((unsigned*)(ws + WS_CTL) + 64 + 64 * x, 1u, __ATOMIC_RELAXED, __HIP_MEMORY_SCOPE_AGENT);
          cw[0] = (x < 8u && r < (unsigned)(G / 8) && (G % 8) == 0) ? (r * 8u + x) : 0xffffffffu; }
      __syncthreads();
      const unsigned v = cw[0]; vb = (v == 0xffffffffu) ? -1 : (int)v; }
    bf16* OA = (bf16*)((unsigned char*)a.out + DO_OA); bf16* OB = (bf16*)((unsigned char*)a.out + DO_OB);
#ifndef REPEAT_P
#define REPEAT_P -1
#endif
#define PHASE_REP(k) for (int rep_ = 0; rep_ < ((REPEAT_P == (k)) ? 2 : 1); ++rep_)
    p0_prologue(a, lds, wave, lane);
    if (vb < 0) { if (tid == 0) __hip_atomic_fetch_add((unsigned*)(ws + WS_CTL) + 32, 1u, __ATOMIC_RELAXED, __HIP_MEMORY_SCOPE_AGENT); }
    GRID_SYNC();
    if (__hip_atomic_load((unsigned*)(ws + WS_CTL) + 32, __ATOMIC_RELAXED, __HIP_MEMORY_SCOPE_AGENT) != 0u) vb = bx;
    PHASE_REP(1) { pg8::Gemm g{(const bf16*)(ws + WS_XN), (const bf16*)(ws + WS_WIN), M, NIN, D, D}; pg8::StaticOrder S; S.init(M, NIN, G, vb);
      EpiProj E{PROJ, (float*)(ws + WS_SMALL), (bf16*)(ws + WS_CSRC)};
      pg8::gemm_phase<EpiProj, pg8::StaticOrder, true, true>(lds, g, S, E);
    GRID_SYNC(); }
    PHASE_REP(2) {
    { const int vv_ = vb >= 0 ? vb : bx; const int grp_ = (vv_ & 7) * (G / 32) + (vv_ >> 5), sub_ = (vv_ >> 3) & 3;
      if (G == 256) compress_item(grp_, sub_, ws, lds, wave, lane); else if (bx < 64) for (int q_ = 0; q_ < 4; ++q_) compress_item(bx, q_, ws, lds, wave, lane); }
    for (int it = bx; it < 512; it += G) gla_local_pair(it, a, lds, tid, wave, lane);
    for (int it = (G - 1 - bx) * NWAVES + wave; it < 256 * 2; it += G * NWAVES) p2a_item(it, ws, lds + wave * 18432, lane);
    for (int it = bx * NWAVES + wave; it < M / 8; it += G * NWAVES) rope_item(it, ws, lane);
    GRID_SYNC(); }
    PHASE_REP(3) {
    gla_scan(ws, (unsigned char*)a.out, lds, tid);
    __syncthreads();
    { const int vv_ = vb >= 0 ? vb : bx; const int xcc_ = vv_ & 7, q_ = ((xcc_ >> 2) * (G / 8) + (vv_ >> 3)), nq_ = 2 * (G / 8);
      for (int r_ = 0; r_ * nq_ < 256; ++r_) { const int o_ = (r_ & 1) ? (nq_ - 1 - q_) : q_; const int tr_ = r_ * nq_ + o_; if (tr_ >= 256) continue;
        const int idx = (tr_ << 2) | (xcc_ & 3);
        nsa_block_item(idx, ws, OA, lds, tid, wave, lane); } }
    GRID_SYNC(); }
    PHASE_REP(4) {
    for (int it = bx; it < 512; it += G) gla_out_pair(it, a, lds, tid, wave, lane);
    GRID_SYNC(); }
    PHASE_REP(5) {
    { pg8::Gemm g{OA, (const bf16*)(ws + WS_WUPA), 2 * M, 2 * D, 512, 512}; UpOrder S; S.so.init(M, D, G, vb);
      EpiUp2 E{PROJ, PROJ, PLD};
      pg8::gemm_phase<EpiUp2, UpOrder, true, true>(lds, g, S, E); }
    { pg8::StaticOrder S; S.init(M, D, G, vb); pg8::Unit u; S.next(0, u);
      asm volatile("s_waitcnt vmcnt(0) lgkmcnt(0)" ::: "memory"); __syncthreads();
      if (tid == 0) { __builtin_amdgcn_fence(__ATOMIC_RELEASE, "agent"); asm volatile("s_waitcnt vmcnt(0)" ::: "memory");
          unsigned* c_ = (unsigned*)(ws + WS_CTL) + 12288 + 64 * u.pm; __hip_atomic_fetch_add(c_, 1u, __ATOMIC_RELAXED, __HIP_MEMORY_SCOPE_AGENT);
          while (__hip_atomic_load(c_, __ATOMIC_RELAXED, __HIP_MEMORY_SCOPE_AGENT) < 4u) __builtin_amdgcn_s_sleep(1);
          __builtin_amdgcn_fence(__ATOMIC_ACQUIRE, "agent"); asm volatile("s_waitcnt vmcnt(0)" ::: "memory"); }
      __syncthreads(); } }
    PHASE_REP(6) {
    { pg8::Gemm g{PROJ, (const bf16*)(ws + WS_WOUT), M, D, D, PLD}; pg8::StaticOrder S; S.init(M, D, G, vb);
      EpiRes<true> E{a.in[0], a.out, (bf16*)(ws + WS_XB), ROWSQ1};
      pg8::gemm_phase<EpiRes<true>, pg8::StaticOrder, false, true>(lds, g, S, E); }
    GRID_SYNC(); }
    PHASE_REP(7) {
    { pg8::Gemm g{(const bf16*)(ws + WS_XB), (const bf16*)(ws + WS_WGU), M, NGU, D, D}; pg8::StaticOrder S; S.init(M, NGU, G, vb);
      EpiFfn E{(bf16*)(ws + WS_H), ROWSQ1};
      pg8::gemm_phase<EpiFfn, pg8::StaticOrder, true, true>(lds, g, S, E); }
    GRID_SYNC(); }
    { pg8::Gemm g{(const bf16*)(ws + WS_H), (const bf16*)(ws + WS_WDN), M, D, DFF, DFF}; pg8::StaticOrder S; S.init(M, D, G, vb);
      EpiFinal E{(const bf16*)(ws + WS_XB), a.out, ROWSQ2, (unsigned*)(ws + WS_CTL) + 8192, a.in[19]};
      pg8::gemm_phase<EpiFinal, pg8::StaticOrder, false, true>(lds, g, S, E); }
}

extern "C" void kernel_launch(void* const* d_in, const int* in_sizes, int n_in, void* d_out, int out_size, void* d_ws, size_t ws_size, hipStream_t stream) {
    static int grid = 0;
    if (grid == 0) {
        if (n_in != 20 || in_sizes[0] != M * D || out_size != M * D || ws_size < WS_END) { fprintf(stderr, "kernel_launch: unexpected shapes (n_in %d, in0 %d, out %d, ws %zu)\n", n_in, n_in > 0 ? in_sizes[0] : -1, out_size, ws_size); grid = -1; return; }
        int dev = 0, cus = 0, per_cu = 0;
        hipGetDevice(&dev); hipDeviceGetAttribute(&cus, hipDeviceAttributeMultiprocessorCount, dev);
        hipFuncSetAttribute((const void*)fwd_megakernel, hipFuncAttributeMaxDynamicSharedMemorySize, LDS_BYTES);
        hipOccupancyMaxActiveBlocksPerMultiprocessor(&per_cu, (const void*)fwd_megakernel, NTHR, LDS_BYTES);
        if (per_cu < 1) { fprintf(stderr, "kernel_launch: occupancy query says %d blocks per CU\n", per_cu); per_cu = 1; }
        (void)hipGetLastError();
        grid = cus * per_cu; if (grid > 256) grid = 256;
        if (grid != 256) { fprintf(stderr, "kernel_launch: this kernel needs exactly 256 co-resident workgroups (one 256x256 output tile per workgroup in the fused epilogues); the device offers %d; nothing launched\n", grid); grid = -1; return; }
    }
    if (grid < 0) return;
    (void)hipMemsetAsync((char*)d_ws + WS_CTL, 0, 98304, stream);
    Args a{};
    for (int i = 0; i < 20; ++i) a.in[i] = (const float*)d_in[i];
    a.out = (float*)d_out; a.ws = (unsigned char*)d_ws;
    void* args[] = {&a};
    hipError_t e = hipLaunchCooperativeKernel((const void*)fwd_megakernel, dim3(grid), dim3(NTHR), args, LDS_BYTES, stream);
    if (e != hipSuccess) fprintf(stderr, "cooperative launch failed: %s (grid %d)\n", hipGetErrorString(e), grid);
}
```

```cpp
#include <hip/hip_runtime.h>
#include <hip/hip_cooperative_groups.h>
#include <cstdio>
#include <cstdint>
namespace cg = cooperative_groups;
namespace pg8 {
#define PG8_LAS __attribute__((address_space(3)))
typedef unsigned short bf16_t;
typedef short bf16x8 __attribute__((ext_vector_type(8)));
typedef float f32x4 __attribute__((ext_vector_type(4)));
typedef unsigned u32x4 __attribute__((ext_vector_type(4)));
constexpr int BM = 256, BK = 64, HALF = 128, HTB = HALF * BK * 2  , STAGE_BYTES = 8 * HTB, NXCD = 8, WGM = 8;

__host__ __device__ __forceinline__ int lds_byte(int r, int c) { const int st = (r >> 4) * 2 + (c >> 5), rr = r & 15, cc = c & 31, ob = rr * 64 + cc * 2; return st * 1024 + (ob ^ (((ob >> 9) & 1) << 5)); }
__host__ __device__ __forceinline__ void stage_rc(int b, int& R, int& C) { const int st = b / 1024, sb = b % 1024, swz = sb ^ (((sb >> 9) & 1) << 5); R = (st >> 1) * 16 + swz / 64; C = (st & 1) * 32 + (swz % 64) / 2; }
__host__ __device__ __forceinline__ int perm32(int rho) { const int n = rho >> 4, i = rho & 15; return 8 * (i >> 2) + 4 * n + (i & 3); }

struct Unit { int pm, pn; };
struct Gemm { const bf16_t* A; const bf16_t* Bt; int M, N, K, lda; };

struct StaticOrder {
    int nM, nN, nwg, G, c;
    __host__ __device__ void init(int M, int N, int G_, int c_) { nM = M / BM; nN = N / BM; nwg = nM * nN; G = G_; c = c_; }
    __host__ __device__ bool next(int i, Unit& u) const {
        const long L = (long)i * G + c; if (L >= nwg) return false;
        int wgid = (int)L; { const int q = nwg / NXCD, r = nwg % NXCD, xcd = wgid % NXCD, off = wgid / NXCD; wgid = (xcd < r ? xcd * (q + 1) : r * (q + 1) + (xcd - r) * q) + off; }
        const int nig = WGM * nN, gid = wgid / nig, fm = gid * WGM, gsz = (nM - fm) < WGM ? (nM - fm) : WGM;
        u.pm = fm + ((wgid % nig) % gsz); u.pn = (wgid % nig) / gsz; return true;
    }
    __device__ __forceinline__ void a_ready(const Unit&) const {}
    __device__ __forceinline__ void done(const Unit&) const {}
};

__device__ __forceinline__ unsigned cvt_pk_bf16(float lo, float hi) { unsigned r; asm volatile("v_cvt_pk_bf16_f32 %0, %1, %2" : "=v"(r) : "v"(lo), "v"(hi)); return r; }
template <class Epi, class Sched, bool ALIGN_EPI = false, bool SP2 = false>
__device__ __forceinline__ void gemm_phase(PG8_LAS unsigned char* lds, const Gemm g, const Sched& S, const Epi& E) {
    int tid_ = threadIdx.x; asm volatile("" : "+v"(tid_));
    const int tid = tid_, wid = __builtin_amdgcn_readfirstlane(tid >> 6), lane = tid & 63, wr = wid >> 2, wc = wid & 3, fr = lane & 15, fq = lane >> 4;
    const int K = g.K, nt = K / BK;
    unsigned voffA[2], voffB[2];
#pragma unroll
    for (int i = 0; i < 2; ++i) { int R, C; stage_rc(tid * 16 + i * 8192, R, C); const int Rb = Epi::PERM ? ((R & ~31) + perm32(R & 31)) : R;
        voffA[i] = (unsigned)(R * g.lda + C) * 2u; voffB[i] = (unsigned)(Rb * K + C) * 2u; }
    const size_t kstep = (size_t)(BK * 2);
    const size_t hstep = (size_t)HALF * K * 2;
    const size_t tstep = 2 * hstep; const size_t hstepA = (size_t)HALF * g.lda * 2, tstepA = 2 * hstepA;
    const unsigned ldsw = (unsigned)wid * 1024u;
    const int aoff = lds_byte(wr * 64 + fr, fq * 8), boff = lds_byte(wc * 32 + fr, fq * 8);
#define PG8_SA(b, h) (((b) * 2 + (h)) * HTB)
#define PG8_SB(b, h) ((4 + (b) * 2 + (h)) * HTB)
#define PG8_STAGE(bufoff, gbase, voff) do { _Pragma("unroll") for (int _i = 0; _i < 2; ++_i) \
        __builtin_amdgcn_global_load_lds((const unsigned*)((const char*)(gbase) + (voff)[_i]), (PG8_LAS unsigned*)(lds + (bufoff) + ldsw + _i * 8192), 16, 0, 0); } while (0)
#define PG8_LDA(dst, b, h) do { _Pragma("unroll") for (int m = 0; m < 4; ++m) _Pragma("unroll") for (int k = 0; k < 2; ++k) dst[m][k] = *(const PG8_LAS bf16x8*)(lds + PG8_SA(b, h) + aoff + m * 2048 + k * 1024); } while (0)
#define PG8_LDB(dst, b, h) do { _Pragma("unroll") for (int n = 0; n < 2; ++n) _Pragma("unroll") for (int k = 0; k < 2; ++k) dst[n][k] = *(const PG8_LAS bf16x8*)(lds + PG8_SB(b, h) + boff + n * 2048 + k * 1024); } while (0)
#define PG8_MMA(ai, bj, At, Bt) do { __builtin_amdgcn_s_setprio(1); _Pragma("unroll") for (int m = 0; m < 4; ++m) _Pragma("unroll") for (int n = 0; n < 2; ++n) _Pragma("unroll") for (int k = 0; k < 2; ++k) \
        acc[ai][bj][m][n] = __builtin_amdgcn_mfma_f32_16x16x32_bf16(Bt[n][k], At[m][k], acc[ai][bj][m][n], 0, 0, 0); __builtin_amdgcn_s_setprio(0); } while (0)
#define PG8_WAIT_V(n) asm volatile("s_waitcnt vmcnt(" #n ")" ::: "memory")
#define PG8_WAIT_L(n) asm volatile("s_waitcnt lgkmcnt(" #n ")" ::: "memory")
#define PG8_BAR __builtin_amdgcn_s_barrier()
#define PG8_SCHED __builtin_amdgcn_sched_barrier(0)
    Unit cur, nxt; int ui = 0;
    if (!S.next(0, cur)) return;
    f32x4 acc[2][2][4][2];
#pragma unroll
    for (int a = 0; a < 2; ++a)
#pragma unroll
        for (int b = 0; b < 2; ++b)
#pragma unroll
            for (int m = 0; m < 4; ++m)
#pragma unroll
                for (int n = 0; n < 2; ++n) acc[a][b][m][n] = (f32x4){0.f, 0.f, 0.f, 0.f};
    bf16x8 At[4][2], B0[2][2], B1[2][2];
    const char* cA = (const char*)g.A + (size_t)cur.pm * tstepA; const char* cB = (const char*)g.Bt + (size_t)cur.pn * tstep;
    S.a_ready(cur);
    if constexpr (SP2) {
        PG8_STAGE(PG8_SB(0, 0), cB, voffB); PG8_STAGE(PG8_SB(0, 1), cB + hstep, voffB); PG8_STAGE(PG8_SA(0, 0), cA, voffA); PG8_STAGE(PG8_SA(0, 1), cA + hstepA, voffA);
        if (wr == 1) PG8_BAR;
        PG8_WAIT_V(2); PG8_BAR;
        PG8_STAGE(PG8_SB(1, 0), cB + kstep, voffB); PG8_STAGE(PG8_SA(1, 0), cA + kstep, voffA); PG8_STAGE(PG8_SB(1, 1), cB + hstep + kstep, voffB);
        PG8_WAIT_V(6); PG8_BAR;
    } else {
        PG8_STAGE(PG8_SB(0, 0), cB, voffB); PG8_STAGE(PG8_SA(0, 0), cA, voffA); PG8_STAGE(PG8_SB(0, 1), cB + hstep, voffB); PG8_STAGE(PG8_SA(0, 1), cA + hstepA, voffA);
        if (wr == 1) PG8_BAR;
        PG8_WAIT_V(4); PG8_BAR;
        PG8_STAGE(PG8_SB(1, 0), cB + kstep, voffB); PG8_STAGE(PG8_SA(1, 0), cA + kstep, voffA); PG8_STAGE(PG8_SB(1, 1), cB + hstep + kstep, voffB);
        PG8_WAIT_V(6); PG8_BAR;
    }
    for (;;) {
        const bool has_next = S.next(ui + 1, nxt);
        const char* nA = has_next ? (const char*)g.A + (size_t)nxt.pm * tstepA : cA; const char* nB = has_next ? (const char*)g.Bt + (size_t)nxt.pn * tstep : cB;
        for (int t = 0; t < nt; t += 2) {
            const bool last = (t == nt - 2);
            const char* a1 = cA + (size_t)(t + 1) * kstep;
            const char* a2 = last ? nA : cA + (size_t)(t + 2) * kstep; const char* b2 = last ? nB : cB + (size_t)(t + 2) * kstep;
            const char* a3 = a2 + kstep; const char* b3 = b2 + kstep;
            if (last && has_next) S.a_ready(nxt);
            if constexpr (SP2) {
            PG8_LDB(B0, 0, 0); PG8_LDB(B1, 0, 1); PG8_SCHED; PG8_LDA(At, 0, 0); PG8_STAGE(PG8_SA(1, 1), a1 + hstepA, voffA);
            PG8_WAIT_V(8); PG8_WAIT_L(0); PG8_BAR; PG8_MMA(0, 0, At, B0); PG8_MMA(0, 1, At, B1); PG8_BAR; PG8_SCHED;
            PG8_LDA(At, 0, 1); PG8_STAGE(PG8_SB(0, 0), b2, voffB); PG8_STAGE(PG8_SB(0, 1), b2 + hstep, voffB); PG8_STAGE(PG8_SA(0, 0), a2, voffA);
            PG8_WAIT_V(8); PG8_WAIT_L(0); PG8_BAR; PG8_MMA(1, 0, At, B0); PG8_MMA(1, 1, At, B1); PG8_BAR; PG8_SCHED;
            PG8_LDB(B0, 1, 0); PG8_LDB(B1, 1, 1); PG8_SCHED; PG8_LDA(At, 1, 0); PG8_STAGE(PG8_SA(0, 1), a2 + hstepA, voffA);
            PG8_WAIT_V(8); PG8_WAIT_L(0); PG8_BAR; PG8_MMA(0, 0, At, B0); PG8_MMA(0, 1, At, B1); PG8_BAR; PG8_SCHED;
            PG8_LDA(At, 1, 1); PG8_STAGE(PG8_SB(1, 0), b3, voffB); PG8_STAGE(PG8_SB(1, 1), b3 + hstep, voffB); PG8_STAGE(PG8_SA(1, 0), a3, voffA);
            PG8_WAIT_V(8); PG8_WAIT_L(0); PG8_BAR; PG8_MMA(1, 0, At, B0); PG8_MMA(1, 1, At, B1); PG8_BAR; PG8_SCHED;
            } else {
            PG8_LDB(B0, 0, 0); PG8_SCHED; PG8_LDA(At, 0, 0); PG8_STAGE(PG8_SA(1, 1), a1 + hstepA, voffA);
            PG8_WAIT_L(8); PG8_BAR; PG8_WAIT_L(0); PG8_MMA(0, 0, At, B0); PG8_BAR; PG8_SCHED;
            PG8_LDB(B1, 0, 1); PG8_STAGE(PG8_SB(0, 0), b2, voffB);
            PG8_BAR; PG8_WAIT_L(0); PG8_MMA(0, 1, At, B1); PG8_BAR;
            PG8_LDA(At, 0, 1); PG8_STAGE(PG8_SA(0, 0), a2, voffA);
            PG8_BAR; PG8_WAIT_L(0); PG8_MMA(1, 0, At, B0); PG8_BAR; PG8_SCHED;
            PG8_STAGE(PG8_SB(0, 1), b2 + hstep, voffB);
            PG8_WAIT_V(6); PG8_BAR; PG8_MMA(1, 1, At, B1); PG8_BAR;
            PG8_LDB(B0, 1, 0); PG8_SCHED; PG8_LDA(At, 1, 0); PG8_STAGE(PG8_SA(0, 1), a2 + hstepA, voffA);
            PG8_WAIT_L(8); PG8_BAR; PG8_WAIT_L(0); PG8_MMA(0, 0, At, B0); PG8_BAR; PG8_SCHED;
            PG8_LDB(B1, 1, 1); PG8_STAGE(PG8_SB(1, 0), b3, voffB);
            PG8_BAR; PG8_WAIT_L(0); PG8_MMA(0, 1, At, B1); PG8_BAR;
            PG8_LDA(At, 1, 1); PG8_STAGE(PG8_SA(1, 0), a3, voffA);
            PG8_BAR; PG8_WAIT_L(0); PG8_MMA(1, 0, At, B0); PG8_BAR; PG8_SCHED;
            PG8_STAGE(PG8_SB(1, 1), b3 + hstep, voffB);
            PG8_WAIT_V(6); PG8_BAR; PG8_MMA(1, 1, At, B1); PG8_BAR;
            }
        }
        if constexpr (ALIGN_EPI) { if (wr == 0) PG8_BAR; }
        if constexpr (!Epi::AFTER_DRAIN) { E(acc, cur, wr, wc, fr, fq); S.done(cur); }
        if (!has_next) break;
#pragma unroll
        for (int a = 0; a < 2; ++a)
#pragma unroll
            for (int b = 0; b < 2; ++b)
#pragma unroll
                for (int m = 0; m < 4; ++m)
#pragma unroll
                    for (int n = 0; n < 2; ++n) acc[a][b][m][n] = (f32x4){0.f, 0.f, 0.f, 0.f};
        cur = nxt; cA = nA; cB = nB; ++ui;
        if constexpr (ALIGN_EPI) { if (wr == 1) PG8_BAR; }
    }
    PG8_WAIT_V(0);
    if constexpr (!ALIGN_EPI) { if (wr == 0) PG8_BAR; }
    PG8_BAR;
    if constexpr (Epi::AFTER_DRAIN) { E.fused(acc, cur, wr, wc, fr, fq, lds, wid, lane); S.done(cur); }
#undef PG8_SA
#undef PG8_SB
#undef PG8_STAGE
#undef PG8_LDA
#undef PG8_LDB
#undef PG8_MMA
#undef PG8_WAIT_V
#undef PG8_WAIT_L
#undef PG8_BAR
#undef PG8_SCHED
}
}

#define LAS __attribute__((address_space(3)))
typedef unsigned short bf16;
typedef short bf16x8 __attribute__((ext_vector_type(8)));
typedef float f32x4 __attribute__((ext_vector_type(4)));
typedef unsigned u32x4 __attribute__((ext_vector_type(4)));
typedef unsigned u32x2 __attribute__((ext_vector_type(2)));
constexpr int NWAVES = 8, NTHR = 512;
constexpr int BATCH = 2, T = 8192, D = 1024, M = BATCH * T, DFF = 2816;
constexpr int PLD = 4864;
constexpr int PC_QN = 0, PC_KV = 512, PC_QG = 1280, PC_KG = 1536, PC_VG = 1792, PC_RG = 2304, PC_GM = 2816;
constexpr int NIN = 5120, NGU = 5632;
constexpr float EPS = 1e-6f, NEGB = -1e30f;
constexpr size_t MiB = 1u << 20;
constexpr size_t WS_CTL = 0, CTL_BYTES = 1 * MiB;
constexpr size_t WS_WIN = 1 * MiB, WS_WGU = 11 * MiB, WS_WDN = 22 * MiB, WS_WOUT = 28 * MiB, WS_WUPA = 30 * MiB, WS_WUPB = 31 * MiB;
constexpr size_t WS_CW1K = 32 * MiB, WS_CW1V = 32 * MiB + 512 * 1024, WS_CW2K = 33 * MiB, WS_CW2V = 33 * MiB + 16384;
constexpr size_t WS_KCMP = 33 * MiB + 65536, WS_VCMPT = 33 * MiB + 65536 + 262144;
constexpr size_t WS_ROPE = 34 * MiB, WS_SMALL = 35 * MiB, WS_DEC = 39 * MiB, WS_RSQ1 = 39 * MiB + 262144, WS_RSQ2 = 39 * MiB + 524288;
constexpr size_t WS_XN = 40 * MiB, WS_XB = 40 * MiB;
constexpr size_t WS_PROJ = 72 * MiB, WS_H = 72 * MiB;
constexpr size_t WS_QROT = 224 * MiB, WS_CSRC = 228 * MiB, WS_KROT = 240 * MiB, WS_VTS = 248 * MiB, WS_VTW = 252 * MiB, WS_END = 256 * MiB;
constexpr size_t DO_L = 0, DO_S = 16 * MiB, DO_OA = 32 * MiB, DO_OB = 48 * MiB;
constexpr int LDS_BYTES = 147456;

__device__ __forceinline__ unsigned pk2(float lo, float hi) { return pg8::cvt_pk_bf16(lo, hi); }
__device__ __forceinline__ float bflo(unsigned w) { return __uint_as_float(w << 16); }
__device__ __forceinline__ float bfhi(unsigned w) { return __uint_as_float(w & 0xffff0000u); }
__device__ __forceinline__ float bf2f(short s) { return __uint_as_float(((unsigned)(unsigned short)s) << 16); }
__device__ __forceinline__ unsigned short f2bf(float f) { return (unsigned short)(pk2(f, 0.f) & 0xffffu); }
__device__ __forceinline__ float sigmoidf_(float x) { return __builtin_amdgcn_rcpf(1.f + __expf(-x)); }
__device__ __forceinline__ float siluf_(float x) { return x * __builtin_amdgcn_rcpf(1.f + __expf(-x)); }
__device__ __forceinline__ float wave_sum(float v) {
#pragma unroll
    for (int o = 1; o < 64; o <<= 1) v += __shfl_xor(v, o);
    return v;
}
#define LDS_WAIT() asm volatile("s_waitcnt lgkmcnt(0)" ::: "memory")
__device__ __forceinline__ float max3f_(float a, float b, float c) { float r; asm("v_max3_f32 %0, %1, %2, %3" : "=v"(r) : "v"(a), "v"(b), "v"(c)); return r; }
__device__ __forceinline__ float max16f_(const f32x4 (&s)[4]) {
    const float m1 = max3f_(s[0][0], s[0][1], s[0][2]), m2 = max3f_(s[0][3], s[1][0], s[1][1]), m3 = max3f_(s[1][2], s[1][3], s[2][0]), m4 = max3f_(s[2][1], s[2][2], s[2][3]), m5 = max3f_(s[3][0], s[3][1], s[3][2]);
    return max3f_(max3f_(m1, m2, s[3][3]), max3f_(m3, m4, m5), m1); }
__device__ __forceinline__ int perm32k(int w) { return 8 * ((w >> 2) & 3) + 4 * (w >> 4) + (w & 3); }
#define MFMA16(a, b, c) __builtin_amdgcn_mfma_f32_16x16x32_bf16((a), (b), (c), 0, 0, 0)

struct EpiProj {
    static constexpr bool PERM = true, AFTER_DRAIN = false; bf16* P; float* S; bf16* C;
    __device__ __forceinline__ void operator()(const f32x4 (&acc)[2][2][4][2], const pg8::Unit& u, int wr, int wc, int fr, int fq) const {
        const int row0 = u.pm * 256 + wr * 64 + fr;
        if (u.pn < 19) {
            const float sc = u.pn < 2 ? 0.125f * 1.44269504f : u.pn == 5 ? 0.125f : 1.f;     const int col0 = u.pn * 256 + wc * 32 + 8 * fq;
#pragma unroll
            for (int ai = 0; ai < 2; ++ai)
#pragma unroll
                for (int m = 0; m < 4; ++m) { bf16* rowp = P + (size_t)(row0 + ai * 128 + m * 16) * PLD + col0;
#pragma unroll
                    for (int bj = 0; bj < 2; ++bj) { const f32x4 v0 = acc[ai][bj][m][0] * sc, v1 = acc[ai][bj][m][1] * sc; u32x4 w;
                        w.x = pk2(v0[0], v0[1]); w.y = pk2(v0[2], v0[3]); w.z = pk2(v1[0], v1[1]); w.w = pk2(v1[2], v1[3]);
                        if (u.pn == 2) *(u32x4*)(C + ((size_t)(bj * 2 + (wc >> 1)) * M + (row0 + ai * 128 + m * 16)) * 64 + (wc & 1) * 32 + 8 * fq) = w;
                        else *(u32x4*)(rowp + bj * 128) = w; } }
        } else if (wc < 2) {
#pragma unroll
            for (int ai = 0; ai < 2; ++ai)
#pragma unroll
                for (int m = 0; m < 4; ++m) { float* rp = S + (size_t)(row0 + ai * 128 + m * 16) * 64 + wc * 32 + 8 * fq; *(f32x4*)rp = acc[ai][0][m][0]; *(f32x4*)(rp + 4) = acc[ai][0][m][1]; }
        }
    }
};
template <bool SECOND> struct EpiUp {
    static constexpr bool PERM = true, AFTER_DRAIN = false; const bf16* P; bf16* O; int ldo;
    __device__ __forceinline__ void operator()(const f32x4 (&acc)[2][2][4][2], const pg8::Unit& u, int wr, int wc, int fr, int fq) const {
        const int row0 = u.pm * 256 + wr * 64 + fr, col0 = u.pn * 256 + wc * 32 + 8 * fq;
#pragma unroll
        for (int ai = 0; ai < 2; ++ai)
#pragma unroll
            for (int m = 0; m < 4; ++m) { const size_t row = (size_t)(row0 + ai * 128 + m * 16);
#pragma unroll
                for (int bj = 0; bj < 2; ++bj) { const int col = col0 + bj * 128;
                    const u32x4 gw = *(const u32x4*)(P + row * PLD + PC_GM + (SECOND ? 1024 : 0) + col);
                    const f32x4 a0 = acc[ai][bj][m][0], a1 = acc[ai][bj][m][1];
                    float o[8] = { a0[0] * sigmoidf_(bflo(gw.x)), a0[1] * sigmoidf_(bfhi(gw.x)), a0[2] * sigmoidf_(bflo(gw.y)), a0[3] * sigmoidf_(bfhi(gw.y)),
                                   a1[0] * sigmoidf_(bflo(gw.z)), a1[1] * sigmoidf_(bfhi(gw.z)), a1[2] * sigmoidf_(bflo(gw.w)), a1[3] * sigmoidf_(bfhi(gw.w)) };
                    if (SECOND) { const u32x4 pw = *(const u32x4*)(O + row * ldo + col);
                        o[0] += bflo(pw.x); o[1] += bfhi(pw.x); o[2] += bflo(pw.y); o[3] += bfhi(pw.y); o[4] += bflo(pw.z); o[5] += bfhi(pw.z); o[6] += bflo(pw.w); o[7] += bfhi(pw.w); }
                    u32x4 w; w.x = pk2(o[0], o[1]); w.y = pk2(o[2], o[3]); w.z = pk2(o[4], o[5]); w.w = pk2(o[6], o[7]); *(u32x4*)(O + row * ldo + col) = w; } }
    }
};
struct UpOrder { pg8::StaticOrder so;
    __device__ bool next(int i, pg8::Unit& u) const { if (i > 1) return false; pg8::Unit b; if (!so.next(0, b)) return false; u.pm = b.pm + (i ? 64 : 0); u.pn = b.pn + (i ? 4 : 0); return true; }
    __device__ __forceinline__ void a_ready(const pg8::Unit&) const {}
    __device__ __forceinline__ void done(const pg8::Unit&) const {}
};
struct EpiUp2 { static constexpr bool PERM = true, AFTER_DRAIN = false; const bf16* P; bf16* O; int ldo;
    __device__ __forceinline__ void operator()(const f32x4 (&acc)[2][2][4][2], const pg8::Unit& u, int wr, int wc, int fr, int fq) const {
        if (u.pm < 64) { EpiUp<false> e{P, O, ldo}; e(acc, u, wr, wc, fr, fq); }
        else { EpiUp<true> e{P, O, ldo}; pg8::Unit v; v.pm = u.pm - 64; v.pn = u.pn - 4; e(acc, v, wr, wc, fr, fq); }
    }
};
template <bool WRITE_XB> struct EpiRes {
    static constexpr bool PERM = true, AFTER_DRAIN = true; const float* base; float* out; bf16* XB; float* rsq;
    __device__ __forceinline__ void fused(f32x4 (&acc)[2][2][4][2], const pg8::Unit& u, int wr, int wc, int fr, int fq, PG8_LAS unsigned char* lds, int wid, int lane) const {
        const int row0 = u.pm * 256 + wr * 64 + fr, col0 = u.pn * 256 + wc * 32 + 8 * fq;
        PG8_LAS float* rs = (PG8_LAS float*)lds;
#pragma unroll
        for (int ai = 0; ai < 2; ++ai) { f32x4 bb[4][2][2];
#pragma unroll
            for (int m = 0; m < 4; ++m)
#pragma unroll
                for (int bj = 0; bj < 2; ++bj) { const size_t off = (size_t)(row0 + ai * 128 + m * 16) * D + col0 + bj * 128; bb[m][bj][0] = *(const f32x4*)(base + off); bb[m][bj][1] = *(const f32x4*)(base + off + 4); }
#pragma unroll
            for (int m = 0; m < 4; ++m) { const size_t row = (size_t)(row0 + ai * 128 + m * 16); float ss = 0.f;
#pragma unroll
                for (int bj = 0; bj < 2; ++bj) { const size_t off = row * D + col0 + bj * 128;
                    const f32x4 v0 = bb[m][bj][0] + acc[ai][bj][m][0], v1 = bb[m][bj][1] + acc[ai][bj][m][1];
                    if (!WRITE_XB) { *(f32x4*)(out + off) = v0; *(f32x4*)(out + off + 4) = v1; }
                    ss += (v0[0] * v0[0] + v0[1] * v0[1]) + (v0[2] * v0[2] + v0[3] * v0[3]) + (v1[0] * v1[0] + v1[1] * v1[1]) + (v1[2] * v1[2] + v1[3] * v1[3]);
                    if (WRITE_XB) { u32x4 w; w.x = pk2(v0[0], v0[1]); w.y = pk2(v0[2], v0[3]); w.z = pk2(v1[0], v1[1]); w.w = pk2(v1[2], v1[3]); *(u32x4*)(XB + off) = w; } }
                ss += __shfl_xor(ss, 16); ss += __shfl_xor(ss, 32);
                if (fq == 0) rs[(ai * 128 + wr * 64 + m * 16 + fr) * 4 + wc] = ss; } }
        __syncthreads();
        const int t = wid * 64 + lane;
        if (t < 256) rsq[(size_t)u.pn * M + u.pm * 256 + t] = (rs[t * 4] + rs[t * 4 + 1]) + (rs[t * 4 + 2] + rs[t * 4 + 3]);
        __syncthreads();
    }
};
struct EpiFinal {
    static constexpr bool PERM = true, AFTER_DRAIN = true; const bf16* base; float* out; float* rsq; unsigned* cnt; const float* gain;
    __device__ __forceinline__ void fused(f32x4 (&acc)[2][2][4][2], const pg8::Unit& u, int wr, int wc, int fr, int fq, PG8_LAS unsigned char* lds, int wid, int lane) const {
        const int row0 = u.pm * 256 + wr * 64 + fr, col0 = u.pn * 256 + wc * 32 + 8 * fq;
        PG8_LAS float* rs = (PG8_LAS float*)lds;
        u32x4 bw[2][4][2];
#pragma unroll
        for (int ai = 0; ai < 2; ++ai)
#pragma unroll
            for (int m = 0; m < 4; ++m)
#pragma unroll
                for (int bj = 0; bj < 2; ++bj) bw[ai][m][bj] = *(const u32x4*)(base + (size_t)(row0 + ai * 128 + m * 16) * D + col0 + bj * 128);
#pragma unroll
        for (int ai = 0; ai < 2; ++ai)
#pragma unroll
            for (int m = 0; m < 4; ++m) { float ss = 0.f;
#pragma unroll
                for (int bj = 0; bj < 2; ++bj) { const u32x4 w = bw[ai][m][bj]; const f32x4 b0 = {bflo(w.x), bfhi(w.x), bflo(w.y), bfhi(w.y)}, b1 = {bflo(w.z), bfhi(w.z), bflo(w.w), bfhi(w.w)};
                    const f32x4 v0 = b0 + acc[ai][bj][m][0], v1 = b1 + acc[ai][bj][m][1]; acc[ai][bj][m][0] = v0; acc[ai][bj][m][1] = v1;
                    ss += (v0[0] * v0[0] + v0[1] * v0[1]) + (v0[2] * v0[2] + v0[3] * v0[3]) + (v1[0] * v1[0] + v1[1] * v1[1]) + (v1[2] * v1[2] + v1[3] * v1[3]); }
                ss += __shfl_xor(ss, 16); ss += __shfl_xor(ss, 32);
                if (fq == 0) rs[(ai * 128 + wr * 64 + m * 16 + fr) * 4 + wc] = ss; }
        __syncthreads();
        const int t = wid * 64 + lane;
        if (t < 256) rsq[(size_t)u.pn * M + u.pm * 256 + t] = (rs[t * 4] + rs[t * 4 + 1]) + (rs[t * 4 + 2] + rs[t * 4 + 3]);
        asm volatile("s_waitcnt vmcnt(0)" ::: "memory");
        __syncthreads();
        if (t == 0) { __builtin_amdgcn_fence(__ATOMIC_RELEASE, "agent"); asm volatile("s_waitcnt vmcnt(0)" ::: "memory");
            unsigned* c = cnt + 64 * u.pm; __hip_atomic_fetch_add(c, 1u, __ATOMIC_RELAXED, __HIP_MEMORY_SCOPE_AGENT);
            while (__hip_atomic_load(c, __ATOMIC_RELAXED, __HIP_MEMORY_SCOPE_AGENT) < 4u) __builtin_amdgcn_s_sleep(2);
            __builtin_amdgcn_fence(__ATOMIC_ACQUIRE, "agent"); asm volatile("s_waitcnt vmcnt(0)" ::: "memory"); }
        __syncthreads();
        PG8_LAS float* rstd = (PG8_LAS float*)(lds + 4096);
        if (t < 256) { const size_t row = (size_t)u.pm * 256 + t; rstd[t] = rsqrtf(((rsq[row] + rsq[(size_t)M + row]) + (rsq[(size_t)2 * M + row] + rsq[(size_t)3 * M + row])) * (1.f / D) + EPS); }
        __syncthreads();
#pragma unroll
        for (int ai = 0; ai < 2; ++ai)
#pragma unroll
            for (int m = 0; m < 4; ++m) { const int rl = ai * 128 + wr * 64 + m * 16 + fr; const float r = rstd[rl]; const size_t row = (size_t)u.pm * 256 + rl;
#pragma unroll
                for (int bj = 0; bj < 2; ++bj) { const size_t off = row * D + col0 + bj * 128; const f32x4 g0 = *(const f32x4*)(gain + col0 + bj * 128), g1 = *(const f32x4*)(gain + col0 + bj * 128 + 4); *(f32x4*)(out + off) = acc[ai][bj][m][0] * r * g0; *(f32x4*)(out + off + 4) = acc[ai][bj][m][1] * r * g1; } }
        __syncthreads();
    }
};
struct EpiFfn {
    static constexpr bool PERM = true, AFTER_DRAIN = false; bf16* H; const float* rsq;
    __device__ __forceinline__ void operator()(const f32x4 (&acc)[2][2][4][2], const pg8::Unit& u, int wr, int wc, int fr, int fq) const {
        const int row0 = u.pm * 256 + wr * 64 + fr, f0 = u.pn * 128 + wc * 16 + 4 * fq;
        float rq[2][4][4];
#pragma unroll
        for (int ai = 0; ai < 2; ++ai)
#pragma unroll
            for (int m = 0; m < 4; ++m) { const size_t row = (size_t)(row0 + ai * 128 + m * 16);
#pragma unroll
                for (int p = 0; p < 4; ++p) rq[ai][m][p] = rsq[(size_t)p * M + row]; }
#pragma unroll
        for (int ai = 0; ai < 2; ++ai)
#pragma unroll
            for (int m = 0; m < 4; ++m) { const size_t row = (size_t)(row0 + ai * 128 + m * 16);
                const float rstd = rsqrtf(((rq[ai][m][0] + rq[ai][m][1]) + (rq[ai][m][2] + rq[ai][m][3])) * (1.f / D) + EPS);
#pragma unroll
                for (int bj = 0; bj < 2; ++bj) { const f32x4 gv = acc[ai][bj][m][0] * rstd, uv = acc[ai][bj][m][1] * rstd;
                    u32x2 w; w.x = pk2(siluf_(gv[0]) * uv[0], siluf_(gv[1]) * uv[1]); w.y = pk2(siluf_(gv[2]) * uv[2], siluf_(gv[3]) * uv[3]);
                    *(u32x2*)(H + row * DFF + f0 + bj * 64) = w; } }
    }
};

template <int MODE> __device__ __forceinline__ void tr_item(const float* W0, const float* W1, int K, int Nsrc, bf16* WT, int item, int nblk, const float* kscale, LAS float* scr, int lane) {
    const int kb = item / nblk, nb = item % nblk, k0 = 64 * kb, n0 = 32 * nb, nn = n0 + (lane & 31);
    const float* src = W0; int sc = nn;
    if (MODE == 1) sc = nn < 1280 ? nn : nn < 2304 ? nn + 24 : nn < 4864 ? nn + 40 : nn < 4888 ? nn - 4864 + 1280 : nn < 4904 ? nn - 4888 + 2328 : -1;
    if (MODE == 2) { const int q = nn >> 3, e = nn & 7; src = (e < 4) ? W0 : W1; sc = 4 * q + (e & 3); }
    float tv[32];
#pragma unroll
    for (int i = 0; i < 32; ++i) { const int kk = 2 * i + (lane >> 5); tv[i] = sc >= 0 ? src[(size_t)(k0 + kk) * Nsrc + sc] : 0.f; }
#pragma unroll
    for (int i = 0; i < 32; ++i) { const int kk = 2 * i + (lane >> 5); float v = tv[i]; if (kscale) v *= kscale[k0 + kk]; scr[kk * 33 + (lane & 31)] = v; }
    LDS_WAIT();
    const int c = lane & 7;
#pragma unroll
    for (int j = 0; j < 4; ++j) { const int n = (lane >> 3) + 8 * j; const LAS float* s = scr + (8 * c) * 33 + n;
        u32x4 o; o.x = pk2(s[0 * 33], s[1 * 33]); o.y = pk2(s[2 * 33], s[3 * 33]); o.z = pk2(s[4 * 33], s[5 * 33]); o.w = pk2(s[6 * 33], s[7 * 33]);
        *(u32x4*)(WT + (size_t)(n0 + n) * K + k0 + 8 * c) = o; }
    LDS_WAIT();
}
__device__ __forceinline__ void rms_row_to_bf16(const float* xrow, const float* gain, bf16* orow, int lane) {
    const f32x4* xr = (const f32x4*)xrow + lane; const f32x4* gr = (const f32x4*)gain + lane;
    f32x4 v[4]; float s = 0.f;
#pragma unroll
    for (int j = 0; j < 4; ++j) { v[j] = xr[64 * j]; s += (v[j].x * v[j].x + v[j].y * v[j].y) + (v[j].z * v[j].z + v[j].w * v[j].w); }
    const float rstd = rsqrtf(wave_sum(s) * (1.f / D) + EPS);
    u32x2* o8 = (u32x2*)orow + lane;
#pragma unroll
    for (int j = 0; j < 4; ++j) { const f32x4 g = gr[64 * j]; u32x2 w; w.x = pk2(v[j].x * rstd * g.x, v[j].y * rstd * g.y); w.y = pk2(v[j].z * rstd * g.z, v[j].w * rstd * g.w); o8[64 * j] = w; }
}
struct Args { const float* in[20]; float* out; unsigned char* ws; };

__device__ __forceinline__ void p0_prologue(const Args& a, LAS unsigned char* lds, int wave, int lane) {
    unsigned char* ws = a.ws;
    LAS float* scr = (LAS float*)(lds + wave * 16384);
    const int gw = blockIdx.x * NWAVES + wave, NGW = gridDim.x * NWAVES;
    constexpr int I_IN = 16 * (NIN / 32), I_GU = 16 * (NGU / 32), I_DN = 44 * 32, I_OUT = 16 * 32, I_UP = 8 * 32, I_C1 = 32 * 4, I_C2 = 2 * 2;
    constexpr int NITEMS = I_IN + I_GU + I_DN + I_OUT + 2 * I_UP + 2 * I_C1 + 2 * I_C2;
    for (int it = gw; it < NITEMS; it += NGW) {
        int r = it;
        if (r < I_IN) { tr_item<1>(a.in[2], nullptr, 1024, 4904, (bf16*)(ws + WS_WIN), r, NIN / 32, nullptr, scr, lane); continue; } r -= I_IN;
        if (r < I_GU) { tr_item<2>(a.in[16], a.in[17], 1024, DFF, (bf16*)(ws + WS_WGU), r, NGU / 32, a.in[15], scr, lane); continue; } r -= I_GU;
        if (r < I_DN) { tr_item<0>(a.in[18], nullptr, DFF, 1024, (bf16*)(ws + WS_WDN), r, 32, nullptr, scr, lane); continue; } r -= I_DN;
        if (r < I_OUT) { tr_item<0>(a.in[14], nullptr, 1024, 1024, (bf16*)(ws + WS_WOUT), r, 32, nullptr, scr, lane); continue; } r -= I_OUT;
        if (r < I_UP) { tr_item<0>(a.in[12], nullptr, 512, 1024, (bf16*)(ws + WS_WUPA), r, 32, nullptr, scr, lane); continue; } r -= I_UP;
        if (r < I_UP) { tr_item<0>(a.in[13], nullptr, 512, 1024, (bf16*)(ws + WS_WUPB), r, 32, nullptr, scr, lane); continue; } r -= I_UP;
        if (r < I_C1) { tr_item<0>(a.in[5], nullptr, 2048, 128, (bf16*)(ws + WS_CW1K), r, 4, nullptr, scr, lane); continue; } r -= I_C1;
        if (r < I_C1) { tr_item<0>(a.in[7], nullptr, 2048, 128, (bf16*)(ws + WS_CW1V), r, 4, nullptr, scr, lane); continue; } r -= I_C1;
        if (r < I_C2) { tr_item<0>(a.in[6], nullptr, 128, 64, (bf16*)(ws + WS_CW2K), r, 2, nullptr, scr, lane); continue; } r -= I_C2;
        tr_item<0>(a.in[8], nullptr, 128, 64, (bf16*)(ws + WS_CW2V), r, 2, nullptr, scr, lane);
    }
    for (int m0 = gw; m0 < M; m0 += 4 * NGW) {
        f32x4 v[4][4]; float ss[4];
#pragma unroll
        for (int r = 0; r < 4; ++r) { const int m = m0 + r * NGW < M ? m0 + r * NGW : m0; const f32x4* xr = (const f32x4*)(a.in[0] + (size_t)m * D) + lane;
#pragma unroll
            for (int j = 0; j < 4; ++j) v[r][j] = xr[64 * j]; }
#pragma unroll
        for (int r = 0; r < 4; ++r) { float s_ = 0.f;
#pragma unroll
            for (int j = 0; j < 4; ++j) s_ += (v[r][j].x * v[r][j].x + v[r][j].y * v[r][j].y) + (v[r][j].z * v[r][j].z + v[r][j].w * v[r][j].w);
            ss[r] = rsqrtf(wave_sum(s_) * (1.f / D) + EPS); }
#pragma unroll
        for (int r = 0; r < 4; ++r) { const int m = m0 + r * NGW; if (m < M) { u32x2* o8 = (u32x2*)((bf16*)(ws + WS_XN) + (size_t)m * D) + lane; const f32x4* gr = (const f32x4*)a.in[1] + lane;
#pragma unroll
            for (int j = 0; j < 4; ++j) { const f32x4 g = gr[64 * j]; u32x2 w; w.x = pk2(v[r][j].x * ss[r] * g.x, v[r][j].y * ss[r] * g.y); w.y = pk2(v[r][j].z * ss[r] * g.z, v[r][j].w * ss[r] * g.w); o8[64 * j] = w; } } } }
    for (int e = blockIdx.x * NTHR + threadIdx.x; e < T * 8; e += gridDim.x * NTHR) {
        const int t = e >> 3, i = e & 7;
        const float f = i == 0 ? 1.0f : i == 1 ? 0.19392274f : i == 2 ? 0.03760603f : i == 3 ? 0.0072926646f : i == 4 ? 0.0014142136f : i == 5 ? 0.0002742482f : i == 6 ? 5.3182957e-05f : 1.0313385e-05f;
        const float ang = (float)t * f;
        const float p = ang * 0.15915494f; const float er = fmaf(ang, 0.15915494f, -p) + ang * 6.4206382e-09f; const float fr = (p - rintf(p)) + er;
        ((float*)(ws + WS_ROPE))[e] = __builtin_amdgcn_cosf(fr); ((float*)(ws + WS_ROPE))[T * 8 + e] = __builtin_amdgcn_sinf(fr);
    }
    if (gw >= NGW - 32) { const int g2 = gw - (NGW - 32), kv = g2 >> 4, q = g2 & 15; const float* pe = a.in[3 + kv] + 128 * q; const float* w1 = a.in[kv ? 7 : 5] + (size_t)(128 * q) * 128;
        float s0 = 0.f, s1 = 0.f;
#pragma unroll 32
        for (int k = 0; k < 128; ++k) { const float p = pe[k]; s0 += p * w1[k * 128 + lane]; s1 += p * w1[k * 128 + 64 + lane]; }
        float* b1 = (float*)(ws + WS_CTL) + 2048 + (kv * 16 + q) * 128; b1[lane] = s0; b1[64 + lane] = s1; }
}

__device__ __forceinline__ u32x4 rope_unit(u32x4 x, const u32x4 y, const float* RC, const float* RS, int t, float sg) {
    const f32x4 c0 = *(const f32x4*)(RC + t * 8), c1 = *(const f32x4*)(RC + t * 8 + 4), s0 = *(const f32x4*)(RS + t * 8), s1 = *(const f32x4*)(RS + t * 8 + 4);
    x.x = pk2(bflo(x.x) * c0[0] + sg * bflo(y.x) * s0[0], bfhi(x.x) * c0[1] + sg * bfhi(y.x) * s0[1]); x.y = pk2(bflo(x.y) * c0[2] + sg * bflo(y.y) * s0[2], bfhi(x.y) * c0[3] + sg * bfhi(y.y) * s0[3]);
    x.z = pk2(bflo(x.z) * c1[0] + sg * bflo(y.z) * s1[0], bfhi(x.z) * c1[1] + sg * bfhi(y.z) * s1[1]); x.w = pk2(bflo(x.w) * c1[2] + sg * bflo(y.w) * s1[2], bfhi(x.w) * c1[3] + sg * bfhi(y.w) * s1[3]);
    return x;
}
__device__ __forceinline__ void rope_item(int item, unsigned char* ws, int lane) {
    const bf16* PROJ = (const bf16*)(ws + WS_PROJ); const float* RC = (const float*)(ws + WS_ROPE); const float* RS = RC + T * 8; bf16* QROT = (bf16*)(ws + WS_QROT); bf16* KROT = (bf16*)(ws + WS_KROT);
    const size_t row0 = (size_t)item * 8; const int tq0 = (int)(row0 & (T - 1));
    { const int sub = lane & 7; const float sg = sub == 0 ? -1.f : 1.f; u32x4 x[8], y[8];
#pragma unroll
      for (int tt = 0; tt < 8; ++tt) { const bf16* src = PROJ + (row0 + tt) * PLD + PC_QN; x[tt] = *(const u32x4*)(src + 8 * lane); y[tt] = *(const u32x4*)(src + 8 * (lane ^ 1)); }
#pragma unroll
      for (int tt = 0; tt < 8; ++tt) { if (sub < 2) { x[tt] = rope_unit(x[tt], y[tt], RC, RS, tq0 + tt, sg); *(u32x4*)(QROT + (row0 + tt) * 128 + (lane >> 3) * 16 + 8 * sub) = x[tt]; } } }
    { u32x4 x[4], y[4];
#pragma unroll
      for (int it = 0; it < 4; ++it) { const int id = it * 64 + lane, tt = id >> 5, w = id & 31, tensor = w >> 4, g = (w >> 3) & 1, u8 = w & 7;
          const bf16* p = PROJ + (row0 + tt) * PLD + PC_KV + (2 + 2 * tensor) * 128 + g * 64; x[it] = *(const u32x4*)(p + 8 * u8); y[it] = *(const u32x4*)(p + 8 * (u8 ^ 1)); }
#pragma unroll
      for (int it = 0; it < 4; ++it) { const int id = it * 64 + lane, tt = id >> 5, w = id & 31, u8 = w & 7;
          if (u8 < 2) x[it] = rope_unit(x[it], y[it], RC, RS, tq0 + tt, u8 == 0 ? -1.f : 1.f);
          *(u32x4*)(KROT + ((size_t)(w >> 3) * M + row0 + tt) * 64 + 8 * u8) = x[it]; } }
}
__device__ __forceinline__ void p2a_item(int item, unsigned char* ws, LAS unsigned char* wl, int lane) {
    const bf16* PROJ = (const bf16*)(ws + WS_PROJ);
    const int part = item & 1, tile = item >> 1, b = tile >> 7, t0 = (tile & 127) * 64;
    int csrc; bf16* dst; int nc, cdst;
    if (part == 0) { csrc = PC_KV + 3 * 128; dst = (bf16*)(ws + WS_VTS); nc = 128; cdst = 0; }
    else { csrc = PC_KV + 5 * 128; dst = (bf16*)(ws + WS_VTW); nc = 128; cdst = 0; }
    LAS unsigned char* tb = wl;
#pragma unroll
    for (int it = 0; it < 16; ++it) { const int id = it * 64 + lane, tt = id >> 4, uu = id & 15;
        const u32x4 v = *(const u32x4*)(PROJ + ((size_t)b * T + t0 + tt) * PLD + csrc + 8 * uu);
        *(LAS u32x2*)(tb + tt * 264 + uu * 16) = (u32x2){v.x, v.y}; *(LAS u32x2*)(tb + tt * 264 + uu * 16 + 8) = (u32x2){v.z, v.w}; }
    LDS_WAIT();
#pragma unroll
    for (int pass = 0; pass < 2; ++pass) { const int c = pass * 64 + lane;
        bf16* dp = dst + ((((size_t)(b * 2 + pass)) * 128 + (t0 >> 6)) * 64 + lane) * 64;
#pragma unroll
        for (int hb = 0; hb < 2; ++hb) { unsigned wv[16];
#pragma unroll
            for (int p2 = 0; p2 < 16; ++p2) { unsigned lo, hi;
                { const int p = 2 * p2, fqq = p >> 3, e = p & 7, key = 32 * hb + (e < 4 ? 4 * fqq + e : 16 + 4 * fqq + (e - 4)); lo = *(const LAS unsigned short*)(tb + key * 264 + c * 2); }
                { const int p = 2 * p2 + 1, fqq = p >> 3, e = p & 7, key = 32 * hb + (e < 4 ? 4 * fqq + e : 16 + 4 * fqq + (e - 4)); hi = *(const LAS unsigned short*)(tb + key * 264 + c * 2); }
                wv[p2] = lo | (hi << 16); }
#pragma unroll
            for (int q = 0; q < 4; ++q) *(u32x4*)(dp + 32 * hb + 8 * q) = (u32x4){wv[4 * q], wv[4 * q + 1], wv[4 * q + 2], wv[4 * q + 3]}; } }
    LDS_WAIT();
}

__device__ __forceinline__ void compress_item(int item, int sub, unsigned char* ws, LAS unsigned char* lds, int wave, int lane) {
    const int kv = item >> 5, g = (item >> 4) & 1, rt = item & 15, fr = lane & 15, fq = lane >> 4;
    const int rbase = rt * 64 + sub * 16;
    const bf16* Ap; { const int rowidx = rbase + fr, b = rowidx >> 9, ii = rowidx & 511; int tok0 = b * T + 16 * ii; if (tok0 > M - 32) tok0 = M - 32;
        Ap = (const bf16*)(ws + WS_CSRC) + ((size_t)(kv * 2 + g) * M + tok0) * 64 + 8 * fq; }
    const bf16* Bp = (const bf16*)(ws + (kv ? WS_CW1V : WS_CW1K)) + (size_t)(16 * wave + fr) * 2048 + 8 * fq;
    f32x4 acc = {0.f, 0.f, 0.f, 0.f};
    for (int kb = 0; kb < 64; kb += 16) {
        bf16x8 bv[16], av[16];
#pragma unroll
        for (int k2 = 0; k2 < 16; ++k2) { bv[k2] = *(const bf16x8*)(Bp + 32 * (kb + k2)); av[k2] = *(const bf16x8*)(Ap + 32 * (kb + k2)); }
#pragma unroll
        for (int k2 = 0; k2 < 16; ++k2) acc = MFMA16(av[k2], bv[k2], acc); }
    float bias = 0.f;
#pragma unroll
    for (int q = 0; q < 16; ++q) bias += ((const float*)(ws + WS_CTL))[2048 + (kv * 16 + q) * 128 + 16 * wave + fr];
    LAS bf16* H1 = (LAS bf16*)lds;
#pragma unroll
    for (int i = 0; i < 4; ++i) H1[(4 * fq + i) * 136 + 16 * wave + fr] = f2bf(siluf_(acc[i] + bias));
    __syncthreads();
    if (wave < 4) { const int ct = wave; const bf16* W2 = (const bf16*)(ws + (kv ? WS_CW2V : WS_CW2K)) + (size_t)(16 * ct + fr) * 128 + 8 * fq; f32x4 a2 = {0.f, 0.f, 0.f, 0.f};
#pragma unroll
        for (int ks = 0; ks < 4; ++ks) { const bf16x8 av = *(const LAS bf16x8*)(H1 + fr * 136 + 32 * ks + 8 * fq); const bf16x8 bv = *(const bf16x8*)(W2 + 32 * ks); a2 = MFMA16(av, bv, a2); }
        const int c = 16 * ct + fr;
        float vv[4];
#pragma unroll
        for (int i = 0; i < 4; ++i) { const int i2 = (rbase + 4 * fq + i) & 511; vv[i] = (i2 == 511) ? 0.f : a2[i]; }
        const int r0 = rbase + 4 * fq, b2 = r0 >> 9, i20 = r0 & 511;
        if (kv == 0) {
#pragma unroll
            for (int i = 0; i < 4; ++i) { const float nb = __shfl_xor(vv[i], 1); if (!(fr & 1)) *(unsigned*)((bf16*)(ws + WS_KCMP) + ((size_t)(b2 * 2 + g) * 512 + i20 + i) * 64 + c) = pk2(vv[i], nb); }
        } else { u32x2 w; w.x = pk2(vv[0], vv[1]); w.y = pk2(vv[2], vv[3]);
            *(u32x2*)((bf16*)(ws + WS_VCMPT) + ((size_t)(b2 * 2 + g) * 64 + c) * 512 + (i20 & ~31) + perm32k(i20 & 31)) = w; } }
    __syncthreads();
}

__device__ __forceinline__ void gla_cum(LAS float* cum, LAS float* tot, const float* SM, const float* w2, const float* gb, int b, int h, int c, int tid) {
    const int dk = tid & 63, tg = __builtin_amdgcn_readfirstlane(tid >> 6);
    float wcol[16];
#pragma unroll
    for (int r = 0; r < 16; ++r) wcol[r] = w2[r * 256 + h * 64 + dk];
    const float bias = gb[h * 64 + dk]; float run = 0.f, vals[8];
    LAS float* lrs = tot + 7680;
    if (tid < 256) *(LAS f32x4*)(lrs + (tid >> 2) * 16 + 4 * (tid & 3)) = *(const f32x4*)(SM + ((size_t)b * T + 64 * c + (tid >> 2)) * 64 + 24 + 4 * (tid & 3));
    __syncthreads();
#pragma unroll
    for (int j = 0; j < 8; ++j) { const LAS float* lr = lrs + (8 * tg + j) * 16; float z = bias;
#pragma unroll
        for (int r4 = 0; r4 < 4; ++r4) { const f32x4 v = *(const LAS f32x4*)(lr + 4 * r4); z += v[0] * wcol[4 * r4] + v[1] * wcol[4 * r4 + 1] + v[2] * wcol[4 * r4 + 2] + v[3] * wcol[4 * r4 + 3]; }
        const float la = (fminf(z, 0.f) - __logf(1.f + __expf(-fabsf(z)))) * (1.f / 16.f); run += la; vals[j] = run; }
    tot[tg * 64 + dk] = run;
    __syncthreads();
    float pre = 0.f;
#pragma unroll
    for (int g2 = 0; g2 < 7; ++g2) pre += (g2 < tg) ? tot[g2 * 64 + dk] : 0.f;
#pragma unroll
    for (int j = 0; j < 8; ++j) cum[(8 * tg + j) * 65 + dk] = vals[j] + pre;
    __syncthreads();
}
constexpr int GL_CUM = 0, GL_TOT = 16640, GL_KT = 18688, GL_VT = 27904, GL_SSQ = 46336;
__device__ __forceinline__ void gla_local_item(int item, const Args& a, LAS unsigned char* lds, int tid, int wave, int lane) {
    unsigned char* ws = a.ws; const bf16* PROJ = (const bf16*)(ws + WS_PROJ);
    const int b = item >> 9, h = (item >> 7) & 3, c = item & 127, fr = lane & 15, fq = lane >> 4;
    LAS float* cum = (LAS float*)(lds + GL_CUM); LAS float* tot = (LAS float*)(lds + GL_TOT); LAS bf16* KT = (LAS bf16*)(lds + GL_KT); LAS bf16* VT = (LAS bf16*)(lds + GL_VT);
    gla_cum(cum, tot, (const float*)(ws + WS_SMALL), a.in[9], a.in[10], b, h, c, tid);
    { const int s = tid >> 3, u = tid & 7; const size_t row = (size_t)b * T + 64 * c + s; const bf16x8 kr = *(const bf16x8*)(PROJ + row * PLD + PC_KG + h * 64 + 8 * u);
      const int pos = (s & 32) + perm32k(s & 31);
#pragma unroll
      for (int e = 0; e < 8; ++e) { const int dk = 8 * u + e; KT[dk * 72 + pos] = f2bf(bf2f(kr[e]) * __expf(cum[63 * 65 + dk] - cum[s * 65 + dk])); } }
#pragma unroll
    for (int it = 0; it < 2; ++it) { const int id = tid + 512 * it, s = id >> 4, u = id & 15; const size_t row = (size_t)b * T + 64 * c + s;
        const bf16x8 vr = *(const bf16x8*)(PROJ + row * PLD + PC_VG + h * 128 + 8 * u); const int pos = (s & 32) + perm32k(s & 31);
#pragma unroll
        for (int e = 0; e < 8; ++e) VT[(8 * u + e) * 72 + pos] = (bf16)vr[e]; }
    if (tid < 64) ((float*)(ws + WS_DEC))[(size_t)item * 64 + tid] = __expf(cum[63 * 65 + tid]);
    __syncthreads();
    bf16* LS = (bf16*)((unsigned char*)a.out + DO_L);
#pragma unroll
    for (int dkt = 0; dkt < 4; ++dkt) { f32x4 acc = {0.f, 0.f, 0.f, 0.f};
#pragma unroll
        for (int ks = 0; ks < 2; ++ks) { const bf16x8 av = *(const LAS bf16x8*)(VT + (16 * wave + fr) * 72 + 32 * ks + 8 * fq); const bf16x8 bv = *(const LAS bf16x8*)(KT + (16 * dkt + fr) * 72 + 32 * ks + 8 * fq); acc = MFMA16(av, bv, acc); }
#pragma unroll
        for (int i = 0; i < 4; ++i) { const float nb = __shfl_xor(acc[i], 1); if (!(fr & 1)) *(unsigned*)(LS + ((size_t)item * 128 + 16 * wave + 4 * fq + i) * 64 + 16 * dkt + fr) = pk2(acc[i], nb); } }
    __syncthreads();
}
__device__ __forceinline__ void gla_out_item(int item, const Args& a, LAS unsigned char* lds, int tid, int wave, int lane) {
    unsigned char* ws = a.ws; const bf16* PROJ = (const bf16*)(ws + WS_PROJ);
    const int b = item >> 9, h = (item >> 7) & 3, c = item & 127, fr = lane & 15, fq = lane >> 4, tt = wave & 3, hh = wave >> 2;
    LAS bf16* VT = (LAS bf16*)(lds + GL_VT);
    LAS float* cum = (LAS float*)(lds + GL_CUM); LAS float* tot = (LAS float*)(lds + GL_TOT); LAS float* ssqb = (LAS float*)(lds + GL_SSQ);
    gla_cum(cum, tot, (const float*)(ws + WS_SMALL), a.in[9], a.in[10], b, h, c, tid);
#pragma unroll
    for (int it = 0; it < 2; ++it) { const int id = tid + 512 * it, s = id >> 4, u = id & 15; const size_t row = (size_t)b * T + 64 * c + s;
        const bf16x8 vr = *(const bf16x8*)(PROJ + row * PLD + PC_VG + h * 128 + 8 * u); const int pos = (s & 32) + perm32k(s & 31);
#pragma unroll
        for (int e = 0; e < 8; ++e) VT[(8 * u + e) * 72 + pos] = (bf16)vr[e]; }
    __syncthreads();
    const int tokq = 16 * tt + fr; const size_t rowq = (size_t)b * T + 64 * c + tokq;
    bf16x8 qf[2];
#pragma unroll
    for (int ks = 0; ks < 2; ++ks) { const bf16x8 raw = *(const bf16x8*)(PROJ + rowq * PLD + PC_QG + h * 64 + 32 * ks + 8 * fq);
#pragma unroll
        for (int e = 0; e < 8; ++e) qf[ks][e] = (short)f2bf(bf2f(raw[e]) * __expf(cum[tokq * 65 + 32 * ks + 8 * fq + e])); }
    f32x4 at[4];
#pragma unroll
    for (int st = 0; st < 4; ++st) { at[st] = (f32x4){0.f, 0.f, 0.f, 0.f};
        if (st <= tt) { const int s = 16 * st + fr; const size_t rows = (size_t)b * T + 64 * c + s; bf16x8 kf[2];
#pragma unroll
            for (int ks = 0; ks < 2; ++ks) { const bf16x8 raw = *(const bf16x8*)(PROJ + rows * PLD + PC_KG + h * 64 + 32 * ks + 8 * fq);
#pragma unroll
                for (int e = 0; e < 8; ++e) kf[ks][e] = (short)f2bf(bf2f(raw[e]) * __expf(-cum[s * 65 + 32 * ks + 8 * fq + e])); }
            at[st] = MFMA16(kf[0], qf[0], at[st]); at[st] = MFMA16(kf[1], qf[1], at[st]);
            if (st == tt) {
#pragma unroll
                for (int i = 0; i < 4; ++i) if (4 * fq + i > fr) at[st][i] = 0.f; } } }
    bf16x8 pf[2];
#pragma unroll
    for (int k2 = 0; k2 < 2; ++k2) { const u32x4 w = {pk2(at[2 * k2][0], at[2 * k2][1]), pk2(at[2 * k2][2], at[2 * k2][3]), pk2(at[2 * k2 + 1][0], at[2 * k2 + 1][1]), pk2(at[2 * k2 + 1][2], at[2 * k2 + 1][3])}; pf[k2] = __builtin_bit_cast(bf16x8, w); }
    const bf16* LS = (const bf16*)((const unsigned char*)a.out + DO_S);
    f32x4 o[4]; float ssq = 0.f;
#pragma unroll
    for (int j = 0; j < 4; ++j) { const int dv0 = 64 * hh + 16 * j; f32x4 acc = {0.f, 0.f, 0.f, 0.f};
#pragma unroll
        for (int ks = 0; ks < 2; ++ks) { const bf16x8 sf = *(const bf16x8*)(LS + ((size_t)item * 128 + dv0 + fr) * 64 + 32 * ks + 8 * fq); acc = MFMA16(sf, qf[ks], acc); }
#pragma unroll
        for (int k2 = 0; k2 < 2; ++k2) { const bf16x8 vf = *(const LAS bf16x8*)(VT + (dv0 + fr) * 72 + 32 * k2 + 8 * fq); acc = MFMA16(vf, pf[k2], acc); }
        o[j] = acc; ssq += (acc[0] * acc[0] + acc[1] * acc[1]) + (acc[2] * acc[2] + acc[3] * acc[3]); }
    ssq += __shfl_xor(ssq, 16); ssq += __shfl_xor(ssq, 32);
    if (fq == 0) ssqb[hh * 64 + tokq] = ssq;
    __syncthreads();
    const float rstd = rsqrtf((ssqb[tokq] + ssqb[64 + tokq]) * (1.f / 128.f) + EPS);
#pragma unroll
    for (int j = 0; j < 4; ++j) { const int dvb = 64 * hh + 16 * j + 4 * fq; const f32x4 gn = *(const f32x4*)(a.in[11] + dvb); const bf16* rp = PROJ + rowq * PLD + PC_RG + h * 128 + dvb; bf16* op = (bf16*)((unsigned char*)a.out + DO_OB) + rowq * 512 + h * 128 + dvb;
        const u32x2 rw = *(const u32x2*)rp; const float r0 = bflo(rw.x), r1 = bfhi(rw.x), r2 = bflo(rw.y), r3 = bfhi(rw.y);
        u32x2 w; w.x = pk2(o[j][0] * rstd * gn[0] * siluf_(r0), o[j][1] * rstd * gn[1] * siluf_(r1)); w.y = pk2(o[j][2] * rstd * gn[2] * siluf_(r2), o[j][3] * rstd * gn[3] * siluf_(r3));
        *(u32x2*)op = w; }
    __syncthreads();
}

constexpr int GL2_STRIDE = 53248;
__device__ __forceinline__ void gla_cum2(LAS float* cum, LAS float* tot, LAS float* lrs, const float* SM, const float* w2, const float* gb, int b, int h, int c, int th) {
    const int dk = th & 63, tg = __builtin_amdgcn_readfirstlane(th >> 6);
    float wcol[16];
#pragma unroll
    for (int r = 0; r < 16; ++r) wcol[r] = w2[r * 256 + h * 64 + dk];
    const float bias = gb[h * 64 + dk]; float run = 0.f, vals[16];
    *(LAS f32x4*)(lrs + (th >> 2) * 16 + 4 * (th & 3)) = *(const f32x4*)(SM + ((size_t)b * T + 64 * c + (th >> 2)) * 64 + 24 + 4 * (th & 3));
    __syncthreads();
#pragma unroll
    for (int j = 0; j < 16; ++j) { const LAS float* lr = lrs + (16 * tg + j) * 16; float z = bias;
#pragma unroll
        for (int r4 = 0; r4 < 4; ++r4) { const f32x4 v = *(const LAS f32x4*)(lr + 4 * r4); z += v[0] * wcol[4 * r4] + v[1] * wcol[4 * r4 + 1] + v[2] * wcol[4 * r4 + 2] + v[3] * wcol[4 * r4 + 3]; }
        const float la = (fminf(z, 0.f) - __logf(1.f + __expf(-fabsf(z)))) * (1.f / 16.f); run += la; vals[j] = run; }
    tot[tg * 64 + dk] = run;
    __syncthreads();
    float pre = 0.f;
#pragma unroll
    for (int g2 = 0; g2 < 3; ++g2) pre += (g2 < tg) ? tot[g2 * 64 + dk] : 0.f;
#pragma unroll
    for (int j = 0; j < 16; ++j) cum[(16 * tg + j) * 65 + dk] = vals[j] + pre;
    __syncthreads();
}
__device__ __forceinline__ void gla_local_pair(int pair, const Args& a, LAS unsigned char* lds0, int tid, int wave, int lane) {
    unsigned char* ws = a.ws; const bf16* PROJ = (const bf16*)(ws + WS_PROJ);
    const int half = tid >> 8, th = tid & 255, wv = wave & 3, item = 2 * pair + half;
    LAS unsigned char* lds = lds0 + half * GL2_STRIDE;
    const int b = item >> 9, h = (item >> 7) & 3, c = item & 127, fr = lane & 15, fq = lane >> 4;
    LAS float* cum = (LAS float*)(lds + GL_CUM); LAS float* tot = (LAS float*)(lds + GL_TOT); LAS bf16* KT = (LAS bf16*)(lds + GL_KT); LAS bf16* VT = (LAS bf16*)(lds + GL_VT);
    gla_cum2(cum, tot, (LAS float*)(lds + 47360), (const float*)(ws + WS_SMALL), a.in[9], a.in[10], b, h, c, th);
#pragma unroll
    for (int it = 0; it < 2; ++it) { const int id = th + 256 * it, s = id >> 3, u = id & 7; const size_t row = (size_t)b * T + 64 * c + s; const bf16x8 kr = *(const bf16x8*)(PROJ + row * PLD + PC_KG + h * 64 + 8 * u);
        const int pos = (s & 32) + perm32k(s & 31);
#pragma unroll
        for (int e = 0; e < 8; ++e) { const int dk = 8 * u + e; KT[dk * 72 + pos] = f2bf(bf2f(kr[e]) * __expf(cum[63 * 65 + dk] - cum[s * 65 + dk])); } }
#pragma unroll
    for (int it = 0; it < 4; ++it) { const int id = th + 256 * it, s = id >> 4, u = id & 15; const size_t row = (size_t)b * T + 64 * c + s;
        const bf16x8 vr = *(const bf16x8*)(PROJ + row * PLD + PC_VG + h * 128 + 8 * u); const int pos = (s & 32) + perm32k(s & 31);
#pragma unroll
        for (int e = 0; e < 8; ++e) VT[(8 * u + e) * 72 + pos] = (bf16)vr[e]; }
    if (th < 64) ((float*)(ws + WS_DEC))[(size_t)item * 64 + th] = __expf(cum[63 * 65 + th]);
    __syncthreads();
    bf16* LS = (bf16*)((unsigned char*)a.out + DO_L);
#pragma unroll
    for (int q2 = 0; q2 < 2; ++q2) { const int dvt = 2 * wv + q2;
#pragma unroll
      for (int dkt = 0; dkt < 4; ++dkt) { f32x4 acc = {0.f, 0.f, 0.f, 0.f};
#pragma unroll
        for (int ks = 0; ks < 2; ++ks) { const bf16x8 av = *(const LAS bf16x8*)(VT + (16 * dvt + fr) * 72 + 32 * ks + 8 * fq); const bf16x8 bv = *(const LAS bf16x8*)(KT + (16 * dkt + fr) * 72 + 32 * ks + 8 * fq); acc = MFMA16(av, bv, acc); }
#pragma unroll
        for (int i = 0; i < 4; ++i) { const float nb = __shfl_xor(acc[i], 1); if (!(fr & 1)) *(unsigned*)(LS + ((size_t)item * 128 + 16 * dvt + 4 * fq + i) * 64 + 16 * dkt + fr) = pk2(acc[i], nb); } } }
    __syncthreads();
}
__device__ __forceinline__ void gla_out_pair(int pair, const Args& a, LAS unsigned char* lds0, int tid, int wave, int lane) {
    unsigned char* ws = a.ws; const bf16* PROJ = (const bf16*)(ws + WS_PROJ);
    const int half = tid >> 8, th = tid & 255, tt = wave & 3, item = 2 * pair + half;
    LAS unsigned char* lds = lds0 + half * GL2_STRIDE;
    const int b = item >> 9, h = (item >> 7) & 3, c = item & 127, fr = lane & 15, fq = lane >> 4;
    LAS bf16* VT = (LAS bf16*)(lds + GL_VT); LAS float* cum = (LAS float*)(lds + GL_CUM); LAS float* tot = (LAS float*)(lds + GL_TOT);
    const bf16* LSp = (const bf16*)((const unsigned char*)a.out + DO_S); bf16x8 sfr[8][2];
#pragma unroll
    for (int j = 0; j < 8; ++j)
#pragma unroll
        for (int ks = 0; ks < 2; ++ks) sfr[j][ks] = *(const bf16x8*)(LSp + ((size_t)item * 128 + 16 * j + fr) * 64 + 32 * ks + 8 * fq);
    gla_cum2(cum, tot, (LAS float*)(lds + 47360), (const float*)(ws + WS_SMALL), a.in[9], a.in[10], b, h, c, th);
#pragma unroll
    for (int it = 0; it < 4; ++it) { const int id = th + 256 * it, s = id >> 4, u = id & 15; const size_t row = (size_t)b * T + 64 * c + s;
        const bf16x8 vr = *(const bf16x8*)(PROJ + row * PLD + PC_VG + h * 128 + 8 * u); const int pos = (s & 32) + perm32k(s & 31);
#pragma unroll
        for (int e = 0; e < 8; ++e) VT[(8 * u + e) * 72 + pos] = (bf16)vr[e]; }
    LAS bf16* KE = (LAS bf16*)(lds + GL_KT);
    { const int s = th >> 2, qd = th & 3; const bf16* kp = PROJ + ((size_t)b * T + 64 * c + s) * PLD + PC_KG + h * 64 + 16 * qd; const bf16x8 r0 = *(const bf16x8*)kp, r1 = *(const bf16x8*)(kp + 8);
      float f[16];
#pragma unroll
      for (int e = 0; e < 8; ++e) { f[e] = bf2f(r0[e]) * __expf(-cum[s * 65 + 16 * qd + e]); f[8 + e] = bf2f(r1[e]) * __expf(-cum[s * 65 + 16 * qd + 8 + e]); }
      *(LAS u32x4*)(KE + s * 72 + 16 * qd) = (u32x4){pk2(f[0], f[1]), pk2(f[2], f[3]), pk2(f[4], f[5]), pk2(f[6], f[7])};
      *(LAS u32x4*)(KE + s * 72 + 16 * qd + 8) = (u32x4){pk2(f[8], f[9]), pk2(f[10], f[11]), pk2(f[12], f[13]), pk2(f[14], f[15])}; }
    __syncthreads();
    const int tokq = 16 * tt + fr; const size_t rowq = (size_t)b * T + 64 * c + tokq;
    bf16x8 qf[2];
#pragma unroll
    for (int ks = 0; ks < 2; ++ks) { const bf16x8 raw = *(const bf16x8*)(PROJ + rowq * PLD + PC_QG + h * 64 + 32 * ks + 8 * fq);
#pragma unroll
        for (int e = 0; e < 8; ++e) qf[ks][e] = (short)f2bf(bf2f(raw[e]) * __expf(cum[tokq * 65 + 32 * ks + 8 * fq + e])); }
    f32x4 at[4];
#pragma unroll
    for (int st = 0; st < 4; ++st) { at[st] = (f32x4){0.f, 0.f, 0.f, 0.f};
        if (st <= tt) { const int s = 16 * st + fr; bf16x8 kf[2];
#pragma unroll
            for (int ks = 0; ks < 2; ++ks) kf[ks] = *(const LAS bf16x8*)(KE + s * 72 + 32 * ks + 8 * fq);
            at[st] = MFMA16(kf[0], qf[0], at[st]); at[st] = MFMA16(kf[1], qf[1], at[st]);
            if (st == tt) {
#pragma unroll
                for (int i = 0; i < 4; ++i) if (4 * fq + i > fr) at[st][i] = 0.f; } } }
    bf16x8 pf[2];
#pragma unroll
    for (int k2 = 0; k2 < 2; ++k2) { const u32x4 w = {pk2(at[2 * k2][0], at[2 * k2][1]), pk2(at[2 * k2][2], at[2 * k2][3]), pk2(at[2 * k2 + 1][0], at[2 * k2 + 1][1]), pk2(at[2 * k2 + 1][2], at[2 * k2 + 1][3])}; pf[k2] = __builtin_bit_cast(bf16x8, w); }
    f32x4 o[8]; float ssq = 0.f;
#pragma unroll
    for (int j = 0; j < 8; ++j) { const int dv0 = 16 * j; f32x4 acc = {0.f, 0.f, 0.f, 0.f};
#pragma unroll
        for (int ks = 0; ks < 2; ++ks) acc = MFMA16(sfr[j][ks], qf[ks], acc);
#pragma unroll
        for (int k2 = 0; k2 < 2; ++k2) { const bf16x8 vf = *(const LAS bf16x8*)(VT + (dv0 + fr) * 72 + 32 * k2 + 8 * fq); acc = MFMA16(vf, pf[k2], acc); }
        o[j] = acc; ssq += (acc[0] * acc[0] + acc[1] * acc[1]) + (acc[2] * acc[2] + acc[3] * acc[3]); }
    ssq += __shfl_xor(ssq, 16); ssq += __shfl_xor(ssq, 32);
    const float rstd = rsqrtf(ssq * (1.f / 128.f) + EPS);
#pragma unroll
    for (int j = 0; j < 8; ++j) { const int dvb = 16 * j + 4 * fq; const f32x4 gn = *(const f32x4*)(a.in[11] + dvb); const bf16* rp = PROJ + rowq * PLD + PC_RG + h * 128 + dvb; bf16* op = (bf16*)((unsigned char*)a.out + DO_OB) + rowq * 512 + h * 128 + dvb;
        const u32x2 rw = *(const u32x2*)rp; const float r0 = bflo(rw.x), r1 = bfhi(rw.x), r2 = bflo(rw.y), r3 = bfhi(rw.y);
        u32x2 w; w.x = pk2(o[j][0] * rstd * gn[0] * siluf_(r0), o[j][1] * rstd * gn[1] * siluf_(r1)); w.y = pk2(o[j][2] * rstd * gn[2] * siluf_(r2), o[j][3] * rstd * gn[3] * siluf_(r3));
        *(u32x2*)op = w; }
    __syncthreads();
}

__device__ __forceinline__ void gla_scan(unsigned char* ws, unsigned char* dout, LAS unsigned char* lds, int tid) {
    LAS float* sx = (LAS float*)lds;
    const int seg = tid >> 7, el = tid & 127;
    for (int e0 = blockIdx.x * 128; e0 < 8 * 128 * 32; e0 += gridDim.x * 128) { const int e = e0 + el;
        const int bh = e >> 12, dv = (e >> 5) & 127, dkp = e & 31;
        const size_t eo = (((size_t)bh * 128 * 128 + dv) * 64) / 2 + dkp; const unsigned* p = (const unsigned*)(dout + DO_L) + eo + (size_t)(32 * seg) * 4096; unsigned* ps = (unsigned*)(dout + DO_S) + eo + (size_t)(32 * seg) * 4096;
        const float* dp = (const float*)(ws + WS_DEC) + (size_t)bh * 128 * 64 + 2 * dkp + (32 * seg) * 64;
        float r0 = 0.f, r1 = 0.f, D0 = 1.f, D1 = 1.f;
#pragma unroll 16
        for (int c = 0; c < 32; ++c) { const unsigned w = p[(size_t)c * 4096]; const float d0 = dp[c * 64], d1 = dp[c * 64 + 1]; r0 = d0 * r0 + bflo(w); r1 = d1 * r1 + bfhi(w); D0 *= d0; D1 *= d1; }
        *(LAS f32x4*)(sx + (seg * 128 + el) * 4) = (f32x4){r0, r1, D0, D1};
        __syncthreads();
        r0 = 0.f; r1 = 0.f;
        for (int k = 0; k < seg; ++k) { const f32x4 v = *(const LAS f32x4*)(sx + (k * 128 + el) * 4); r0 = v[2] * r0 + v[0]; r1 = v[3] * r1 + v[1]; }
#pragma unroll 16
        for (int c = 0; c < 32; ++c) { const unsigned w = p[(size_t)c * 4096]; const float d0 = dp[c * 64], d1 = dp[c * 64 + 1]; ps[(size_t)c * 4096] = pk2(r0, r1); r0 = d0 * r0 + bflo(w); r1 = d1 * r1 + bfhi(w); }
        __syncthreads();
    }
}
constexpr int NT_TILE = 16384, NT_V = 8192, NT_TPS = 3, NT_R = 2 * NT_TPS, NS_WAVE = NT_R * NT_TILE, NS_WSZ = 2176, NS_UX = NS_WAVE + 8 * NS_WSZ, NS_JL = NS_UX + 128;
template <bool LOADV, class DescF, class CompF>
__device__ __forceinline__ void tile_loop(int n, DescF desc, CompF comp, LAS unsigned char* tb, int tid) {
    if (n <= 0) return;
#define NT_BAR() asm volatile("s_waitcnt lgkmcnt(0)\n\ts_barrier" ::: "memory")
    const int row = tid >> 3, unit = tid & 7, ns = (n + NT_TPS - 1) / NT_TPS;
    u32x4 kr[NT_TPS], vr[NT_TPS];
#define NT_GL(j) do { _Pragma("unroll") for (int u_ = 0; u_ < NT_TPS; ++u_) { int i_ = NT_TPS * (j) + u_; i_ = i_ < n ? i_ : n - 1; const bf16 *Kg_, *Vg_; int kp_, vp_; desc(i_, Kg_, kp_, Vg_, vp_); \
        kr[u_] = *(const u32x4*)(Kg_ + (size_t)row * kp_ + unit * 8); if (LOADV) vr[u_] = *(const u32x4*)(Vg_ + (size_t)row * vp_ + unit * 8); else vr[u_] = (u32x4){0u, 0u, 0u, 0u}; } } while (0)
#define NT_LS(half) do { _Pragma("unroll") for (int u_ = 0; u_ < NT_TPS; ++u_) { LAS unsigned char* p_ = tb + ((half) * NT_TPS + u_) * NT_TILE + row * 128 + ((unit ^ (row & 7)) * 16); \
        *(LAS u32x4*)p_ = kr[u_]; if (LOADV) *(LAS u32x4*)(p_ + NT_V) = vr[u_]; } } while (0)
    NT_GL(0); NT_LS(0);
    NT_BAR();
    for (int j = 0; j < ns; ++j) {
        if (j + 1 < ns) NT_GL(j + 1);
#pragma unroll
        for (int u = 0; u < NT_TPS; ++u) { const int i = NT_TPS * j + u; if (i < n) comp(i, tb + ((j & 1) * NT_TPS + u) * NT_TILE); }
        if (j + 1 < ns) NT_LS((j + 1) & 1);
        NT_BAR();
    }
#undef NT_GL
#undef NT_BAR
#undef NT_LS
}
__device__ __forceinline__ void lds_scores(f32x4 (&s)[4], const LAS unsigned char* buf, const bf16x8 (&q)[2], int fr, int fq, float cinit = 0.f) {
    const f32x4 c4 = {cinit, cinit, cinit, cinit};
#pragma unroll
    for (int h2 = 0; h2 < 2; ++h2) { bf16x8 kf[2][2];
#pragma unroll
        for (int t2 = 0; t2 < 2; ++t2) { const LAS unsigned char* kp = buf + (16 * (2 * h2 + t2) + fr) * 128; kf[t2][0] = *(const LAS bf16x8*)(kp + ((fq ^ (fr & 7)) * 16)); kf[t2][1] = *(const LAS bf16x8*)(kp + (((fq + 4) ^ (fr & 7)) * 16)); }
        asm volatile("" ::: "memory");
        __builtin_amdgcn_s_setprio(1);
#pragma unroll
        for (int t2 = 0; t2 < 2; ++t2) { s[2 * h2 + t2] = MFMA16(kf[t2][0], q[0], c4); s[2 * h2 + t2] = MFMA16(kf[t2][1], q[1], s[2 * h2 + t2]); }
        __builtin_amdgcn_s_setprio(0); }
}
__device__ __forceinline__ void lds_pv(f32x4 (&O)[4], const LAS unsigned char* buf, const f32x4 (&p)[4], int fr, int fq) {
    bf16x8 pf[2];
#pragma unroll
    for (int k2 = 0; k2 < 2; ++k2) { const u32x4 w = {pk2(p[2 * k2][0], p[2 * k2][1]), pk2(p[2 * k2][2], p[2 * k2][3]), pk2(p[2 * k2 + 1][0], p[2 * k2 + 1][1]), pk2(p[2 * k2 + 1][2], p[2 * k2 + 1][3])}; pf[k2] = __builtin_bit_cast(bf16x8, w); }
#pragma unroll
    for (int h2 = 0; h2 < 2; ++h2) { bf16x8 vf[2][2];
#pragma unroll
        for (int d2 = 0; d2 < 2; ++d2) { const LAS unsigned char* vp = buf + NT_V + (16 * (2 * h2 + d2) + fr) * 128; vf[d2][0] = *(const LAS bf16x8*)(vp + ((fq ^ (fr & 7)) * 16)); vf[d2][1] = *(const LAS bf16x8*)(vp + (((fq + 4) ^ (fr & 7)) * 16)); }
        asm volatile("" ::: "memory");
        __builtin_amdgcn_s_setprio(1);
#pragma unroll
        for (int d2 = 0; d2 < 2; ++d2) { O[2 * h2 + d2] = MFMA16(vf[d2][0], pf[0], O[2 * h2 + d2]); O[2 * h2 + d2] = MFMA16(vf[d2][1], pf[1], O[2 * h2 + d2]); }
        __builtin_amdgcn_s_setprio(0); }
}
template <int MODE, class MaskF>
__device__ __forceinline__ void attn_tile(const LAS unsigned char* buf, const bf16x8 (&q)[2], float& m, bool& st, float& l, f32x4 (&O)[4], bool rowsel, MaskF mask, int fr, int fq) {
    f32x4 s[4]; lds_scores(s, buf, q, fr, fq, (MODE == 1 && !rowsel) ? -INFINITY : -m);
    if (MODE == 2) {
#pragma unroll
        for (int t = 0; t < 4; ++t)
#pragma unroll
            for (int i = 0; i < 4; ++i) s[t][i] = mask(16 * t + 4 * fq + i) ? s[t][i] : -INFINITY; }
    float mx = max16f_(s);
    if (__builtin_amdgcn_ballot_w64(mx > 8.f || (!st && mx > -INFINITY)) != 0ull) {
        mx = fmaxf(mx, __shfl_xor(mx, 16)); mx = fmaxf(mx, __shfl_xor(mx, 32));
        const float dl = st ? fmaxf(mx, 0.f) : (mx > -INFINITY ? mx : 0.f), alpha = st ? __builtin_amdgcn_exp2f(-dl) : 1.f; st = st || (mx > -INFINITY); m += dl; l *= alpha;
#pragma unroll
        for (int dt = 0; dt < 4; ++dt) O[dt] = O[dt] * alpha;
#pragma unroll
        for (int t = 0; t < 4; ++t)
#pragma unroll
            for (int i = 0; i < 4; ++i) s[t][i] -= dl; }
    float rs = 0.f;
#pragma unroll
    for (int t = 0; t < 4; ++t)
#pragma unroll
        for (int i = 0; i < 4; ++i) { const float p = __builtin_amdgcn_exp2f(s[t][i]); s[t][i] = p; rs += p; }
    l += rs;
    lds_pv(O, buf, s, fr, fq);
}
__device__ __forceinline__ void nsa_block_item(int idx, unsigned char* ws, bf16* OA, LAS unsigned char* lds, int tid, int wave, int lane) {
    const bf16* PROJ = (const bf16*)(ws + WS_PROJ); const bf16* KROT = (const bf16*)(ws + WS_KROT);
    const int fr = lane & 15, fq = lane >> 4;
    const int ti = 255 - (idx >> 2), bg = idx & 3, b = bg >> 1, g = bg & 1, tb0 = 32 * ti, t0 = tb0 + 4 * wave;
    const int tokj = fr >> 2, hh = fr & 3, trow = t0 + tokj; const size_t grow = (size_t)b * T + trow;
    LAS unsigned char* wl = lds + NS_WAVE + wave * NS_WSZ;
    LAS float* imp = (LAS float*)wl; LAS unsigned* selw = (LAS unsigned*)(wl + 2112);
    LAS unsigned* ux = (LAS unsigned*)(lds + NS_UX); LAS unsigned char* jl = lds + NS_JL;
    bf16x8 qraw[2], qrot[2];
#pragma unroll
    for (int ks = 0; ks < 2; ++ks) { qraw[ks] = *(const bf16x8*)(PROJ + grow * PLD + PC_QN + (g * 4 + hh) * 64 + 32 * ks + 8 * fq);
        qrot[ks] = qraw[ks]; }
    if (fq < 2) qrot[0] = *(const bf16x8*)((const bf16*)(ws + WS_QROT) + grow * 128 + (g * 4 + hh) * 16 + 8 * fq);
    for (int i = lane; i < 528; i += 64) imp[i] = 0.f;
    f32x4 Ot[4];
#pragma unroll
    for (int dt = 0; dt < 4; ++dt) Ot[dt] = (f32x4){0.f, 0.f, 0.f, 0.f};
    const float* gp = (const float*)(ws + WS_SMALL) + grow * 64 + (g * 4 + hh) * 3;
    {
        const int nvr = trow >= 31 ? ((trow - 31) >> 4) + 1 : 0; const int nv0 = t0 >= 31 ? ((t0 - 31) >> 4) + 1 : 0; const int tl = tb0 + 31; const int nvm = tl >= 31 ? ((tl - 31) >> 4) + 1 : 0; const int ntile = (nvm + 63) >> 6;
        const bf16* Kc = (const bf16*)(ws + WS_KCMP) + (size_t)bg * 512 * 64; const bf16* Vc = (const bf16*)(ws + WS_VCMPT) + (size_t)bg * 64 * 512;
        auto desc = [&](int i, const bf16*& Kg, int& kp, const bf16*& Vg, int& vp) { Kg = Kc + (size_t)(64 * i) * 64; kp = 64; Vg = Vc + 64 * i; vp = 512; };
        float m = NEGB, l = 0.f;
        tile_loop<false>(ntile, desc, [&](int kt, const LAS unsigned char* buf) {
            f32x4 s[4]; lds_scores(s, buf, qraw, fr, fq);
            if (64 * kt + 64 > nv0) {
#pragma unroll
                for (int t = 0; t < 4; ++t)
#pragma unroll
                    for (int i = 0; i < 4; ++i) s[t][i] = (64 * kt + 16 * t + 4 * fq + i) < nvr ? s[t][i] : -INFINITY; }
            float mx = max16f_(s);
            if (__builtin_amdgcn_ballot_w64(mx > m + 8.f) != 0ull) { mx = fmaxf(mx, __shfl_xor(mx, 16)); mx = fmaxf(mx, __shfl_xor(mx, 32)); const float mn = fmaxf(m, mx); l *= __builtin_amdgcn_exp2f(m - mn); m = mn; }
            float rs = 0.f;
#pragma unroll
            for (int t = 0; t < 4; ++t)
#pragma unroll
                for (int i = 0; i < 4; ++i) rs += __builtin_amdgcn_exp2f(s[t][i] - m);
            l += rs; }, lds, tid);
        l += __shfl_xor(l, 16); l += __shfl_xor(l, 32);
        const float invl = l > 0.f ? 1.f / l : 0.f;
        f32x4 Oc[4];
#pragma unroll
        for (int dt = 0; dt < 4; ++dt) Oc[dt] = (f32x4){0.f, 0.f, 0.f, 0.f};
        tile_loop<true>(ntile, desc, [&](int kt, const LAS unsigned char* buf) {
            f32x4 s[4]; lds_scores(s, buf, qraw, fr, fq);
#pragma unroll
            for (int t = 0; t < 4; ++t)
#pragma unroll
                for (int i = 0; i < 4; ++i) { const bool okk = (64 * kt + 16 * t + 4 * fq + i) < nvr; s[t][i] = okk ? __builtin_amdgcn_exp2f(s[t][i] - m) * invl : 0.f; }
            lds_pv(Oc, buf, s, fr, fq);
#pragma unroll
            for (int t = 0; t < 4; ++t) { float s3 = (s[t][0] + s[t][1]) + (s[t][2] + s[t][3]), p3 = s[t][3];
                s3 += __shfl_xor(s3, 1); s3 += __shfl_xor(s3, 2); p3 += __shfl_xor(p3, 1); p3 += __shfl_xor(p3, 2);
                const int q = 16 * kt + 4 * t + fq;
                if (hh == 0) imp[tokj * 132 + q] += s3;
                asm volatile("s_waitcnt lgkmcnt(0)" ::: "memory");
                if (hh == 0) imp[tokj * 132 + q + 1] += p3;
                asm volatile("s_waitcnt lgkmcnt(0)" ::: "memory"); } }, lds, tid);
        const float gc = sigmoidf_(gp[0]);
#pragma unroll
        for (int dt = 0; dt < 4; ++dt) Ot[dt] = Oc[dt] * gc;
    }
    const int cur = tb0 >> 6;
    { const int tok = lane >> 4, sub = lane & 15; unsigned key[8]; bool cand[8];
#define ROW_SUM(x) do { x += __builtin_amdgcn_update_dpp(0, x, 0xB1, 0xF, 0xF, true); x += __builtin_amdgcn_update_dpp(0, x, 0x4E, 0xF, 0xF, true); \
        x += __builtin_amdgcn_update_dpp(0, x, 0x141, 0xF, 0xF, true); x += __builtin_amdgcn_update_dpp(0, x, 0x140, 0xF, 0xF, true); } while (0)
#pragma unroll
        for (int e = 0; e < 8; ++e) { const int j = 8 * sub + e; cand[e] = (j >= 1 && j <= cur - 2); key[e] = cand[e] ? __float_as_uint(imp[tok * 132 + j]) : 0u; }
        unsigned selb = 0;
        if (cur - 2 > 13) {
            unsigned tau = 0u;
            for (int bit = 30; bit >= 0; --bit) { const unsigned t = tau | (1u << bit); int c = 0;
#pragma unroll
                for (int e = 0; e < 8; ++e) c += (key[e] >= t) ? 1 : 0;
                ROW_SUM(c); tau = (c >= 13) ? t : tau; }
            int cg = 0, tc = 0;
#pragma unroll
            for (int e = 0; e < 8; ++e) { cg += (cand[e] && key[e] > tau) ? 1 : 0; tc += (cand[e] && key[e] == tau) ? 1 : 0; }
            ROW_SUM(cg); const int need = 13 - cg;
            int inc = tc; inc += __builtin_amdgcn_update_dpp(0, inc, 0x111, 0xF, 0xF, true); inc += __builtin_amdgcn_update_dpp(0, inc, 0x112, 0xF, 0xF, true);
            inc += __builtin_amdgcn_update_dpp(0, inc, 0x114, 0xF, 0xF, true); inc += __builtin_amdgcn_update_dpp(0, inc, 0x118, 0xF, 0xF, true);
            int before = inc - tc;
#pragma unroll
            for (int e = 0; e < 8; ++e) { const bool tie = cand[e] && key[e] == tau; const bool sl = cand[e] && (key[e] > tau || (tie && before < need)); before += tie ? 1 : 0; selb |= sl ? (1u << e) : 0u; }
        } else {
#pragma unroll
            for (int e = 0; e < 8; ++e) selb |= cand[e] ? (1u << e) : 0u; }
#undef ROW_SUM
        unsigned bits = 0;
#pragma unroll
        for (int e = 0; e < 8; ++e) { const int j = 8 * sub + e; const bool sel = (j <= cur) && (j == 0 || j >= cur - 1 || ((selb >> e) & 1u)); bits |= sel ? (1u << e) : 0u; }
        ((LAS unsigned char*)selw)[tok * 16 + sub] = (unsigned char)bits; }
    asm volatile("s_waitcnt lgkmcnt(0)" ::: "memory");
    unsigned sw[4], un[4];
#pragma unroll
    for (int w = 0; w < 4; ++w) { sw[w] = selw[tokj * 4 + w]; un[w] = __builtin_amdgcn_readfirstlane(selw[w] | selw[4 + w] | selw[8 + w] | selw[12 + w]); }
    if (lane == 0) { ux[wave * 4 + 0] = un[0]; ux[wave * 4 + 1] = un[1]; ux[wave * 4 + 2] = un[2]; ux[wave * 4 + 3] = un[3]; }
    __syncthreads();
    unsigned U[4];
#pragma unroll
    for (int w = 0; w < 4; ++w) { unsigned u = 0;
#pragma unroll
        for (int v2 = 0; v2 < 8; ++v2) u |= ux[v2 * 4 + w];
        U[w] = __builtin_amdgcn_readfirstlane(u); }
    const int nsl = __builtin_popcount(U[0]) + __builtin_popcount(U[1]) + __builtin_popcount(U[2]) + __builtin_popcount(U[3]);
    if (tid < 128) { const int w = tid >> 5, bit = tid & 31; const unsigned uw = w == 0 ? U[0] : w == 1 ? U[1] : w == 2 ? U[2] : U[3];
        if ((uw >> bit) & 1u) { int pos = __builtin_popcount(uw & ((1u << bit) - 1u)); if (w > 0) pos += __builtin_popcount(U[0]); if (w > 1) pos += __builtin_popcount(U[1]); if (w > 2) pos += __builtin_popcount(U[2]); jl[pos] = (unsigned char)tid; } }
    __syncthreads();
    {
        const bf16* Ks = KROT + ((size_t)g * M + (size_t)b * T) * 64; const bf16* Vs = (const bf16*)(ws + WS_VTS) + (size_t)bg * 128 * 4096;
        float m = 0.f, l = 0.f; bool st = false; f32x4 Os[4];
#pragma unroll
        for (int dt = 0; dt < 4; ++dt) Os[dt] = (f32x4){0.f, 0.f, 0.f, 0.f};
        tile_loop<true>(nsl, [&](int i, const bf16*& Kg, int& kp, const bf16*& Vg, int& vp) { const int j = jl[i]; Kg = Ks + (size_t)(64 * j) * 64; kp = 64; Vg = Vs + (size_t)j * 4096; vp = 64; },
            [&](int i, const LAS unsigned char* buf) { const int j = __builtin_amdgcn_readfirstlane((int)jl[i]); const int w = j >> 5, bit = j & 31;
                const unsigned uw = w == 0 ? un[0] : w == 1 ? un[1] : w == 2 ? un[2] : un[3];
                if (!((uw >> bit) & 1u)) return;
                const unsigned swv = w == 0 ? sw[0] : w == 1 ? sw[1] : w == 2 ? sw[2] : sw[3]; const bool rowsel = (swv >> bit) & 1u;
                if (j < cur) attn_tile<1>(buf, qrot, m, st, l, Os, rowsel, [&](int) { return true; }, fr, fq);
                else attn_tile<2>(buf, qrot, m, st, l, Os, rowsel, [&](int kk) { return rowsel && (64 * j + kk <= trow); }, fr, fq); }, lds, tid);
        l += __shfl_xor(l, 16); l += __shfl_xor(l, 32);
        const float gs = sigmoidf_(gp[1]) * (l > 0.f ? 1.f / l : 0.f);
#pragma unroll
        for (int dt = 0; dt < 4; ++dt) Ot[dt] += Os[dt] * gs;
    }
    {
        const bf16* Kw = KROT + ((size_t)(2 + g) * M + (size_t)b * T) * 64; const bf16* Vw = (const bf16*)(ws + WS_VTW) + (size_t)bg * 128 * 4096;
        float m = 0.f, l = 0.f; bool st = false; f32x4 Ow[4];
#pragma unroll
        for (int dt = 0; dt < 4; ++dt) Ow[dt] = (f32x4){0.f, 0.f, 0.f, 0.f};
        const int jlo = (tb0 > 511 ? tb0 - 511 : 0) >> 6, jhi = (tb0 + 31) >> 6;
        tile_loop<true>(jhi - jlo + 1, [&](int i, const bf16*& Kg, int& kp, const bf16*& Vg, int& vp) { const int j = jlo + i; Kg = Kw + (size_t)(64 * j) * 64; kp = 64; Vg = Vw + (size_t)j * 4096; vp = 64; },
            [&](int i, const LAS unsigned char* buf) { const int j = jlo + i;
                if (64 * j + 63 + 511 < t0 || 64 * j > t0 + 3) return;
                if (64 * j + 511 >= t0 + 3 && 64 * j + 63 <= t0) attn_tile<0>(buf, qrot, m, st, l, Ow, true, [&](int) { return true; }, fr, fq);
                else attn_tile<2>(buf, qrot, m, st, l, Ow, true, [&](int kk) { const int key = 64 * j + kk; return key <= trow && key + 511 >= trow; }, fr, fq); }, lds, tid);
        l += __shfl_xor(l, 16); l += __shfl_xor(l, 32);
        const float gw = sigmoidf_(gp[2]) * (l > 0.f ? 1.f / l : 0.f);
#pragma unroll
        for (int dt = 0; dt < 4; ++dt) Ot[dt] += Ow[dt] * gw;
    }
#pragma unroll
    for (int dt = 0; dt < 4; ++dt) { u32x2 w; w.x = pk2(Ot[dt][0], Ot[dt][1]); w.y = pk2(Ot[dt][2], Ot[dt][3]); *(u32x2*)(OA + grow * 512 + (g * 4 + hh) * 64 + 16 * dt + 4 * fq) = w; }
    __syncthreads();
}

#define XB_TMO      128
#define XB_XCNT(j)  (256  + 64 * (j))
#define XB_XSUB(j)  (1280 + 64 * (j))
#define XB_XGEN(j)  (2304 + 64 * (j))
#define XB_TOP      3328
#define XB_TOPGEN   3392
#define XCD_BAR_WORDS 3456
#define XB_SPIN_CAP (1u << 18)

__device__ __forceinline__ unsigned xb_ld(unsigned* p)              { return __hip_atomic_load(p, __ATOMIC_RELAXED, __HIP_MEMORY_SCOPE_AGENT); }
__device__ __forceinline__ unsigned xb_add(unsigned* p, unsigned v) { return __hip_atomic_fetch_add(p, v, __ATOMIC_RELAXED, __HIP_MEMORY_SCOPE_AGENT); }
__device__ __forceinline__ unsigned xb_xcc_id() { return (unsigned)__builtin_amdgcn_s_getreg((3 << 11) | 20) & 0xFu; }
#define XB_SPIN(cond, bar) do { unsigned _sp = 0; while (cond) { __builtin_amdgcn_s_sleep(1); \
    if ((++_sp & 255u) == 0u) { if (xb_ld(&(bar)[XB_TMO])) break; if (_sp > XB_SPIN_CAP) { atomicAdd(&(bar)[XB_TMO], 1u); break; } } } } while (0)

struct XcdBarrier {
    unsigned* bar; unsigned x;
    volatile LAS unsigned* st;
};

__device__ __forceinline__ XcdBarrier xcd_barrier_post(unsigned* bar, volatile LAS unsigned* st) {
    XcdBarrier b; b.bar = bar; b.x = xb_xcc_id(); b.st = st;
    if (threadIdx.x == 0) (void)xb_add(&bar[XB_XCNT(b.x)], 1u);
    return b;
}
__device__ __forceinline__ void xcd_barrier_complete(unsigned* bar, unsigned x, unsigned& nloc, unsigned& nx) {
    const unsigned G = gridDim.x * gridDim.y * gridDim.z;
    unsigned sum, cnt, mine, sp = 0u;
    for (;;) {
        sum = 0u; cnt = 0u; mine = 0u;
#pragma unroll
        for (unsigned j = 0; j < 16; ++j) { const unsigned c = xb_ld(&bar[XB_XCNT(j)]); sum += c; cnt += (c > 0u) ? 1u : 0u; mine = (j == x) ? c : mine; }
        if (sum == G) break;
        __builtin_amdgcn_s_sleep(1);
        if ((++sp & 255u) == 0u) { if (xb_ld(&bar[XB_TMO])) break; if (sp > XB_SPIN_CAP) { atomicAdd(&bar[XB_TMO], 1u); break; } }
    }
    nloc = mine > 0u ? mine : 1u; nx = cnt > 0u ? cnt : 1u;
}

__device__ __forceinline__ void xcd_barrier(const XcdBarrier& b) {
    asm volatile("s_waitcnt vmcnt(0)" ::: "memory");
    __syncthreads();
    if (threadIdx.x == 0) {
        unsigned* bar = b.bar;
        __builtin_amdgcn_s_waitcnt(0);
        unsigned nloc = b.st[0], nx = b.st[1];
        if (nloc == 0u) { xcd_barrier_complete(bar, b.x, nloc, nx); b.st[0] = nloc; b.st[1] = nx; }
        const unsigned old = xb_add(&bar[XB_XSUB(b.x)], 1u);
        const unsigned gen = old / nloc;
        if (old + 1u == (gen + 1u) * nloc) {
            __builtin_amdgcn_fence(__ATOMIC_RELEASE, "agent");
            asm volatile("s_waitcnt vmcnt(0)" ::: "memory");
            const unsigned og = xb_add(&bar[XB_TOP], 1u);
            const unsigned tg = og / nx;
            if (og + 1u == (tg + 1u) * nx) xb_add(&bar[XB_TOPGEN], 1u);
            else XB_SPIN(xb_ld(&bar[XB_TOPGEN]) == tg, bar);
            __builtin_amdgcn_fence(__ATOMIC_ACQUIRE, "agent");
            xb_add(&bar[XB_XGEN(b.x)], 1u);
            asm volatile("s_waitcnt vmcnt(0)" ::: "memory");
        } else {
            XB_SPIN(xb_ld(&bar[XB_XGEN(b.x)]) == gen, bar);
            __builtin_amdgcn_fence(__ATOMIC_ACQUIRE, "agent");
            asm volatile("s_waitcnt vmcnt(0)" ::: "memory");
        }
    }
    __syncthreads();
}

__global__ void __launch_bounds__(NTHR, 2) fwd_megakernel(Args a) {
    extern __shared__ __attribute__((aligned(16))) unsigned char lds_raw[];
    cg::grid_group grid = cg::this_grid();
    unsigned bar_k_ = 0;
#define GRID_SYNC() do { asm volatile("s_waitcnt vmcnt(0) lgkmcnt(0)" ::: "memory"); __syncthreads(); \
    if (threadIdx.x == 0) { unsigned* bw_ = (unsigned*)(a.ws + WS_CTL) + 16384; const unsigned G_ = gridDim.x, k1_ = bar_k_ + 1u; \
        __builtin_amdgcn_fence(__ATOMIC_RELEASE, "agent"); asm volatile("s_waitcnt vmcnt(0)" ::: "memory"); \
        if (G_ % 16u) { __hip_atomic_fetch_add(bw_, 1u, __ATOMIC_RELAXED, __HIP_MEMORY_SCOPE_AGENT); while (__hip_atomic_load(bw_, __ATOMIC_RELAXED, __HIP_MEMORY_SCOPE_AGENT) < k1_ * G_) __builtin_amdgcn_s_sleep(1); } \
        else { const unsigned grp_ = blockIdx.x >> 4; unsigned* gc_ = bw_ + 64u * (1u + grp_); unsigned* gr_ = bw_ + 64u * (33u + grp_); \
            if (__hip_atomic_fetch_add(gc_, 1u, __ATOMIC_RELAXED, __HIP_MEMORY_SCOPE_AGENT) == k1_ * 16u - 1u) { __hip_atomic_fetch_add(bw_, 1u, __ATOMIC_RELAXED, __HIP_MEMORY_SCOPE_AGENT); \
                while (__hip_atomic_load(bw_, __ATOMIC_RELAXED, __HIP_MEMORY_SCOPE_AGENT) < k1_ * (G_ >> 4)) __builtin_amdgcn_s_sleep(1); \
                __hip_atomic_store(gr_, k1_, __ATOMIC_RELAXED, __HIP_MEMORY_SCOPE_AGENT); } \
            else { while (__hip_atomic_load(gr_, __ATOMIC_RELAXED, __HIP_MEMORY_SCOPE_AGENT) < k1_) __builtin_amdgcn_s_sleep(1); } } \
        __builtin_amdgcn_fence(__ATOMIC_ACQUIRE, "agent"); asm volatile("s_waitcnt vmcnt(0)" ::: "memory"); } \
    ++bar_k_; __syncthreads(); } while (0)
    grid.sync();
    LAS unsigned char* lds = (LAS unsigned char*)lds_raw;
    unsigned char* ws = a.ws;
    const int tid = threadIdx.x, lane = tid & 63, wave = __builtin_amdgcn_readfirstlane(tid >> 6);
    const int G = gridDim.x, bx = blockIdx.x;
    bf16* PROJ = (bf16*)(ws + WS_PROJ);
    float* ROWSQ1 = (float*)(ws + WS_RSQ1); float* ROWSQ2 = (float*)(ws + WS_RSQ2);

    { LAS unsigned* z_ = (LAS unsigned*)(lds + 131072 + 64); if (tid < 2) z_[tid] = 0u; }
    __syncthreads();
    int vb = bx;
    { LAS unsigned* cw = (LAS unsigned*)(lds + 131072);
      if (tid == 0) { const unsigned x = (unsigned)__builtin_amdgcn_s_getreg((3 << 11) | 20) & 0xFu; const unsigned r = __hip_atomic_fetch_add((unsigned*)(ws + WS_CTL) + 64 + 64 * x, 1u, __ATOMIC_RELAXED, __HIP_MEMORY_SCOPE_AGENT);
          cw[0] = (x < 8u && r < (unsigned)(G / 8) && (G % 8) == 0) ? (r * 8u + x) : 0xffffffffu; }
      __syncthreads();
      const unsigned v = cw[0]; vb = (v == 0xffffffffu) ? -1 : (int)v; }
    bf16* OA = (bf16*)((unsigned char*)a.out + DO_OA); bf16* OB = (bf16*)((unsigned char*)a.out + DO_OB);
#ifndef REPEAT_P
#define REPEAT_P -1
#endif
#define PHASE_REP(k) for (int rep_ = 0; rep_ < ((REPEAT_P == (k)) ? 2 : 1); ++rep_)
    p0_prologue(a, lds, wave, lane);
    if (vb < 0) { if (tid == 0) __hip_atomic_fetch_add((unsigned*)(ws + WS_CTL) + 32, 1u, __ATOMIC_RELAXED, __HIP_MEMORY_SCOPE_AGENT); }
    GRID_SYNC();
    if (__hip_atomic_load((unsigned*)(ws + WS_CTL) + 32, __ATOMIC_RELAXED, __HIP_MEMORY_SCOPE_AGENT) != 0u) vb = bx;
    PHASE_REP(1) { pg8::Gemm g{(const bf16*)(ws + WS_XN), (const bf16*)(ws + WS_WIN), M, NIN, D, D}; pg8::StaticOrder S; S.init(M, NIN, G, vb);
      EpiProj E{PROJ, (float*)(ws + WS_SMALL), (bf16*)(ws + WS_CSRC)};
      pg8::gemm_phase<EpiProj, pg8::StaticOrder, true, true>(lds, g, S, E);
    GRID_SYNC(); }
    PHASE_REP(2) {
    { const int vv_ = vb >= 0 ? vb : bx; const int grp_ = (vv_ & 7) * (G / 32) + (vv_ >> 5), sub_ = (vv_ >> 3) & 3;
      if (G == 256) compress_item(grp_, sub_, ws, lds, wave, lane); else if (bx < 64) for (int q_ = 0; q_ < 4; ++q_) compress_item(bx, q_, ws, lds, wave, lane); }
    for (int it = bx; it < 512; it += G) gla_local_pair(it, a, lds, tid, wave, lane);
    for (int it = (G - 1 - bx) * NWAVES + wave; it < 256 * 2; it += G * NWAVES) p2a_item(it, ws, lds + wave * 18432, lane);
    for (int it = bx * NWAVES + wave; it < M / 8; it += G * NWAVES) rope_item(it, ws, lane);
    GRID_SYNC(); }
    PHASE_REP(3) {
    gla_scan(ws, (unsigned char*)a.out, lds, tid);
    __syncthreads();
    { const int vv_ = vb >= 0 ? vb : bx; const int xcc_ = vv_ & 7, q_ = ((xcc_ >> 2) * (G / 8) + (vv_ >> 3)), nq_ = 2 * (G / 8);
      for (int r_ = 0; r_ * nq_ < 256; ++r_) { const int o_ = (r_ & 1) ? (nq_ - 1 - q_) : q_; const int tr_ = r_ * nq_ + o_; if (tr_ >= 256) continue;
        const int idx = (tr_ << 2) | (xcc_ & 3);
        nsa_block_item(idx, ws, OA, lds, tid, wave, lane); } }
    GRID_SYNC(); }
    PHASE_REP(4) {
    for (int it = bx; it < 512; it += G) gla_out_pair(it, a, lds, tid, wave, lane);
    GRID_SYNC(); }
    PHASE_REP(5) {
    { pg8::Gemm g{OA, (const bf16*)(ws + WS_WUPA), 2 * M, 2 * D, 512, 512}; UpOrder S; S.so.init(M, D, G, vb);
      EpiUp2 E{PROJ, PROJ, PLD};
      pg8::gemm_phase<EpiUp2, UpOrder, true, true>(lds, g, S, E); }
    { pg8::StaticOrder S; S.init(M, D, G, vb); pg8::Unit u; S.next(0, u);
      asm volatile("s_waitcnt vmcnt(0) lgkmcnt(0)" ::: "memory"); __syncthreads();
      if (tid == 0) { __builtin_amdgcn_fence(__ATOMIC_RELEASE, "agent"); asm volatile("s_waitcnt vmcnt(0)" ::: "memory");
          unsigned* c_ = (unsigned*)(ws + WS_CTL) + 12288 + 64 * u.pm; __hip_atomic_fetch_add(c_, 1u, __ATOMIC_RELAXED, __HIP_MEMORY_SCOPE_AGENT);
          while (__hip_atomic_load(c_, __ATOMIC_RELAXED, __HIP_MEMORY_SCOPE_AGENT) < 4u) __builtin_amdgcn_s_sleep(1);
          __builtin_amdgcn_fence(__ATOMIC_ACQUIRE, "agent"); asm volatile("s_waitcnt vmcnt(0)" ::: "memory"); }
      __syncthreads(); } }
    PHASE_REP(6) {
    { pg8::Gemm g{PROJ, (const bf16*)(ws + WS_WOUT), M, D, D, PLD}; pg8::StaticOrder S; S.init(M, D, G, vb);
      EpiRes<true> E{a.in[0], a.out, (bf16*)(ws + WS_XB), ROWSQ1};
      pg8::gemm_phase<EpiRes<true>, pg8::StaticOrder, false, true>(lds, g, S, E); }
    GRID_SYNC(); }
    PHASE_REP(7) {
    { pg8::Gemm g{(const bf16*)(ws + WS_XB), (const bf16*)(ws + WS_WGU), M, NGU, D, D}; pg8::StaticOrder S; S.init(M, NGU, G, vb);
      EpiFfn E{(bf16*)(ws + WS_H), ROWSQ1};
      pg8::gemm_phase<EpiFfn, pg8::StaticOrder, true, true>(lds, g, S, E); }
    GRID_SYNC(); }
    { pg8::Gemm g{(const bf16*)(ws + WS_H), (const bf16*)(ws + WS_WDN), M, D, DFF, DFF}; pg8::StaticOrder S; S.init(M, D, G, vb);
      EpiFinal E{(const bf16*)(ws + WS_XB), a.out, ROWSQ2, (unsigned*)(ws + WS_CTL) + 8192, a.in[19]};
      pg8::gemm_phase<EpiFinal, pg8::StaticOrder, false, true>(lds, g, S, E); }
}

extern "C" void kernel_launch(void* const* d_in, const int* in_sizes, int n_in, void* d_out, int out_size, void* d_ws, size_t ws_size, hipStream_t stream) {
    static int grid = 0;
    if (grid == 0) {
        if (n_in != 20 || in_sizes[0] != M * D || out_size != M * D || ws_size < WS_END) { fprintf(stderr, "kernel_launch: unexpected shapes (n_in %d, in0 %d, out %d, ws %zu)\n", n_in, n_in > 0 ? in_sizes[0] : -1, out_size, ws_size); grid = -1; return; }
        int dev = 0, cus = 0, per_cu = 0;
        hipGetDevice(&dev); hipDeviceGetAttribute(&cus, hipDeviceAttributeMultiprocessorCount, dev);
        hipFuncSetAttribute((const void*)fwd_megakernel, hipFuncAttributeMaxDynamicSharedMemorySize, LDS_BYTES);
        hipOccupancyMaxActiveBlocksPerMultiprocessor(&per_cu, (const void*)fwd_megakernel, NTHR, LDS_BYTES);
        if (per_cu < 1) { fprintf(stderr, "kernel_launch: occupancy query says %d blocks per CU\n", per_cu); per_cu = 1; }
        (void)hipGetLastError();
        grid = cus * per_cu; if (grid > 256) grid = 256;
        if (grid != 256) { fprintf(stderr, "kernel_launch: this kernel needs exactly 256 co-resident workgroups (one 256x256 output tile per workgroup in the fused epilogues); the device offers %d; nothing launched\n", grid); grid = -1; return; }
    }
    if (grid < 0) return;
    (void)hipMemsetAsync((char*)d_ws + WS_CTL, 0, 98304, stream);
    Args a{};
    for (int i = 0; i < 20; ++i) a.in[i] = (const float*)d_in[i];
    a.out = (float*)d_out; a.ws = (unsigned char*)d_ws;
    void* args[] = {&a};
    hipError_t e = hipLaunchCooperativeKernel((const void*)fwd_megakernel, dim3(grid), dim3(NTHR), args, LDS_BYTES, stream);
    if (e != hipSuccess) fprintf(stderr, "cooperative launch failed: %s (grid %d)\n", hipGetErrorString(e), grid);
}
```

```cpp
#include <hip/hip_runtime.h>
#include <hip/hip_cooperative_groups.h>
#include <cstdio>
#include <cstdint>
namespace cg = cooperative_groups;
namespace pg8 {
#define PG8_LAS __attribute__((address_space(3)))
typedef unsigned short bf16_t;
typedef short bf16x8 __attribute__((ext_vector_type(8)));
typedef float f32x4 __attribute__((ext_vector_type(4)));
typedef unsigned u32x4 __attribute__((ext_vector_type(4)));
constexpr int BM = 256, BK = 64, HALF = 128, HTB = HALF * BK * 2  , STAGE_BYTES = 8 * HTB, NXCD = 8, WGM = 8;

__host__ __device__ __forceinline__ int lds_byte(int r, int c) { const int st = (r >> 4) * 2 + (c >> 5), rr = r & 15, cc = c & 31, ob = rr * 64 + cc * 2; return st * 1024 + (ob ^ (((ob >> 9) & 1) << 5)); }
__host__ __device__ __forceinline__ void stage_rc(int b, int& R, int& C) { const int st = b / 1024, sb = b % 1024, swz = sb ^ (((sb >> 9) & 1) << 5); R = (st >> 1) * 16 + swz / 64; C = (st & 1) * 32 + (swz % 64) / 2; }
__host__ __device__ __forceinline__ int perm32(int rho) { const int n = rho >> 4, i = rho & 15; return 8 * (i >> 2) + 4 * n + (i & 3); }

struct Unit { int pm, pn; };
struct Gemm { const bf16_t* A; const bf16_t* Bt; int M, N, K, lda; };

struct StaticOrder {
    int nM, nN, nwg, G, c;
    __host__ __device__ void init(int M, int N, int G_, int c_) { nM = M / BM; nN = N / BM; nwg = nM * nN; G = G_; c = c_; }
    __host__ __device__ bool next(int i, Unit& u) const {
        const long L = (long)i * G + c; if (L >= nwg) return false;
        int wgid = (int)L; { const int q = nwg / NXCD, r = nwg % NXCD, xcd = wgid % NXCD, off = wgid / NXCD; wgid = (xcd < r ? xcd * (q + 1) : r * (q + 1) + (xcd - r) * q) + off; }
        const int nig = WGM * nN, gid = wgid / nig, fm = gid * WGM, gsz = (nM - fm) < WGM ? (nM - fm) : WGM;
        u.pm = fm + ((wgid % nig) % gsz); u.pn = (wgid % nig) / gsz; return true;
    }
    __device__ __forceinline__ void a_ready(const Unit&) const {}
    __device__ __forceinline__ void done(const Unit&) const {}
};

__device__ __forceinline__ unsigned cvt_pk_bf16(float lo, float hi) { unsigned r; asm volatile("v_cvt_pk_bf16_f32 %0, %1, %2" : "=v"(r) : "v"(lo), "v"(hi)); return r; }
template <class Epi, class Sched, bool ALIGN_EPI = false, bool SP2 = false>
__device__ __forceinline__ void gemm_phase(PG8_LAS unsigned char* lds, const Gemm g, const Sched& S, const Epi& E) {
    int tid_ = threadIdx.x; asm volatile("" : "+v"(tid_));
    const int tid = tid_, wid = __builtin_amdgcn_readfirstlane(tid >> 6), lane = tid & 63, wr = wid >> 2, wc = wid & 3, fr = lane & 15, fq = lane >> 4;
    const int K = g.K, nt = K / BK;
    unsigned voffA[2], voffB[2];
#pragma unroll
    for (int i = 0; i < 2; ++i) { int R, C; stage_rc(tid * 16 + i * 8192, R, C); const int Rb = Epi::PERM ? ((R & ~31) + perm32(R & 31)) : R;
        voffA[i] = (unsigned)(R * g.lda + C) * 2u; voffB[i] = (unsigned)(Rb * K + C) * 2u; }
    const size_t kstep = (size_t)(BK * 2);
    const size_t hstep = (size_t)HALF * K * 2;
    const size_t tstep = 2 * hstep; const size_t hstepA = (size_t)HALF * g.lda * 2, tstepA = 2 * hstepA;
    const unsigned ldsw = (unsigned)wid * 1024u;
    const int aoff = lds_byte(wr * 64 + fr, fq * 8), boff = lds_byte(wc * 32 + fr, fq * 8);
#define PG8_SA(b, h) (((b) * 2 + (h)) * HTB)
#define PG8_SB(b, h) ((4 + (b) * 2 + (h)) * HTB)
#define PG8_STAGE(bufoff, gbase, voff) do { _Pragma("unroll") for (int _i = 0; _i < 2; ++_i) \
        __builtin_amdgcn_global_load_lds((const unsigned*)((const char*)(gbase) + (voff)[_i]), (PG8_LAS unsigned*)(lds + (bufoff) + ldsw + _i * 8192), 16, 0, 0); } while (0)
#define PG8_LDA(dst, b, h) do { _Pragma("unroll") for (int m = 0; m < 4; ++m) _Pragma("unroll") for (int k = 0; k < 2; ++k) dst[m][k] = *(const PG8_LAS bf16x8*)(lds + PG8_SA(b, h) + aoff + m * 2048 + k * 1024); } while (0)
#define PG8_LDB(dst, b, h) do { _Pragma("unroll") for (int n = 0; n < 2; ++n) _Pragma("unroll") for (int k = 0; k < 2; ++k) dst[n][k] = *(const PG8_LAS bf16x8*)(lds + PG8_SB(b, h) + boff + n * 2048 + k * 1024); } while (0)
#define PG8_MMA(ai, bj, At, Bt) do { __builtin_amdgcn_s_setprio(1); _Pragma("unroll") for (int m = 0; m < 4; ++m) _Pragma("unroll") for (int n = 0; n < 2; ++n) _Pragma("unroll") for (int k = 0; k < 2; ++k) \
        acc[ai][bj][m][n] = __builtin_amdgcn_mfma_f32_16x16x32_bf16(Bt[n][k], At[m][k], acc[ai][bj][m][n], 0, 0, 0); __builtin_amdgcn_s_setprio(0); } while (0)
#define PG8_WAIT_V(n) asm volatile("s_waitcnt vmcnt(" #n ")" ::: "memory")
#define PG8_WAIT_L(n) asm volatile("s_waitcnt lgkmcnt(" #n ")" ::: "memory")
#define PG8_BAR __builtin_amdgcn_s_barrier()
#define PG8_SCHED __builtin_amdgcn_sched_barrier(0)
    Unit cur, nxt; int ui = 0;
    if (!S.next(0, cur)) return;
    f32x4 acc[2][2][4][2];
#pragma unroll
    for (int a = 0; a < 2; ++a)
#pragma unroll
        for (int b = 0; b < 2; ++b)
#pragma unroll
            for (int m = 0; m < 4; ++m)
#pragma unroll
                for (int n = 0; n < 2; ++n) acc[a][b][m][n] = (f32x4){0.f, 0.f, 0.f, 0.f};
    bf16x8 At[4][2], B0[2][2], B1[2][2];
    const char* cA = (const char*)g.A + (size_t)cur.pm * tstepA; const char* cB = (const char*)g.Bt + (size_t)cur.pn * tstep;
    S.a_ready(cur);
    if constexpr (SP2) {
        PG8_STAGE(PG8_SB(0, 0), cB, voffB); PG8_STAGE(PG8_SB(0, 1), cB + hstep, voffB); PG8_STAGE(PG8_SA(0, 0), cA, voffA); PG8_STAGE(PG8_SA(0, 1), cA + hstepA, voffA);
        if (wr == 1) PG8_BAR;
        PG8_WAIT_V(2); PG8_BAR;
        PG8_STAGE(PG8_SB(1, 0), cB + kstep, voffB); PG8_STAGE(PG8_SA(1, 0), cA + kstep, voffA); PG8_STAGE(PG8_SB(1, 1), cB + hstep + kstep, voffB);
        PG8_WAIT_V(6); PG8_BAR;
    } else {
        PG8_STAGE(PG8_SB(0, 0), cB, voffB); PG8_STAGE(PG8_SA(0, 0), cA, voffA); PG8_STAGE(PG8_SB(0, 1), cB + hstep, voffB); PG8_STAGE(PG8_SA(0, 1), cA + hstepA, voffA);
        if (wr == 1) PG8_BAR;
        PG8_WAIT_V(4); PG8_BAR;
        PG8_STAGE(PG8_SB(1, 0), cB + kstep, voffB); PG8_STAGE(PG8_SA(1, 0), cA + kstep, voffA); PG8_STAGE(PG8_SB(1, 1), cB + hstep + kstep, voffB);
        PG8_WAIT_V(6); PG8_BAR;
    }
    for (;;) {
        const bool has_next = S.next(ui + 1, nxt);
        const char* nA = has_next ? (const char*)g.A + (size_t)nxt.pm * tstepA : cA; const char* nB = has_next ? (const char*)g.Bt + (size_t)nxt.pn * tstep : cB;
        for (int t = 0; t < nt; t += 2) {
            const bool last = (t == nt - 2);
            const char* a1 = cA + (size_t)(t + 1) * kstep;
            const char* a2 = last ? nA : cA + (size_t)(t + 2) * kstep; const char* b2 = last ? nB : cB + (size_t)(t + 2) * kstep;
            const char* a3 = a2 + kstep; const char* b3 = b2 + kstep;
            if (last && has_next) S.a_ready(nxt);
            if constexpr (SP2) {
            PG8_LDB(B0, 0, 0); PG8_LDB(B1, 0, 1); PG8_SCHED; PG8_LDA(At, 0, 0); PG8_STAGE(PG8_SA(1, 1), a1 + hstepA, voffA);
            PG8_WAIT_V(8); PG8_WAIT_L(0); PG8_BAR; PG8_MMA(0, 0, At, B0); PG8_MMA(0, 1, At, B1); PG8_BAR; PG8_SCHED;
            PG8_LDA(At, 0, 1); PG8_STAGE(PG8_SB(0, 0), b2, voffB); PG8_STAGE(PG8_SB(0, 1), b2 + hstep, voffB); PG8_STAGE(PG8_SA(0, 0), a2, voffA);
            PG8_WAIT_V(8); PG8_WAIT_L(0); PG8_BAR; PG8_MMA(1, 0, At, B0); PG8_MMA(1, 1, At, B1); PG8_BAR; PG8_SCHED;
            PG8_LDB(B0, 1, 0); PG8_LDB(B1, 1, 1); PG8_SCHED; PG8_LDA(At, 1, 0); PG8_STAGE(PG8_SA(0, 1), a2 + hstepA, voffA);
            PG8_WAIT_V(8); PG8_WAIT_L(0); PG8_BAR; PG8_MMA(0, 0, At, B0); PG8_MMA(0, 1, At, B1); PG8_BAR; PG8_SCHED;
            PG8_LDA(At, 1, 1); PG8_STAGE(PG8_SB(1, 0), b3, voffB); PG8_STAGE(PG8_SB(1, 1), b3 + hstep, voffB); PG8_STAGE(PG8_SA(1, 0), a3, voffA);
            PG8_WAIT_V(8); PG8_WAIT_L(0); PG8_BAR; PG8_MMA(1, 0, At, B0); PG8_MMA(1, 1, At, B1); PG8_BAR; PG8_SCHED;
            } else {
            PG8_LDB(B0, 0, 0); PG8_SCHED; PG8_LDA(At, 0, 0); PG8_STAGE(PG8_SA(1, 1), a1 + hstepA, voffA);
            PG8_WAIT_L(8); PG8_BAR; PG8_WAIT_L(0); PG8_MMA(0, 0, At, B0); PG8_BAR; PG8_SCHED;
            PG8_LDB(B1, 0, 1); PG8_STAGE(PG8_SB(0, 0), b2, voffB);
            PG8_BAR; PG8_WAIT_L(0); PG8_MMA(0, 1, At, B1); PG8_BAR;
            PG8_LDA(At, 0, 1); PG8_STAGE(PG8_SA(0, 0), a2, voffA);
            PG8_BAR; PG8_WAIT_L(0); PG8_MMA(1, 0, At, B0); PG8_BAR; PG8_SCHED;
            PG8_STAGE(PG8_SB(0, 1), b2 + hstep, voffB);
            PG8_WAIT_V(6); PG8_BAR; PG8_MMA(1, 1, At, B1); PG8_BAR;
            PG8_LDB(B0, 1, 0); PG8_SCHED; PG8_LDA(At, 1, 0); PG8_STAGE(PG8_SA(0, 1), a2 + hstepA, voffA);
            PG8_WAIT_L(8); PG8_BAR; PG8_WAIT_L(0); PG8_MMA(0, 0, At, B0); PG8_BAR; PG8_SCHED;
            PG8_LDB(B1, 1, 1); PG8_STAGE(PG8_SB(1, 0), b3, voffB);
            PG8_BAR; PG8_WAIT_L(0); PG8_MMA(0, 1, At, B1); PG8_BAR;
            PG8_LDA(At, 1, 1); PG8_STAGE(PG8_SA(1, 0), a3, voffA);
            PG8_BAR; PG8_WAIT_L(0); PG8_MMA(1, 0, At, B0); PG8_BAR; PG8_SCHED;
            PG8_STAGE(PG8_SB(1, 1), b3 + hstep, voffB);
            PG8_WAIT_V(6); PG8_BAR; PG8_MMA(1, 1, At, B1); PG8_BAR;
            }
        }
        if constexpr (ALIGN_EPI) { if (wr == 0) PG8_BAR; }
        if constexpr (!Epi::AFTER_DRAIN) { E(acc, cur, wr, wc, fr, fq); S.done(cur); }
        if (!has_next) break;
#pragma unroll
        for (int a = 0; a < 2; ++a)
#pragma unroll
            for (int b = 0; b < 2; ++b)
#pragma unroll
                for (int m = 0; m < 4; ++m)
#pragma unroll
                    for (int n = 0; n < 2; ++n) acc[a][b][m][n] = (f32x4){0.f, 0.f, 0.f, 0.f};
        cur = nxt; cA = nA; cB = nB; ++ui;
        if constexpr (ALIGN_EPI) { if (wr == 1) PG8_BAR; }
    }
    PG8_WAIT_V(0);
    if constexpr (!ALIGN_EPI) { if (wr == 0) PG8_BAR; }
    PG8_BAR;
    if constexpr (Epi::AFTER_DRAIN) { E.fused(acc, cur, wr, wc, fr, fq, lds, wid, lane); S.done(cur); }
#undef PG8_SA
#undef PG8_SB
#undef PG8_STAGE
#undef PG8_LDA
#undef PG8_LDB
#undef PG8_MMA
#undef PG8_WAIT_V
#undef PG8_WAIT_L
#undef PG8_BAR
#undef PG8_SCHED
}
}

#define LAS __attribute__((address_space(3)))
typedef unsigned short bf16;
typedef short bf16x8 __attribute__((ext_vector_type(8)));
typedef float f32x4 __attribute__((ext_vector_type(4)));
typedef unsigned u32x4 __attribute__((ext_vector_type(4)));
typedef unsigned u32x2 __attribute__((ext_vector_type(2)));
constexpr int NWAVES = 8, NTHR = 512;
constexpr int BATCH = 2, T = 8192, D = 1024, M = BATCH * T, DFF = 2816;
constexpr int PLD = 4864;
constexpr int PC_QN = 0, PC_KV = 512, PC_QG = 1280, PC_KG = 1536, PC_VG = 1792, PC_RG = 2304, PC_GM = 2816;
constexpr int NIN = 5120, NGU = 5632;
constexpr float EPS = 1e-6f, NEGB = -1e30f;
constexpr size_t MiB = 1u << 20;
constexpr size_t WS_CTL = 0, CTL_BYTES = 1 * MiB;
constexpr size_t WS_WIN = 1 * MiB, WS_WGU = 11 * MiB, WS_WDN = 22 * MiB, WS_WOUT = 28 * MiB, WS_WUPA = 30 * MiB, WS_WUPB = 31 * MiB;
constexpr size_t WS_CW1K = 32 * MiB, WS_CW1V = 32 * MiB + 512 * 1024, WS_CW2K = 33 * MiB, WS_CW2V = 33 * MiB + 16384;
constexpr size_t WS_KCMP = 33 * MiB + 65536, WS_VCMPT = 33 * MiB + 65536 + 262144;
constexpr size_t WS_ROPE = 34 * MiB, WS_SMALL = 35 * MiB, WS_DEC = 39 * MiB, WS_RSQ1 = 39 * MiB + 262144, WS_RSQ2 = 39 * MiB + 524288;
constexpr size_t WS_XN = 40 * MiB, WS_XB = 40 * MiB;
constexpr size_t WS_PROJ = 72 * MiB, WS_H = 72 * MiB;
constexpr size_t WS_QROT = 224 * MiB, WS_CSRC = 228 * MiB, WS_KROT = 240 * MiB, WS_VTS = 248 * MiB, WS_VTW = 252 * MiB, WS_END = 256 * MiB;
constexpr size_t DO_L = 0, DO_S = 16 * MiB, DO_OA = 32 * MiB, DO_OB = 48 * MiB;
constexpr int LDS_BYTES = 147456;

__device__ __forceinline__ unsigned pk2(float lo, float hi) { return pg8::cvt_pk_bf16(lo, hi); }
__device__ __forceinline__ float bflo(unsigned w) { return __uint_as_float(w << 16); }
__device__ __forceinline__ float bfhi(unsigned w) { return __uint_as_float(w & 0xffff0000u); }
__device__ __forceinline__ float bf2f(short s) { return __uint_as_float(((unsigned)(unsigned short)s) << 16); }
__device__ __forceinline__ unsigned short f2bf(float f) { return (unsigned short)(pk2(f, 0.f) & 0xffffu); }
__device__ __forceinline__ float sigmoidf_(float x) { return __builtin_amdgcn_rcpf(1.f + __expf(-x)); }
__device__ __forceinline__ float siluf_(float x) { return x * __builtin_amdgcn_rcpf(1.f + __expf(-x)); }
__device__ __forceinline__ float wave_sum(float v) {
#pragma unroll
    for (int o = 1; o < 64; o <<= 1) v += __shfl_xor(v, o);
    return v;
}
#define LDS_WAIT() asm volatile("s_waitcnt lgkmcnt(0)" ::: "memory")
__device__ __forceinline__ float max3f_(float a, float b, float c) { float r; asm("v_max3_f32 %0, %1, %2, %3" : "=v"(r) : "v"(a), "v"(b), "v"(c)); return r; }
__device__ __forceinline__ float max16f_(const f32x4 (&s)[4]) {
    const float m1 = max3f_(s[0][0], s[0][1], s[0][2]), m2 = max3f_(s[0][3], s[1][0], s[1][1]), m3 = max3f_(s[1][2], s[1][3], s[2][0]), m4 = max3f_(s[2][1], s[2][2], s[2][3]), m5 = max3f_(s[3][0], s[3][1], s[3][2]);
    return max3f_(max3f_(m1, m2, s[3][3]), max3f_(m3, m4, m5), m1); }
__device__ __forceinline__ int perm32k(int w) { return 8 * ((w >> 2) & 3) + 4 * (w >> 4) + (w & 3); }
#define MFMA16(a, b, c) __builtin_amdgcn_mfma_f32_16x16x32_bf16((a), (b), (c), 0, 0, 0)

struct EpiProj {
    static constexpr bool PERM = true, AFTER_DRAIN = false; bf16* P; float* S; bf16* C;
    __device__ __forceinline__ void operator()(const f32x4 (&acc)[2][2][4][2], const pg8::Unit& u, int wr, int wc, int fr, int fq) const {
        const int row0 = u.pm * 256 + wr * 64 + fr;
        if (u.pn < 19) {
            const float sc = u.pn < 2 ? 0.125f * 1.44269504f : u.pn == 5 ? 0.125f : 1.f;     const int col0 = u.pn * 256 + wc * 32 + 8 * fq;
#pragma unroll
            for (int ai = 0; ai < 2; ++ai)
#pragma unroll
                for (int m = 0; m < 4; ++m) { bf16* rowp = P + (size_t)(row0 + ai * 128 + m * 16) * PLD + col0;
#pragma unroll
                    for (int bj = 0; bj < 2; ++bj) { const f32x4 v0 = acc[ai][bj][m][0] * sc, v1 = acc[ai][bj][m][1] * sc; u32x4 w;
                        w.x = pk2(v0[0], v0[1]); w.y = pk2(v0[2], v0[3]); w.z = pk2(v1[0], v1[1]); w.w = pk2(v1[2], v1[3]);
                        if (u.pn == 2) *(u32x4*)(C + ((size_t)(bj * 2 + (wc >> 1)) * M + (row0 + ai * 128 + m * 16)) * 64 + (wc & 1) * 32 + 8 * fq) = w;
                        else *(u32x4*)(rowp + bj * 128) = w; } }
        } else if (wc < 2) {
#pragma unroll
            for (int ai = 0; ai < 2; ++ai)
#pragma unroll
                for (int m = 0; m < 4; ++m) { float* rp = S + (size_t)(row0 + ai * 128 + m * 16) * 64 + wc * 32 + 8 * fq; *(f32x4*)rp = acc[ai][0][m][0]; *(f32x4*)(rp + 4) = acc[ai][0][m][1]; }
        }
    }
};
template <bool SECOND> struct EpiUp {
    static constexpr bool PERM = true, AFTER_DRAIN = false; const bf16* P; bf16* O; int ldo;
    __device__ __forceinline__ void operator()(const f32x4 (&acc)[2][2][4][2], const pg8::Unit& u, int wr, int wc, int fr, int fq) const {
        const int row0 = u.pm * 256 + wr * 64 + fr, col0 = u.pn * 256 + wc * 32 + 8 * fq;
#pragma unroll
        for (int ai = 0; ai < 2; ++ai) { u32x4 gwv[4][2], pwv[4][2];
#pragma unroll
            for (int m = 0; m < 4; ++m)
#pragma unroll
                for (int bj = 0; bj < 2; ++bj) { const size_t row = (size_t)(row0 + ai * 128 + m * 16); const int col = col0 + bj * 128;
                    gwv[m][bj] = *(const u32x4*)(P + row * PLD + PC_GM + (SECOND ? 1024 : 0) + col); if (SECOND) pwv[m][bj] = *(const u32x4*)(O + row * ldo + col); else pwv[m][bj] = (u32x4){0u, 0u, 0u, 0u}; }
#pragma unroll
            for (int m = 0; m < 4; ++m) { const size_t row = (size_t)(row0 + ai * 128 + m * 16);
#pragma unroll
                for (int bj = 0; bj < 2; ++bj) { const int col = col0 + bj * 128; const u32x4 gw = gwv[m][bj];
                    const f32x4 a0 = acc[ai][bj][m][0], a1 = acc[ai][bj][m][1];
                    float o[8] = { a0[0] * sigmoidf_(bflo(gw.x)), a0[1] * sigmoidf_(bfhi(gw.x)), a0[2] * sigmoidf_(bflo(gw.y)), a0[3] * sigmoidf_(bfhi(gw.y)),
                                   a1[0] * sigmoidf_(bflo(gw.z)), a1[1] * sigmoidf_(bfhi(gw.z)), a1[2] * sigmoidf_(bflo(gw.w)), a1[3] * sigmoidf_(bfhi(gw.w)) };
                    if (SECOND) { const u32x4 pw = pwv[m][bj];
                        o[0] += bflo(pw.x); o[1] += bfhi(pw.x); o[2] += bflo(pw.y); o[3] += bfhi(pw.y); o[4] += bflo(pw.z); o[5] += bfhi(pw.z); o[6] += bflo(pw.w); o[7] += bfhi(pw.w); }
                    u32x4 w; w.x = pk2(o[0], o[1]); w.y = pk2(o[2], o[3]); w.z = pk2(o[4], o[5]); w.w = pk2(o[6], o[7]); *(u32x4*)(O + row * ldo + col) = w; } } }
    }
};
struct UpOrder { pg8::StaticOrder so;
    __device__ bool next(int i, pg8::Unit& u) const { if (i > 1) return false; pg8::Unit b; if (!so.next(0, b)) return false; u.pm = b.pm + (i ? 64 : 0); u.pn = b.pn + (i ? 4 : 0); return true; }
    __device__ __forceinline__ void a_ready(const pg8::Unit&) const {}
    __device__ __forceinline__ void done(const pg8::Unit&) const {}
};
struct EpiUp2 { static constexpr bool PERM = true, AFTER_DRAIN = false; const bf16* P; bf16* O; int ldo;
    __device__ __forceinline__ void operator()(const f32x4 (&acc)[2][2][4][2], const pg8::Unit& u, int wr, int wc, int fr, int fq) const {
        if (u.pm < 64) { EpiUp<false> e{P, O, ldo}; e(acc, u, wr, wc, fr, fq); }
        else { EpiUp<true> e{P, O, ldo}; pg8::Unit v; v.pm = u.pm - 64; v.pn = u.pn - 4; e(acc, v, wr, wc, fr, fq); }
    }
};
template <bool WRITE_XB> struct EpiRes {
    static constexpr bool PERM = true, AFTER_DRAIN = true; const float* base; float* out; bf16* XB; float* rsq;
    __device__ __forceinline__ void fused(f32x4 (&acc)[2][2][4][2], const pg8::Unit& u, int wr, int wc, int fr, int fq, PG8_LAS unsigned char* lds, int wid, int lane) const {
        const int row0 = u.pm * 256 + wr * 64 + fr, col0 = u.pn * 256 + wc * 32 + 8 * fq;
        PG8_LAS float* rs = (PG8_LAS float*)lds;
#pragma unroll
        for (int ai = 0; ai < 2; ++ai) { f32x4 bb[4][2][2];
#pragma unroll
            for (int m = 0; m < 4; ++m)
#pragma unroll
                for (int bj = 0; bj < 2; ++bj) { const size_t off = (size_t)(row0 + ai * 128 + m * 16) * D + col0 + bj * 128; bb[m][bj][0] = *(const f32x4*)(base + off); bb[m][bj][1] = *(const f32x4*)(base + off + 4); }
#pragma unroll
            for (int m = 0; m < 4; ++m) { const size_t row = (size_t)(row0 + ai * 128 + m * 16); float ss = 0.f;
#pragma unroll
                for (int bj = 0; bj < 2; ++bj) { const size_t off = row * D + col0 + bj * 128;
                    const f32x4 v0 = bb[m][bj][0] + acc[ai][bj][m][0], v1 = bb[m][bj][1] + acc[ai][bj][m][1];
                    if (!WRITE_XB) { *(f32x4*)(out + off) = v0; *(f32x4*)(out + off + 4) = v1; }
                    ss += (v0[0] * v0[0] + v0[1] * v0[1]) + (v0[2] * v0[2] + v0[3] * v0[3]) + (v1[0] * v1[0] + v1[1] * v1[1]) + (v1[2] * v1[2] + v1[3] * v1[3]);
                    if (WRITE_XB) { u32x4 w; w.x = pk2(v0[0], v0[1]); w.y = pk2(v0[2], v0[3]); w.z = pk2(v1[0], v1[1]); w.w = pk2(v1[2], v1[3]); *(u32x4*)(XB + off) = w; } }
                ss += __shfl_xor(ss, 16); ss += __shfl_xor(ss, 32);
                if (fq == 0) rs[(ai * 128 + wr * 64 + m * 16 + fr) * 4 + wc] = ss; } }
        __syncthreads();
        const int t = wid * 64 + lane;
        if (t < 256) rsq[(size_t)u.pn * M + u.pm * 256 + t] = (rs[t * 4] + rs[t * 4 + 1]) + (rs[t * 4 + 2] + rs[t * 4 + 3]);
        __syncthreads();
    }
};
struct EpiFinal {
    static constexpr bool PERM = true, AFTER_DRAIN = true; const bf16* base; float* out; float* rsq; unsigned* cnt; const float* gain;
    __device__ __forceinline__ void fused(f32x4 (&acc)[2][2][4][2], const pg8::Unit& u, int wr, int wc, int fr, int fq, PG8_LAS unsigned char* lds, int wid, int lane) const {
        const int row0 = u.pm * 256 + wr * 64 + fr, col0 = u.pn * 256 + wc * 32 + 8 * fq;
        PG8_LAS float* rs = (PG8_LAS float*)lds;
        u32x4 bw[2][4][2];
#pragma unroll
        for (int ai = 0; ai < 2; ++ai)
#pragma unroll
            for (int m = 0; m < 4; ++m)
#pragma unroll
                for (int bj = 0; bj < 2; ++bj) bw[ai][m][bj] = *(const u32x4*)(base + (size_t)(row0 + ai * 128 + m * 16) * D + col0 + bj * 128);
#pragma unroll
        for (int ai = 0; ai < 2; ++ai)
#pragma unroll
            for (int m = 0; m < 4; ++m) { float ss = 0.f;
#pragma unroll
                for (int bj = 0; bj < 2; ++bj) { const u32x4 w = bw[ai][m][bj]; const f32x4 b0 = {bflo(w.x), bfhi(w.x), bflo(w.y), bfhi(w.y)}, b1 = {bflo(w.z), bfhi(w.z), bflo(w.w), bfhi(w.w)};
                    const f32x4 v0 = b0 + acc[ai][bj][m][0], v1 = b1 + acc[ai][bj][m][1]; acc[ai][bj][m][0] = v0; acc[ai][bj][m][1] = v1;
                    ss += (v0[0] * v0[0] + v0[1] * v0[1]) + (v0[2] * v0[2] + v0[3] * v0[3]) + (v1[0] * v1[0] + v1[1] * v1[1]) + (v1[2] * v1[2] + v1[3] * v1[3]); }
                ss += __shfl_xor(ss, 16); ss += __shfl_xor(ss, 32);
                if (fq == 0) rs[(ai * 128 + wr * 64 + m * 16 + fr) * 4 + wc] = ss; }
        __syncthreads();
        const int t = wid * 64 + lane;
        if (t < 256) rsq[(size_t)u.pn * M + u.pm * 256 + t] = (rs[t * 4] + rs[t * 4 + 1]) + (rs[t * 4 + 2] + rs[t * 4 + 3]);
        asm volatile("s_waitcnt vmcnt(0)" ::: "memory");
        __syncthreads();
        if (t == 0) { __builtin_amdgcn_fence(__ATOMIC_RELEASE, "agent"); asm volatile("s_waitcnt vmcnt(0)" ::: "memory");
            unsigned* c = cnt + 64 * u.pm; __hip_atomic_fetch_add(c, 1u, __ATOMIC_RELAXED, __HIP_MEMORY_SCOPE_AGENT);
            while (__hip_atomic_load(c, __ATOMIC_RELAXED, __HIP_MEMORY_SCOPE_AGENT) < 4u) __builtin_amdgcn_s_sleep(2);
            __builtin_amdgcn_fence(__ATOMIC_ACQUIRE, "agent"); asm volatile("s_waitcnt vmcnt(0)" ::: "memory"); }
        __syncthreads();
        PG8_LAS float* rstd = (PG8_LAS float*)(lds + 4096);
        if (t < 256) { const size_t row = (size_t)u.pm * 256 + t; rstd[t] = rsqrtf(((rsq[row] + rsq[(size_t)M + row]) + (rsq[(size_t)2 * M + row] + rsq[(size_t)3 * M + row])) * (1.f / D) + EPS); }
        __syncthreads();
#pragma unroll
        for (int ai = 0; ai < 2; ++ai)
#pragma unroll
            for (int m = 0; m < 4; ++m) { const int rl = ai * 128 + wr * 64 + m * 16 + fr; const float r = rstd[rl]; const size_t row = (size_t)u.pm * 256 + rl;
#pragma unroll
                for (int bj = 0; bj < 2; ++bj) { const size_t off = row * D + col0 + bj * 128; const f32x4 g0 = *(const f32x4*)(gain + col0 + bj * 128), g1 = *(const f32x4*)(gain + col0 + bj * 128 + 4); *(f32x4*)(out + off) = acc[ai][bj][m][0] * r * g0; *(f32x4*)(out + off + 4) = acc[ai][bj][m][1] * r * g1; } }
        __syncthreads();
    }
};
struct EpiFfn {
    static constexpr bool PERM = true, AFTER_DRAIN = false; bf16* H; const float* rsq;
    __device__ __forceinline__ void operator()(const f32x4 (&acc)[2][2][4][2], const pg8::Unit& u, int wr, int wc, int fr, int fq) const {
        const int row0 = u.pm * 256 + wr * 64 + fr, f0 = u.pn * 128 + wc * 16 + 4 * fq;
#pragma unroll
        for (int ai = 0; ai < 2; ++ai)
#pragma unroll
            for (int m = 0; m < 4; ++m) { const size_t row = (size_t)(row0 + ai * 128 + m * 16); const float rstd = rsqrtf(((rsq[row] + rsq[(size_t)M + row]) + (rsq[(size_t)2 * M + row] + rsq[(size_t)3 * M + row])) * (1.f / D) + EPS);
#pragma unroll
                for (int bj = 0; bj < 2; ++bj) { const f32x4 gv = acc[ai][bj][m][0] * rstd, uv = acc[ai][bj][m][1] * rstd;
                    u32x2 w; w.x = pk2(siluf_(gv[0]) * uv[0], siluf_(gv[1]) * uv[1]); w.y = pk2(siluf_(gv[2]) * uv[2], siluf_(gv[3]) * uv[3]);
                    *(u32x2*)(H + row * DFF + f0 + bj * 64) = w; } }
    }
};

template <int MODE> __device__ __forceinline__ void tr_item(const float* W0, const float* W1, int K, int Nsrc, bf16* WT, int item, int nblk, const float* kscale, LAS float* scr, int lane) {
    const int kb = item / nblk, nb = item % nblk, k0 = 64 * kb, n0 = 32 * nb, nn = n0 + (lane & 31);
    const float* src = W0; int sc = nn;
    if (MODE == 1) sc = nn < 1280 ? nn : nn < 2304 ? nn + 24 : nn < 4864 ? nn + 40 : nn < 4888 ? nn - 4864 + 1280 : nn < 4904 ? nn - 4888 + 2328 : -1;
    if (MODE == 2) { const int q = nn >> 3, e = nn & 7; src = (e < 4) ? W0 : W1; sc = 4 * q + (e & 3); }
    float tv[32];
#pragma unroll
    for (int i = 0; i < 32; ++i) { const int kk = 2 * i + (lane >> 5); tv[i] = sc >= 0 ? src[(size_t)(k0 + kk) * Nsrc + sc] : 0.f; }
#pragma unroll
    for (int i = 0; i < 32; ++i) { const int kk = 2 * i + (lane >> 5); float v = tv[i]; if (kscale) v *= kscale[k0 + kk]; scr[kk * 33 + (lane & 31)] = v; }
    LDS_WAIT();
    const int c = lane & 7;
#pragma unroll
    for (int j = 0; j < 4; ++j) { const int n = (lane >> 3) + 8 * j; const LAS float* s = scr + (8 * c) * 33 + n;
        u32x4 o; o.x = pk2(s[0 * 33], s[1 * 33]); o.y = pk2(s[2 * 33], s[3 * 33]); o.z = pk2(s[4 * 33], s[5 * 33]); o.w = pk2(s[6 * 33], s[7 * 33]);
        *(u32x4*)(WT + (size_t)(n0 + n) * K + k0 + 8 * c) = o; }
    LDS_WAIT();
}
__device__ __forceinline__ void rms_row_to_bf16(const float* xrow, const float* gain, bf16* orow, int lane) {
    const f32x4* xr = (const f32x4*)xrow + lane; const f32x4* gr = (const f32x4*)gain + lane;
    f32x4 v[4]; float s = 0.f;
#pragma unroll
    for (int j = 0; j < 4; ++j) { v[j] = xr[64 * j]; s += (v[j].x * v[j].x + v[j].y * v[j].y) + (v[j].z * v[j].z + v[j].w * v[j].w); }
    const float rstd = rsqrtf(wave_sum(s) * (1.f / D) + EPS);
    u32x2* o8 = (u32x2*)orow + lane;
#pragma unroll
    for (int j = 0; j < 4; ++j) { const f32x4 g = gr[64 * j]; u32x2 w; w.x = pk2(v[j].x * rstd * g.x, v[j].y * rstd * g.y); w.y = pk2(v[j].z * rstd * g.z, v[j].w * rstd * g.w); o8[64 * j] = w; }
}
struct Args { const float* in[20]; float* out; unsigned char* ws; };

__device__ __forceinline__ void p0_prologue(const Args& a, LAS unsigned char* lds, int wave, int lane) {
    unsigned char* ws = a.ws;
    LAS float* scr = (LAS float*)(lds + wave * 16384);
    const int gw = blockIdx.x * NWAVES + wave, NGW = gridDim.x * NWAVES;
    constexpr int I_IN = 16 * (NIN / 32), I_GU = 16 * (NGU / 32), I_DN = 44 * 32, I_OUT = 16 * 32, I_UP = 8 * 32, I_C1 = 32 * 4, I_C2 = 2 * 2;
    constexpr int NITEMS = I_IN + I_GU + I_DN + I_OUT + 2 * I_UP + 2 * I_C1 + 2 * I_C2;
    for (int it = gw; it < NITEMS; it += NGW) {
        int r = it;
        if (r < I_IN) { tr_item<1>(a.in[2], nullptr, 1024, 4904, (bf16*)(ws + WS_WIN), r, NIN / 32, nullptr, scr, lane); continue; } r -= I_IN;
        if (r < I_GU) { tr_item<2>(a.in[16], a.in[17], 1024, DFF, (bf16*)(ws + WS_WGU), r, NGU / 32, a.in[15], scr, lane); continue; } r -= I_GU;
        if (r < I_DN) { tr_item<0>(a.in[18], nullptr, DFF, 1024, (bf16*)(ws + WS_WDN), r, 32, nullptr, scr, lane); continue; } r -= I_DN;
        if (r < I_OUT) { tr_item<0>(a.in[14], nullptr, 1024, 1024, (bf16*)(ws + WS_WOUT), r, 32, nullptr, scr, lane); continue; } r -= I_OUT;
        if (r < I_UP) { tr_item<0>(a.in[12], nullptr, 512, 1024, (bf16*)(ws + WS_WUPA), r, 32, nullptr, scr, lane); continue; } r -= I_UP;
        if (r < I_UP) { tr_item<0>(a.in[13], nullptr, 512, 1024, (bf16*)(ws + WS_WUPB), r, 32, nullptr, scr, lane); continue; } r -= I_UP;
        if (r < I_C1) { tr_item<0>(a.in[5], nullptr, 2048, 128, (bf16*)(ws + WS_CW1K), r, 4, nullptr, scr, lane); continue; } r -= I_C1;
        if (r < I_C1) { tr_item<0>(a.in[7], nullptr, 2048, 128, (bf16*)(ws + WS_CW1V), r, 4, nullptr, scr, lane); continue; } r -= I_C1;
        if (r < I_C2) { tr_item<0>(a.in[6], nullptr, 128, 64, (bf16*)(ws + WS_CW2K), r, 2, nullptr, scr, lane); continue; } r -= I_C2;
        tr_item<0>(a.in[8], nullptr, 128, 64, (bf16*)(ws + WS_CW2V), r, 2, nullptr, scr, lane);
    }
    for (int m0 = gw; m0 < M; m0 += 4 * NGW) {
        f32x4 v[4][4]; float ss[4];
#pragma unroll
        for (int r = 0; r < 4; ++r) { const int m = m0 + r * NGW < M ? m0 + r * NGW : m0; const f32x4* xr = (const f32x4*)(a.in[0] + (size_t)m * D) + lane;
#pragma unroll
            for (int j = 0; j < 4; ++j) v[r][j] = xr[64 * j]; }
#pragma unroll
        for (int r = 0; r < 4; ++r) { float s_ = 0.f;
#pragma unroll
            for (int j = 0; j < 4; ++j) s_ += (v[r][j].x * v[r][j].x + v[r][j].y * v[r][j].y) + (v[r][j].z * v[r][j].z + v[r][j].w * v[r][j].w);
            ss[r] = rsqrtf(wave_sum(s_) * (1.f / D) + EPS); }
#pragma unroll
        for (int r = 0; r < 4; ++r) { const int m = m0 + r * NGW; if (m < M) { u32x2* o8 = (u32x2*)((bf16*)(ws + WS_XN) + (size_t)m * D) + lane; const f32x4* gr = (const f32x4*)a.in[1] + lane;
#pragma unroll
            for (int j = 0; j < 4; ++j) { const f32x4 g = gr[64 * j]; u32x2 w; w.x = pk2(v[r][j].x * ss[r] * g.x, v[r][j].y * ss[r] * g.y); w.y = pk2(v[r][j].z * ss[r] * g.z, v[r][j].w * ss[r] * g.w); o8[64 * j] = w; } } } }
    for (int e = blockIdx.x * NTHR + threadIdx.x; e < T * 8; e += gridDim.x * NTHR) {
        const int t = e >> 3, i = e & 7;
        const float f = i == 0 ? 1.0f : i == 1 ? 0.19392274f : i == 2 ? 0.03760603f : i == 3 ? 0.0072926646f : i == 4 ? 0.0014142136f : i == 5 ? 0.0002742482f : i == 6 ? 5.3182957e-05f : 1.0313385e-05f;
        const float ang = (float)t * f;
        const float p = ang * 0.15915494f; const float er = fmaf(ang, 0.15915494f, -p) + ang * 6.4206382e-09f; const float fr = (p - rintf(p)) + er;
        ((float*)(ws + WS_ROPE))[e] = __builtin_amdgcn_cosf(fr); ((float*)(ws + WS_ROPE))[T * 8 + e] = __builtin_amdgcn_sinf(fr);
    }
    if (gw >= NGW - 32) { const int g2 = gw - (NGW - 32), kv = g2 >> 4, q = g2 & 15; const float* pe = a.in[3 + kv] + 128 * q; const float* w1 = a.in[kv ? 7 : 5] + (size_t)(128 * q) * 128;
        float s0 = 0.f, s1 = 0.f;
#pragma unroll 32
        for (int k = 0; k < 128; ++k) { const float p = pe[k]; s0 += p * w1[k * 128 + lane]; s1 += p * w1[k * 128 + 64 + lane]; }
        float* b1 = (float*)(ws + WS_CTL) + 2048 + (kv * 16 + q) * 128; b1[lane] = s0; b1[64 + lane] = s1; }
}

__device__ __forceinline__ u32x4 rope_unit(u32x4 x, const u32x4 y, const float* RC, const float* RS, int t, float sg) {
    const f32x4 c0 = *(const f32x4*)(RC + t * 8), c1 = *(const f32x4*)(RC + t * 8 + 4), s0 = *(const f32x4*)(RS + t * 8), s1 = *(const f32x4*)(RS + t * 8 + 4);
    x.x = pk2(bflo(x.x) * c0[0] + sg * bflo(y.x) * s0[0], bfhi(x.x) * c0[1] + sg * bfhi(y.x) * s0[1]); x.y = pk2(bflo(x.y) * c0[2] + sg * bflo(y.y) * s0[2], bfhi(x.y) * c0[3] + sg * bfhi(y.y) * s0[3]);
    x.z = pk2(bflo(x.z) * c1[0] + sg * bflo(y.z) * s1[0], bfhi(x.z) * c1[1] + sg * bfhi(y.z) * s1[1]); x.w = pk2(bflo(x.w) * c1[2] + sg * bflo(y.w) * s1[2], bfhi(x.w) * c1[3] + sg * bfhi(y.w) * s1[3]);
    return x;
}
__device__ __forceinline__ void rope_item(int item, unsigned char* ws, int lane) {
    const bf16* PROJ = (const bf16*)(ws + WS_PROJ); const float* RC = (const float*)(ws + WS_ROPE); const float* RS = RC + T * 8; bf16* QROT = (bf16*)(ws + WS_QROT); bf16* KROT = (bf16*)(ws + WS_KROT);
    const size_t row0 = (size_t)item * 8; const int tq0 = (int)(row0 & (T - 1));
    { const int sub = lane & 7; const float sg = sub == 0 ? -1.f : 1.f; u32x4 x[8], y[8];
#pragma unroll
      for (int tt = 0; tt < 8; ++tt) { const bf16* src = PROJ + (row0 + tt) * PLD + PC_QN; x[tt] = *(const u32x4*)(src + 8 * lane); y[tt] = *(const u32x4*)(src + 8 * (lane ^ 1)); }
#pragma unroll
      for (int tt = 0; tt < 8; ++tt) { if (sub < 2) { x[tt] = rope_unit(x[tt], y[tt], RC, RS, tq0 + tt, sg); *(u32x4*)(QROT + (row0 + tt) * 128 + (lane >> 3) * 16 + 8 * sub) = x[tt]; } } }
    { u32x4 x[4], y[4];
#pragma unroll
      for (int it = 0; it < 4; ++it) { const int id = it * 64 + lane, tt = id >> 5, w = id & 31, tensor = w >> 4, g = (w >> 3) & 1, u8 = w & 7;
          const bf16* p = PROJ + (row0 + tt) * PLD + PC_KV + (2 + 2 * tensor) * 128 + g * 64; x[it] = *(const u32x4*)(p + 8 * u8); y[it] = *(const u32x4*)(p + 8 * (u8 ^ 1)); }
#pragma unroll
      for (int it = 0; it < 4; ++it) { const int id = it * 64 + lane, tt = id >> 5, w = id & 31, u8 = w & 7;
          if (u8 < 2) x[it] = rope_unit(x[it], y[it], RC, RS, tq0 + tt, u8 == 0 ? -1.f : 1.f);
          *(u32x4*)(KROT + ((size_t)(w >> 3) * M + row0 + tt) * 64 + 8 * u8) = x[it]; } }
}
__device__ __forceinline__ void p2a_item(int item, unsigned char* ws, LAS unsigned char* wl, int lane) {
    const bf16* PROJ = (const bf16*)(ws + WS_PROJ);
    const int part = item & 1, tile = item >> 1, b = tile >> 7, t0 = (tile & 127) * 64;
    int csrc; bf16* dst; int nc, cdst;
    if (part == 0) { csrc = PC_KV + 3 * 128; dst = (bf16*)(ws + WS_VTS); nc = 128; cdst = 0; }
    else { csrc = PC_KV + 5 * 128; dst = (bf16*)(ws + WS_VTW); nc = 128; cdst = 0; }
    LAS unsigned char* tb = wl;
#pragma unroll
    for (int it = 0; it < 16; ++it) { const int id = it * 64 + lane, tt = id >> 4, uu = id & 15;
        const u32x4 v = *(const u32x4*)(PROJ + ((size_t)b * T + t0 + tt) * PLD + csrc + 8 * uu);
        *(LAS u32x2*)(tb + tt * 264 + uu * 16) = (u32x2){v.x, v.y}; *(LAS u32x2*)(tb + tt * 264 + uu * 16 + 8) = (u32x2){v.z, v.w}; }
    LDS_WAIT();
#pragma unroll
    for (int pass = 0; pass < 2; ++pass) { const int c = pass * 64 + lane;
        bf16* dp = dst + ((((size_t)(b * 2 + pass)) * 128 + (t0 >> 6)) * 64 + lane) * 64;
#pragma unroll
        for (int hb = 0; hb < 2; ++hb) { unsigned wv[16];
#pragma unroll
            for (int p2 = 0; p2 < 16; ++p2) { unsigned lo, hi;
                { const int p = 2 * p2, fqq = p >> 3, e = p & 7, key = 32 * hb + (e < 4 ? 4 * fqq + e : 16 + 4 * fqq + (e - 4)); lo = *(const LAS unsigned short*)(tb + key * 264 + c * 2); }
                { const int p = 2 * p2 + 1, fqq = p >> 3, e = p & 7, key = 32 * hb + (e < 4 ? 4 * fqq + e : 16 + 4 * fqq + (e - 4)); hi = *(const LAS unsigned short*)(tb + key * 264 + c * 2); }
                wv[p2] = lo | (hi << 16); }
#pragma unroll
            for (int q = 0; q < 4; ++q) *(u32x4*)(dp + 32 * hb + 8 * q) = (u32x4){wv[4 * q], wv[4 * q + 1], wv[4 * q + 2], wv[4 * q + 3]}; } }
    LDS_WAIT();
}

__device__ __forceinline__ void compress_item(int item, int sub, unsigned char* ws, LAS unsigned char* lds, int wave, int lane) {
    const int kv = item >> 5, g = (item >> 4) & 1, rt = item & 15, fr = lane & 15, fq = lane >> 4;
    const int rbase = rt * 64 + sub * 16;
    const bf16* Ap; { const int rowidx = rbase + fr, b = rowidx >> 9, ii = rowidx & 511; int tok0 = b * T + 16 * ii; if (tok0 > M - 32) tok0 = M - 32;
        Ap = (const bf16*)(ws + WS_CSRC) + ((size_t)(kv * 2 + g) * M + tok0) * 64 + 8 * fq; }
    const bf16* Bp = (const bf16*)(ws + (kv ? WS_CW1V : WS_CW1K)) + (size_t)(16 * wave + fr) * 2048 + 8 * fq;
    f32x4 acc = {0.f, 0.f, 0.f, 0.f};
    for (int kb = 0; kb < 64; kb += 16) {
        bf16x8 bv[16], av[16];
#pragma unroll
        for (int k2 = 0; k2 < 16; ++k2) { bv[k2] = *(const bf16x8*)(Bp + 32 * (kb + k2)); av[k2] = *(const bf16x8*)(Ap + 32 * (kb + k2)); }
#pragma unroll
        for (int k2 = 0; k2 < 16; ++k2) acc = MFMA16(av[k2], bv[k2], acc); }
    float bias = 0.f;
#pragma unroll
    for (int q = 0; q < 16; ++q) bias += ((const float*)(ws + WS_CTL))[2048 + (kv * 16 + q) * 128 + 16 * wave + fr];
    LAS bf16* H1 = (LAS bf16*)lds;
#pragma unroll
    for (int i = 0; i < 4; ++i) H1[(4 * fq + i) * 136 + 16 * wave + fr] = f2bf(siluf_(acc[i] + bias));
    __syncthreads();
    if (wave < 4) { const int ct = wave; const bf16* W2 = (const bf16*)(ws + (kv ? WS_CW2V : WS_CW2K)) + (size_t)(16 * ct + fr) * 128 + 8 * fq; f32x4 a2 = {0.f, 0.f, 0.f, 0.f};
#pragma unroll
        for (int ks = 0; ks < 4; ++ks) { const bf16x8 av = *(const LAS bf16x8*)(H1 + fr * 136 + 32 * ks + 8 * fq); const bf16x8 bv = *(const bf16x8*)(W2 + 32 * ks); a2 = MFMA16(av, bv, a2); }
        const int c = 16 * ct + fr;
        float vv[4];
#pragma unroll
        for (int i = 0; i < 4; ++i) { const int i2 = (rbase + 4 * fq + i) & 511; vv[i] = (i2 == 511) ? 0.f : a2[i]; }
        const int r0 = rbase + 4 * fq, b2 = r0 >> 9, i20 = r0 & 511;
        if (kv == 0) {
#pragma unroll
            for (int i = 0; i < 4; ++i) { const float nb = __shfl_xor(vv[i], 1); if (!(fr & 1)) *(unsigned*)((bf16*)(ws + WS_KCMP) + ((size_t)(b2 * 2 + g) * 512 + i20 + i) * 64 + c) = pk2(vv[i], nb); }
        } else { u32x2 w; w.x = pk2(vv[0], vv[1]); w.y = pk2(vv[2], vv[3]);
            *(u32x2*)((bf16*)(ws + WS_VCMPT) + ((size_t)(b2 * 2 + g) * 64 + c) * 512 + (i20 & ~31) + perm32k(i20 & 31)) = w; } }
    __syncthreads();
}

__device__ __forceinline__ void gla_cum(LAS float* cum, LAS float* tot, const float* SM, const float* w2, const float* gb, int b, int h, int c, int tid) {
    const int dk = tid & 63, tg = __builtin_amdgcn_readfirstlane(tid >> 6);
    float wcol[16];
#pragma unroll
    for (int r = 0; r < 16; ++r) wcol[r] = w2[r * 256 + h * 64 + dk];
    const float bias = gb[h * 64 + dk]; float run = 0.f, vals[8];
    LAS float* lrs = tot + 7680;
    if (tid < 256) *(LAS f32x4*)(lrs + (tid >> 2) * 16 + 4 * (tid & 3)) = *(const f32x4*)(SM + ((size_t)b * T + 64 * c + (tid >> 2)) * 64 + 24 + 4 * (tid & 3));
    __syncthreads();
#pragma unroll
    for (int j = 0; j < 8; ++j) { const LAS float* lr = lrs + (8 * tg + j) * 16; float z = bias;
#pragma unroll
        for (int r4 = 0; r4 < 4; ++r4) { const f32x4 v = *(const LAS f32x4*)(lr + 4 * r4); z += v[0] * wcol[4 * r4] + v[1] * wcol[4 * r4 + 1] + v[2] * wcol[4 * r4 + 2] + v[3] * wcol[4 * r4 + 3]; }
        const float la = (fminf(z, 0.f) - __logf(1.f + __expf(-fabsf(z)))) * (1.f / 16.f); run += la; vals[j] = run; }
    tot[tg * 64 + dk] = run;
    __syncthreads();
    float pre = 0.f;
#pragma unroll
    for (int g2 = 0; g2 < 7; ++g2) pre += (g2 < tg) ? tot[g2 * 64 + dk] : 0.f;
#pragma unroll
    for (int j = 0; j < 8; ++j) cum[(8 * tg + j) * 65 + dk] = vals[j] + pre;
    __syncthreads();
}
constexpr int GL_CUM = 0, GL_TOT = 16640, GL_KT = 18688, GL_VT = 27904, GL_SSQ = 46336;
__device__ __forceinline__ void gla_local_item(int item, const Args& a, LAS unsigned char* lds, int tid, int wave, int lane) {
    unsigned char* ws = a.ws; const bf16* PROJ = (const bf16*)(ws + WS_PROJ);
    const int b = item >> 9, h = (item >> 7) & 3, c = item & 127, fr = lane & 15, fq = lane >> 4;
    LAS float* cum = (LAS float*)(lds + GL_CUM); LAS float* tot = (LAS float*)(lds + GL_TOT); LAS bf16* KT = (LAS bf16*)(lds + GL_KT); LAS bf16* VT = (LAS bf16*)(lds + GL_VT);
    gla_cum(cum, tot, (const float*)(ws + WS_SMALL), a.in[9], a.in[10], b, h, c, tid);
    { const int s = tid >> 3, u = tid & 7; const size_t row = (size_t)b * T + 64 * c + s; const bf16x8 kr = *(const bf16x8*)(PROJ + row * PLD + PC_KG + h * 64 + 8 * u);
      const int pos = (s & 32) + perm32k(s & 31);
#pragma unroll
      for (int e = 0; e < 8; ++e) { const int dk = 8 * u + e; KT[dk * 72 + pos] = f2bf(bf2f(kr[e]) * __expf(cum[63 * 65 + dk] - cum[s * 65 + dk])); } }
#pragma unroll
    for (int it = 0; it < 2; ++it) { const int id = tid + 512 * it, s = id >> 4, u = id & 15; const size_t row = (size_t)b * T + 64 * c + s;
        const bf16x8 vr = *(const bf16x8*)(PROJ + row * PLD + PC_VG + h * 128 + 8 * u); const int pos = (s & 32) + perm32k(s & 31);
#pragma unroll
        for (int e = 0; e < 8; ++e) VT[(8 * u + e) * 72 + pos] = (bf16)vr[e]; }
    if (tid < 64) ((float*)(ws + WS_DEC))[(size_t)item * 64 + tid] = __expf(cum[63 * 65 + tid]);
    __syncthreads();
    bf16* LS = (bf16*)((unsigned char*)a.out + DO_L);
#pragma unroll
    for (int dkt = 0; dkt < 4; ++dkt) { f32x4 acc = {0.f, 0.f, 0.f, 0.f};
#pragma unroll
        for (int ks = 0; ks < 2; ++ks) { const bf16x8 av = *(const LAS bf16x8*)(VT + (16 * wave + fr) * 72 + 32 * ks + 8 * fq); const bf16x8 bv = *(const LAS bf16x8*)(KT + (16 * dkt + fr) * 72 + 32 * ks + 8 * fq); acc = MFMA16(av, bv, acc); }
#pragma unroll
        for (int i = 0; i < 4; ++i) { const float nb = __shfl_xor(acc[i], 1); if (!(fr & 1)) *(unsigned*)(LS + ((size_t)item * 128 + 16 * wave + 4 * fq + i) * 64 + 16 * dkt + fr) = pk2(acc[i], nb); } }
    __syncthreads();
}
__device__ __forceinline__ void gla_out_item(int item, const Args& a, LAS unsigned char* lds, int tid, int wave, int lane) {
    unsigned char* ws = a.ws; const bf16* PROJ = (const bf16*)(ws + WS_PROJ);
    const int b = item >> 9, h = (item >> 7) & 3, c = item & 127, fr = lane & 15, fq = lane >> 4, tt = wave & 3, hh = wave >> 2;
    LAS bf16* VT = (LAS bf16*)(lds + GL_VT);
    LAS float* cum = (LAS float*)(lds + GL_CUM); LAS float* tot = (LAS float*)(lds + GL_TOT); LAS float* ssqb = (LAS float*)(lds + GL_SSQ);
    gla_cum(cum, tot, (const float*)(ws + WS_SMALL), a.in[9], a.in[10], b, h, c, tid);
#pragma unroll
    for (int it = 0; it < 2; ++it) { const int id = tid + 512 * it, s = id >> 4, u = id & 15; const size_t row = (size_t)b * T + 64 * c + s;
        const bf16x8 vr = *(const bf16x8*)(PROJ + row * PLD + PC_VG + h * 128 + 8 * u); const int pos = (s & 32) + perm32k(s & 31);
#pragma unroll
        for (int e = 0; e < 8; ++e) VT[(8 * u + e) * 72 + pos] = (bf16)vr[e]; }
    __syncthreads();
    const int tokq = 16 * tt + fr; const size_t rowq = (size_t)b * T + 64 * c + tokq;
    bf16x8 qf[2];
#pragma unroll
    for (int ks = 0; ks < 2; ++ks) { const bf16x8 raw = *(const bf16x8*)(PROJ + rowq * PLD + PC_QG + h * 64 + 32 * ks + 8 * fq);
#pragma unroll
        for (int e = 0; e < 8; ++e) qf[ks][e] = (short)f2bf(bf2f(raw[e]) * __expf(cum[tokq * 65 + 32 * ks + 8 * fq + e])); }
    f32x4 at[4];
#pragma unroll
    for (int st = 0; st < 4; ++st) { at[st] = (f32x4){0.f, 0.f, 0.f, 0.f};
        if (st <= tt) { const int s = 16 * st + fr; const size_t rows = (size_t)b * T + 64 * c + s; bf16x8 kf[2];
#pragma unroll
            for (int ks = 0; ks < 2; ++ks) { const bf16x8 raw = *(const bf16x8*)(PROJ + rows * PLD + PC_KG + h * 64 + 32 * ks + 8 * fq);
#pragma unroll
                for (int e = 0; e < 8; ++e) kf[ks][e] = (short)f2bf(bf2f(raw[e]) * __expf(-cum[s * 65 + 32 * ks + 8 * fq + e])); }
            at[st] = MFMA16(kf[0], qf[0], at[st]); at[st] = MFMA16(kf[1], qf[1], at[st]);
            if (st == tt) {
#pragma unroll
                for (int i = 0; i < 4; ++i) if (4 * fq + i > fr) at[st][i] = 0.f; } } }
    bf16x8 pf[2];
#pragma unroll
    for (int k2 = 0; k2 < 2; ++k2) { const u32x4 w = {pk2(at[2 * k2][0], at[2 * k2][1]), pk2(at[2 * k2][2], at[2 * k2][3]), pk2(at[2 * k2 + 1][0], at[2 * k2 + 1][1]), pk2(at[2 * k2 + 1][2], at[2 * k2 + 1][3])}; pf[k2] = __builtin_bit_cast(bf16x8, w); }
    const bf16* LS = (const bf16*)((const unsigned char*)a.out + DO_S);
    f32x4 o[4]; float ssq = 0.f;
#pragma unroll
    for (int j = 0; j < 4; ++j) { const int dv0 = 64 * hh + 16 * j; f32x4 acc = {0.f, 0.f, 0.f, 0.f};
#pragma unroll
        for (int ks = 0; ks < 2; ++ks) { const bf16x8 sf = *(const bf16x8*)(LS + ((size_t)item * 128 + dv0 + fr) * 64 + 32 * ks + 8 * fq); acc = MFMA16(sf, qf[ks], acc); }
#pragma unroll
        for (int k2 = 0; k2 < 2; ++k2) { const bf16x8 vf = *(const LAS bf16x8*)(VT + (dv0 + fr) * 72 + 32 * k2 + 8 * fq); acc = MFMA16(vf, pf[k2], acc); }
        o[j] = acc; ssq += (acc[0] * acc[0] + acc[1] * acc[1]) + (acc[2] * acc[2] + acc[3] * acc[3]); }
    ssq += __shfl_xor(ssq, 16); ssq += __shfl_xor(ssq, 32);
    if (fq == 0) ssqb[hh * 64 + tokq] = ssq;
    __syncthreads();
    const float rstd = rsqrtf((ssqb[tokq] + ssqb[64 + tokq]) * (1.f / 128.f) + EPS);
#pragma unroll
    for (int j = 0; j < 4; ++j) { const int dvb = 64 * hh + 16 * j + 4 * fq; const f32x4 gn = *(const f32x4*)(a.in[11] + dvb); const bf16* rp = PROJ + rowq * PLD + PC_RG + h * 128 + dvb; bf16* op = (bf16*)((unsigned char*)a.out + DO_OB) + rowq * 512 + h * 128 + dvb;
        const u32x2 rw = *(const u32x2*)rp; const float r0 = bflo(rw.x), r1 = bfhi(rw.x), r2 = bflo(rw.y), r3 = bfhi(rw.y);
        u32x2 w; w.x = pk2(o[j][0] * rstd * gn[0] * siluf_(r0), o[j][1] * rstd * gn[1] * siluf_(r1)); w.y = pk2(o[j][2] * rstd * gn[2] * siluf_(r2), o[j][3] * rstd * gn[3] * siluf_(r3));
        *(u32x2*)op = w; }
    __syncthreads();
}

constexpr int GL2_STRIDE = 53248;
__device__ __forceinline__ void gla_cum2(LAS float* cum, LAS float* tot, LAS float* lrs, const float* SM, const float* w2, const float* gb, int b, int h, int c, int th) {
    const int dk = th & 63, tg = __builtin_amdgcn_readfirstlane(th >> 6);
    float wcol[16];
#pragma unroll
    for (int r = 0; r < 16; ++r) wcol[r] = w2[r * 256 + h * 64 + dk];
    const float bias = gb[h * 64 + dk]; float run = 0.f, vals[16];
    *(LAS f32x4*)(lrs + (th >> 2) * 16 + 4 * (th & 3)) = *(const f32x4*)(SM + ((size_t)b * T + 64 * c + (th >> 2)) * 64 + 24 + 4 * (th & 3));
    __syncthreads();
#pragma unroll
    for (int j = 0; j < 16; ++j) { const LAS float* lr = lrs + (16 * tg + j) * 16; float z = bias;
#pragma unroll
        for (int r4 = 0; r4 < 4; ++r4) { const f32x4 v = *(const LAS f32x4*)(lr + 4 * r4); z += v[0] * wcol[4 * r4] + v[1] * wcol[4 * r4 + 1] + v[2] * wcol[4 * r4 + 2] + v[3] * wcol[4 * r4 + 3]; }
        const float la = (fminf(z, 0.f) - __logf(1.f + __expf(-fabsf(z)))) * (1.f / 16.f); run += la; vals[j] = run; }
    tot[tg * 64 + dk] = run;
    __syncthreads();
    float pre = 0.f;
#pragma unroll
    for (int g2 = 0; g2 < 3; ++g2) pre += (g2 < tg) ? tot[g2 * 64 + dk] : 0.f;
#pragma unroll
    for (int j = 0; j < 16; ++j) cum[(16 * tg + j) * 65 + dk] = vals[j] + pre;
    __syncthreads();
}
__device__ __forceinline__ void gla_local_pair(int pair, const Args& a, LAS unsigned char* lds0, int tid, int wave, int lane) {
    unsigned char* ws = a.ws; const bf16* PROJ = (const bf16*)(ws + WS_PROJ);
    const int half = tid >> 8, th = tid & 255, wv = wave & 3, item = 2 * pair + half;
    LAS unsigned char* lds = lds0 + half * GL2_STRIDE;
    const int b = item >> 9, h = (item >> 7) & 3, c = item & 127, fr = lane & 15, fq = lane >> 4;
    LAS float* cum = (LAS float*)(lds + GL_CUM); LAS float* tot = (LAS float*)(lds + GL_TOT); LAS bf16* KT = (LAS bf16*)(lds + GL_KT); LAS bf16* VT = (LAS bf16*)(lds + GL_VT);
    gla_cum2(cum, tot, (LAS float*)(lds + 47360), (const float*)(ws + WS_SMALL), a.in[9], a.in[10], b, h, c, th);
#pragma unroll
    for (int it = 0; it < 2; ++it) { const int id = th + 256 * it, s = id >> 3, u = id & 7; const size_t row = (size_t)b * T + 64 * c + s; const bf16x8 kr = *(const bf16x8*)(PROJ + row * PLD + PC_KG + h * 64 + 8 * u);
        const int pos = (s & 32) + perm32k(s & 31);
#pragma unroll
        for (int e = 0; e < 8; ++e) { const int dk = 8 * u + e; KT[dk * 72 + pos] = f2bf(bf2f(kr[e]) * __expf(cum[63 * 65 + dk] - cum[s * 65 + dk])); } }
#pragma unroll
    for (int it = 0; it < 4; ++it) { const int id = th + 256 * it, s = id >> 4, u = id & 15; const size_t row = (size_t)b * T + 64 * c + s;
        const bf16x8 vr = *(const bf16x8*)(PROJ + row * PLD + PC_VG + h * 128 + 8 * u); const int pos = (s & 32) + perm32k(s & 31);
#pragma unroll
        for (int e = 0; e < 8; ++e) VT[(8 * u + e) * 72 + pos] = (bf16)vr[e]; }
    if (th < 64) ((float*)(ws + WS_DEC))[(size_t)item * 64 + th] = __expf(cum[63 * 65 + th]);
    __syncthreads();
    bf16* LS = (bf16*)((unsigned char*)a.out + DO_L);
#pragma unroll
    for (int q2 = 0; q2 < 2; ++q2) { const int dvt = 2 * wv + q2;
#pragma unroll
      for (int dkt = 0; dkt < 4; ++dkt) { f32x4 acc = {0.f, 0.f, 0.f, 0.f};
#pragma unroll
        for (int ks = 0; ks < 2; ++ks) { const bf16x8 av = *(const LAS bf16x8*)(VT + (16 * dvt + fr) * 72 + 32 * ks + 8 * fq); const bf16x8 bv = *(const LAS bf16x8*)(KT + (16 * dkt + fr) * 72 + 32 * ks + 8 * fq); acc = MFMA16(av, bv, acc); }
#pragma unroll
        for (int i = 0; i < 4; ++i) { const float nb = __shfl_xor(acc[i], 1); if (!(fr & 1)) *(unsigned*)(LS + ((size_t)item * 128 + 16 * dvt + 4 * fq + i) * 64 + 16 * dkt + fr) = pk2(acc[i], nb); } } }
    __syncthreads();
}
__device__ __forceinline__ void gla_out_pair(int pair, const Args& a, LAS unsigned char* lds0, int tid, int wave, int lane) {
    unsigned char* ws = a.ws; const bf16* PROJ = (const bf16*)(ws + WS_PROJ);
    const int half = tid >> 8, th = tid & 255, tt = wave & 3, item = 2 * pair + half;
    LAS unsigned char* lds = lds0 + half * GL2_STRIDE;
    const int b = item >> 9, h = (item >> 7) & 3, c = item & 127, fr = lane & 15, fq = lane >> 4;
    LAS bf16* VT = (LAS bf16*)(lds + GL_VT); LAS float* cum = (LAS float*)(lds + GL_CUM); LAS float* tot = (LAS float*)(lds + GL_TOT);
    const bf16* LSp = (const bf16*)((const unsigned char*)a.out + DO_S); bf16x8 sfr[8][2];
#pragma unroll
    for (int j = 0; j < 8; ++j)
#pragma unroll
        for (int ks = 0; ks < 2; ++ks) sfr[j][ks] = *(const bf16x8*)(LSp + ((size_t)item * 128 + 16 * j + fr) * 64 + 32 * ks + 8 * fq);
    gla_cum2(cum, tot, (LAS float*)(lds + 47360), (const float*)(ws + WS_SMALL), a.in[9], a.in[10], b, h, c, th);
#pragma unroll
    for (int it = 0; it < 4; ++it) { const int id = th + 256 * it, s = id >> 4, u = id & 15; const size_t row = (size_t)b * T + 64 * c + s;
        const bf16x8 vr = *(const bf16x8*)(PROJ + row * PLD + PC_VG + h * 128 + 8 * u); const int pos = (s & 32) + perm32k(s & 31);
#pragma unroll
        for (int e = 0; e < 8; ++e) VT[(8 * u + e) * 72 + pos] = (bf16)vr[e]; }
    LAS bf16* KE = (LAS bf16*)(lds + GL_KT);
    { const int s = th >> 2, qd = th & 3; const bf16* kp = PROJ + ((size_t)b * T + 64 * c + s) * PLD + PC_KG + h * 64 + 16 * qd; const bf16x8 r0 = *(const bf16x8*)kp, r1 = *(const bf16x8*)(kp + 8);
      float f[16];
#pragma unroll
      for (int e = 0; e < 8; ++e) { f[e] = bf2f(r0[e]) * __expf(-cum[s * 65 + 16 * qd + e]); f[8 + e] = bf2f(r1[e]) * __expf(-cum[s * 65 + 16 * qd + 8 + e]); }
      *(LAS u32x4*)(KE + s * 72 + 16 * qd) = (u32x4){pk2(f[0], f[1]), pk2(f[2], f[3]), pk2(f[4], f[5]), pk2(f[6], f[7])};
      *(LAS u32x4*)(KE + s * 72 + 16 * qd + 8) = (u32x4){pk2(f[8], f[9]), pk2(f[10], f[11]), pk2(f[12], f[13]), pk2(f[14], f[15])}; }
    __syncthreads();
    const int tokq = 16 * tt + fr; const size_t rowq = (size_t)b * T + 64 * c + tokq;
    bf16x8 qf[2];
#pragma unroll
    for (int ks = 0; ks < 2; ++ks) { const bf16x8 raw = *(const bf16x8*)(PROJ + rowq * PLD + PC_QG + h * 64 + 32 * ks + 8 * fq);
#pragma unroll
        for (int e = 0; e < 8; ++e) qf[ks][e] = (short)f2bf(bf2f(raw[e]) * __expf(cum[tokq * 65 + 32 * ks + 8 * fq + e])); }
    f32x4 at[4];
#pragma unroll
    for (int st = 0; st < 4; ++st) { at[st] = (f32x4){0.f, 0.f, 0.f, 0.f};
        if (st <= tt) { const int s = 16 * st + fr; bf16x8 kf[2];
#pragma unroll
            for (int ks = 0; ks < 2; ++ks) kf[ks] = *(const LAS bf16x8*)(KE + s * 72 + 32 * ks + 8 * fq);
            at[st] = MFMA16(kf[0], qf[0], at[st]); at[st] = MFMA16(kf[1], qf[1], at[st]);
            if (st == tt) {
#pragma unroll
                for (int i = 0; i < 4; ++i) if (4 * fq + i > fr) at[st][i] = 0.f; } } }
    bf16x8 pf[2];
#pragma unroll
    for (int k2 = 0; k2 < 2; ++k2) { const u32x4 w = {pk2(at[2 * k2][0], at[2 * k2][1]), pk2(at[2 * k2][2], at[2 * k2][3]), pk2(at[2 * k2 + 1][0], at[2 * k2 + 1][1]), pk2(at[2 * k2 + 1][2], at[2 * k2 + 1][3])}; pf[k2] = __builtin_bit_cast(bf16x8, w); }
    f32x4 o[8]; float ssq = 0.f;
#pragma unroll
    for (int j = 0; j < 8; ++j) { const int dv0 = 16 * j; f32x4 acc = {0.f, 0.f, 0.f, 0.f};
#pragma unroll
        for (int ks = 0; ks < 2; ++ks) acc = MFMA16(sfr[j][ks], qf[ks], acc);
#pragma unroll
        for (int k2 = 0; k2 < 2; ++k2) { const bf16x8 vf = *(const LAS bf16x8*)(VT + (dv0 + fr) * 72 + 32 * k2 + 8 * fq); acc = MFMA16(vf, pf[k2], acc); }
        o[j] = acc; ssq += (acc[0] * acc[0] + acc[1] * acc[1]) + (acc[2] * acc[2] + acc[3] * acc[3]); }
    ssq += __shfl_xor(ssq, 16); ssq += __shfl_xor(ssq, 32);
    const float rstd = rsqrtf(ssq * (1.f / 128.f) + EPS);
#pragma unroll
    for (int j = 0; j < 8; ++j) { const int dvb = 16 * j + 4 * fq; const f32x4 gn = *(const f32x4*)(a.in[11] + dvb); const bf16* rp = PROJ + rowq * PLD + PC_RG + h * 128 + dvb; bf16* op = (bf16*)((unsigned char*)a.out + DO_OB) + rowq * 512 + h * 128 + dvb;
        const u32x2 rw = *(const u32x2*)rp; const float r0 = bflo(rw.x), r1 = bfhi(rw.x), r2 = bflo(rw.y), r3 = bfhi(rw.y);
        u32x2 w; w.x = pk2(o[j][0] * rstd * gn[0] * siluf_(r0), o[j][1] * rstd * gn[1] * siluf_(r1)); w.y = pk2(o[j][2] * rstd * gn[2] * siluf_(r2), o[j][3] * rstd * gn[3] * siluf_(r3));
        *(u32x2*)op = w; }
    __syncthreads();
}

__device__ __forceinline__ void gla_scan(unsigned char* ws, unsigned char* dout, LAS unsigned char* lds, int tid) {
    LAS float* sx = (LAS float*)lds;
    const int seg = tid >> 7, el = tid & 127;
    for (int e0 = blockIdx.x * 128; e0 < 8 * 128 * 32; e0 += gridDim.x * 128) { const int e = e0 + el;
        const int bh = e >> 12, dv = (e >> 5) & 127, dkp = e & 31;
        const size_t eo = (((size_t)bh * 128 * 128 + dv) * 64) / 2 + dkp; const unsigned* p = (const unsigned*)(dout + DO_L) + eo + (size_t)(32 * seg) * 4096; unsigned* ps = (unsigned*)(dout + DO_S) + eo + (size_t)(32 * seg) * 4096;
        const float* dp = (const float*)(ws + WS_DEC) + (size_t)bh * 128 * 64 + 2 * dkp + (32 * seg) * 64;
        float r0 = 0.f, r1 = 0.f, D0 = 1.f, D1 = 1.f;
#pragma unroll 16
        for (int c = 0; c < 32; ++c) { const unsigned w = p[(size_t)c * 4096]; const float d0 = dp[c * 64], d1 = dp[c * 64 + 1]; r0 = d0 * r0 + bflo(w); r1 = d1 * r1 + bfhi(w); D0 *= d0; D1 *= d1; }
        *(LAS f32x4*)(sx + (seg * 128 + el) * 4) = (f32x4){r0, r1, D0, D1};
        __syncthreads();
        r0 = 0.f; r1 = 0.f;
        for (int k = 0; k < seg; ++k) { const f32x4 v = *(const LAS f32x4*)(sx + (k * 128 + el) * 4); r0 = v[2] * r0 + v[0]; r1 = v[3] * r1 + v[1]; }
#pragma unroll 16
        for (int c = 0; c < 32; ++c) { const unsigned w = p[(size_t)c * 4096]; const float d0 = dp[c * 64], d1 = dp[c * 64 + 1]; ps[(size_t)c * 4096] = pk2(r0, r1); r0 = d0 * r0 + bflo(w); r1 = d1 * r1 + bfhi(w); }
        __syncthreads();
    }
}
constexpr int NT_TILE = 16384, NT_V = 8192, NT_TPS = 3, NT_R = 2 * NT_TPS, NS_WAVE = NT_R * NT_TILE, NS_WSZ = 2176, NS_UX = NS_WAVE + 8 * NS_WSZ, NS_JL = NS_UX + 128;
template <bool LOADV, class DescF, class CompF>
__device__ __forceinline__ void tile_loop(int n, DescF desc, CompF comp, LAS unsigned char* tb, int tid) {
    if (n <= 0) return;
#define NT_BAR() asm volatile("s_waitcnt lgkmcnt(0)\n\ts_barrier" ::: "memory")
    const int row = tid >> 3, unit = tid & 7, ns = (n + NT_TPS - 1) / NT_TPS;
    u32x4 kr[NT_TPS], vr[NT_TPS];
#define NT_GL(j) do { _Pragma("unroll") for (int u_ = 0; u_ < NT_TPS; ++u_) { int i_ = NT_TPS * (j) + u_; i_ = i_ < n ? i_ : n - 1; const bf16 *Kg_, *Vg_; int kp_, vp_; desc(i_, Kg_, kp_, Vg_, vp_); \
        kr[u_] = *(const u32x4*)(Kg_ + (size_t)row * kp_ + unit * 8); if (LOADV) vr[u_] = *(const u32x4*)(Vg_ + (size_t)row * vp_ + unit * 8); else vr[u_] = (u32x4){0u, 0u, 0u, 0u}; } } while (0)
#define NT_LS(half) do { _Pragma("unroll") for (int u_ = 0; u_ < NT_TPS; ++u_) { LAS unsigned char* p_ = tb + ((half) * NT_TPS + u_) * NT_TILE + row * 128 + ((unit ^ (row & 7)) * 16); \
        *(LAS u32x4*)p_ = kr[u_]; if (LOADV) *(LAS u32x4*)(p_ + NT_V) = vr[u_]; } } while (0)
    NT_GL(0); NT_LS(0);
    NT_BAR();
    for (int j = 0; j < ns; ++j) {
        if (j + 1 < ns) NT_GL(j + 1);
#pragma unroll
        for (int u = 0; u < NT_TPS; ++u) { const int i = NT_TPS * j + u; if (i < n) comp(i, tb + ((j & 1) * NT_TPS + u) * NT_TILE); }
        if (j + 1 < ns) NT_LS((j + 1) & 1);
        NT_BAR();
    }
#undef NT_GL
#undef NT_BAR
#undef NT_LS
}
__device__ __forceinline__ void lds_scores(f32x4 (&s)[4], const LAS unsigned char* buf, const bf16x8 (&q)[2], int fr, int fq, float cinit = 0.f) {
    const f32x4 c4 = {cinit, cinit, cinit, cinit};
#pragma unroll
    for (int h2 = 0; h2 < 2; ++h2) { bf16x8 kf[2][2];
#pragma unroll
        for (int t2 = 0; t2 < 2; ++t2) { const LAS unsigned char* kp = buf + (16 * (2 * h2 + t2) + fr) * 128; kf[t2][0] = *(const LAS bf16x8*)(kp + ((fq ^ (fr & 7)) * 16)); kf[t2][1] = *(const LAS bf16x8*)(kp + (((fq + 4) ^ (fr & 7)) * 16)); }
        asm volatile("" ::: "memory");
        __builtin_amdgcn_s_setprio(1);
#pragma unroll
        for (int t2 = 0; t2 < 2; ++t2) { s[2 * h2 + t2] = MFMA16(kf[t2][0], q[0], c4); s[2 * h2 + t2] = MFMA16(kf[t2][1], q[1], s[2 * h2 + t2]); }
        __builtin_amdgcn_s_setprio(0); }
}
__device__ __forceinline__ void lds_pv(f32x4 (&O)[4], const LAS unsigned char* buf, const f32x4 (&p)[4], int fr, int fq) {
    bf16x8 pf[2];
#pragma unroll
    for (int k2 = 0; k2 < 2; ++k2) { const u32x4 w = {pk2(p[2 * k2][0], p[2 * k2][1]), pk2(p[2 * k2][2], p[2 * k2][3]), pk2(p[2 * k2 + 1][0], p[2 * k2 + 1][1]), pk2(p[2 * k2 + 1][2], p[2 * k2 + 1][3])}; pf[k2] = __builtin_bit_cast(bf16x8, w); }
#pragma unroll
    for (int h2 = 0; h2 < 2; ++h2) { bf16x8 vf[2][2];
#pragma unroll
        for (int d2 = 0; d2 < 2; ++d2) { const LAS unsigned char* vp = buf + NT_V + (16 * (2 * h2 + d2) + fr) * 128; vf[d2][0] = *(const LAS bf16x8*)(vp + ((fq ^ (fr & 7)) * 16)); vf[d2][1] = *(const LAS bf16x8*)(vp + (((fq + 4) ^ (fr & 7)) * 16)); }
        asm volatile("" ::: "memory");
        __builtin_amdgcn_s_setprio(1);
#pragma unroll
        for (int d2 = 0; d2 < 2; ++d2) { O[2 * h2 + d2] = MFMA16(vf[d2][0], pf[0], O[2 * h2 + d2]); O[2 * h2 + d2] = MFMA16(vf[d2][1], pf[1], O[2 * h2 + d2]); }
        __builtin_amdgcn_s_setprio(0); }
}
template <int MODE, class MaskF>
__device__ __forceinline__ void attn_tile(const LAS unsigned char* buf, const bf16x8 (&q)[2], float& m, bool& st, float& l, f32x4 (&O)[4], bool rowsel, MaskF mask, int fr, int fq) {
    f32x4 s[4]; lds_scores(s, buf, q, fr, fq, (MODE == 1 && !rowsel) ? -INFINITY : -m);
    if (MODE == 2) {
#pragma unroll
        for (int t = 0; t < 4; ++t)
#pragma unroll
            for (int i = 0; i < 4; ++i) s[t][i] = mask(16 * t + 4 * fq + i) ? s[t][i] : -INFINITY; }
    float mx = max16f_(s);
    if (__builtin_amdgcn_ballot_w64(mx > 8.f || (!st && mx > -INFINITY)) != 0ull) {
        mx = fmaxf(mx, __shfl_xor(mx, 16)); mx = fmaxf(mx, __shfl_xor(mx, 32));
        const float dl = st ? fmaxf(mx, 0.f) : (mx > -INFINITY ? mx : 0.f), alpha = st ? __builtin_amdgcn_exp2f(-dl) : 1.f; st = st || (mx > -INFINITY); m += dl; l *= alpha;
#pragma unroll
        for (int dt = 0; dt < 4; ++dt) O[dt] = O[dt] * alpha;
#pragma unroll
        for (int t = 0; t < 4; ++t)
#pragma unroll
            for (int i = 0; i < 4; ++i) s[t][i] -= dl; }
    float rs = 0.f;
#pragma unroll
    for (int t = 0; t < 4; ++t)
#pragma unroll
        for (int i = 0; i < 4; ++i) { const float p = __builtin_amdgcn_exp2f(s[t][i]); s[t][i] = p; rs += p; }
    l += rs;
    lds_pv(O, buf, s, fr, fq);
}
__device__ __forceinline__ void nsa_block_item(int idx, unsigned char* ws, bf16* OA, LAS unsigned char* lds, int tid, int wave, int lane) {
    const bf16* PROJ = (const bf16*)(ws + WS_PROJ); const bf16* KROT = (const bf16*)(ws + WS_KROT);
    const int fr = lane & 15, fq = lane >> 4;
    const int ti = 255 - (idx >> 2), bg = idx & 3, b = bg >> 1, g = bg & 1, tb0 = 32 * ti, t0 = tb0 + 4 * wave;
    const int tokj = fr >> 2, hh = fr & 3, trow = t0 + tokj; const size_t grow = (size_t)b * T + trow;
    LAS unsigned char* wl = lds + NS_WAVE + wave * NS_WSZ;
    LAS float* imp = (LAS float*)wl; LAS unsigned* selw = (LAS unsigned*)(wl + 2112);
    LAS unsigned* ux = (LAS unsigned*)(lds + NS_UX); LAS unsigned char* jl = lds + NS_JL;
    bf16x8 qraw[2], qrot[2];
#pragma unroll
    for (int ks = 0; ks < 2; ++ks) { qraw[ks] = *(const bf16x8*)(PROJ + grow * PLD + PC_QN + (g * 4 + hh) * 64 + 32 * ks + 8 * fq);
        qrot[ks] = qraw[ks]; }
    if (fq < 2) qrot[0] = *(const bf16x8*)((const bf16*)(ws + WS_QROT) + grow * 128 + (g * 4 + hh) * 16 + 8 * fq);
    for (int i = lane; i < 528; i += 64) imp[i] = 0.f;
    f32x4 Ot[4];
#pragma unroll
    for (int dt = 0; dt < 4; ++dt) Ot[dt] = (f32x4){0.f, 0.f, 0.f, 0.f};
    const float* gp = (const float*)(ws + WS_SMALL) + grow * 64 + (g * 4 + hh) * 3;
    {
        const int nvr = trow >= 31 ? ((trow - 31) >> 4) + 1 : 0; const int nv0 = t0 >= 31 ? ((t0 - 31) >> 4) + 1 : 0; const int tl = tb0 + 31; const int nvm = tl >= 31 ? ((tl - 31) >> 4) + 1 : 0; const int ntile = (nvm + 63) >> 6;
        const bf16* Kc = (const bf16*)(ws + WS_KCMP) + (size_t)bg * 512 * 64; const bf16* Vc = (const bf16*)(ws + WS_VCMPT) + (size_t)bg * 64 * 512;
        auto desc = [&](int i, const bf16*& Kg, int& kp, const bf16*& Vg, int& vp) { Kg = Kc + (size_t)(64 * i) * 64; kp = 64; Vg = Vc + 64 * i; vp = 512; };
        float m = NEGB, l = 0.f;
        tile_loop<false>(ntile, desc, [&](int kt, const LAS unsigned char* buf) {
            f32x4 s[4]; lds_scores(s, buf, qraw, fr, fq);
            if (64 * kt + 64 > nv0) {
#pragma unroll
                for (int t = 0; t < 4; ++t)
#pragma unroll
                    for (int i = 0; i < 4; ++i) s[t][i] = (64 * kt + 16 * t + 4 * fq + i) < nvr ? s[t][i] : -INFINITY; }
            float mx = max16f_(s);
            if (__builtin_amdgcn_ballot_w64(mx > m + 8.f) != 0ull) { mx = fmaxf(mx, __shfl_xor(mx, 16)); mx = fmaxf(mx, __shfl_xor(mx, 32)); const float mn = fmaxf(m, mx); l *= __builtin_amdgcn_exp2f(m - mn); m = mn; }
            float rs = 0.f;
#pragma unroll
            for (int t = 0; t < 4; ++t)
#pragma unroll
                for (int i = 0; i < 4; ++i) rs += __builtin_amdgcn_exp2f(s[t][i] - m);
            l += rs; }, lds, tid);
        l += __shfl_xor(l, 16); l += __shfl_xor(l, 32);
        const float invl = l > 0.f ? 1.f / l : 0.f;
        f32x4 Oc[4];
#pragma unroll
        for (int dt = 0; dt < 4; ++dt) Oc[dt] = (f32x4){0.f, 0.f, 0.f, 0.f};
        tile_loop<true>(ntile, desc, [&](int kt, const LAS unsigned char* buf) {
            f32x4 s[4]; lds_scores(s, buf, qraw, fr, fq);
#pragma unroll
            for (int t = 0; t < 4; ++t)
#pragma unroll
                for (int i = 0; i < 4; ++i) { const bool okk = (64 * kt + 16 * t + 4 * fq + i) < nvr; s[t][i] = okk ? __builtin_amdgcn_exp2f(s[t][i] - m) * invl : 0.f; }
            lds_pv(Oc, buf, s, fr, fq);
#pragma unroll
            for (int t = 0; t < 4; ++t) { float s3 = (s[t][0] + s[t][1]) + (s[t][2] + s[t][3]), p3 = s[t][3];
                s3 += __shfl_xor(s3, 1); s3 += __shfl_xor(s3, 2); p3 += __shfl_xor(p3, 1); p3 += __shfl_xor(p3, 2);
                const int q = 16 * kt + 4 * t + fq;
                if (hh == 0) imp[tokj * 132 + q] += s3;
                asm volatile("s_waitcnt lgkmcnt(0)" ::: "memory");
                if (hh == 0) imp[tokj * 132 + q + 1] += p3;
                asm volatile("s_waitcnt lgkmcnt(0)" ::: "memory"); } }, lds, tid);
        const float gc = sigmoidf_(gp[0]);
#pragma unroll
        for (int dt = 0; dt < 4; ++dt) Ot[dt] = Oc[dt] * gc;
    }
    const int cur = tb0 >> 6;
    { const int tok = lane >> 4, sub = lane & 15; unsigned key[8]; bool cand[8];
#define ROW_SUM(x) do { x += __builtin_amdgcn_update_dpp(0, x, 0xB1, 0xF, 0xF, true); x += __builtin_amdgcn_update_dpp(0, x, 0x4E, 0xF, 0xF, true); \
        x += __builtin_amdgcn_update_dpp(0, x, 0x141, 0xF, 0xF, true); x += __builtin_amdgcn_update_dpp(0, x, 0x140, 0xF, 0xF, true); } while (0)
#pragma unroll
        for (int e = 0; e < 8; ++e) { const int j = 8 * sub + e; cand[e] = (j >= 1 && j <= cur - 2); key[e] = cand[e] ? __float_as_uint(imp[tok * 132 + j]) : 0u; }
        unsigned selb = 0;
        if (cur - 2 > 13) {
            unsigned tau = 0u;
            for (int bit = 30; bit >= 0; --bit) { const unsigned t = tau | (1u << bit); int c = 0;
#pragma unroll
                for (int e = 0; e < 8; ++e) c += (key[e] >= t) ? 1 : 0;
                ROW_SUM(c); tau = (c >= 13) ? t : tau; }
            int cg = 0, tc = 0;
#pragma unroll
            for (int e = 0; e < 8; ++e) { cg += (cand[e] && key[e] > tau) ? 1 : 0; tc += (cand[e] && key[e] == tau) ? 1 : 0; }
            ROW_SUM(cg); const int need = 13 - cg;
            int inc = tc; inc += __builtin_amdgcn_update_dpp(0, inc, 0x111, 0xF, 0xF, true); inc += __builtin_amdgcn_update_dpp(0, inc, 0x112, 0xF, 0xF, true);
            inc += __builtin_amdgcn_update_dpp(0, inc, 0x114, 0xF, 0xF, true); inc += __builtin_amdgcn_update_dpp(0, inc, 0x118, 0xF, 0xF, true);
            int before = inc - tc;
#pragma unroll
            for (int e = 0; e < 8; ++e) { const bool tie = cand[e] && key[e] == tau; const bool sl = cand[e] && (key[e] > tau || (tie && before < need)); before += tie ? 1 : 0; selb |= sl ? (1u << e) : 0u; }
        } else {
#pragma unroll
            for (int e = 0; e < 8; ++e) selb |= cand[e] ? (1u << e) : 0u; }
#undef ROW_SUM
        unsigned bits = 0;
#pragma unroll
        for (int e = 0; e < 8; ++e) { const int j = 8 * sub + e; const bool sel = (j <= cur) && (j == 0 || j >= cur - 1 || ((selb >> e) & 1u)); bits |= sel ? (1u << e) : 0u; }
        ((LAS unsigned char*)selw)[tok * 16 + sub] = (unsigned char)bits; }
    asm volatile("s_waitcnt lgkmcnt(0)" ::: "memory");
    unsigned sw[4], un[4];
#pragma unroll
    for (int w = 0; w < 4; ++w) { sw[w] = selw[tokj * 4 + w]; un[w] = __builtin_amdgcn_readfirstlane(selw[w] | selw[4 + w] | selw[8 + w] | selw[12 + w]); }
    if (lane == 0) { ux[wave * 4 + 0] = un[0]; ux[wave * 4 + 1] = un[1]; ux[wave * 4 + 2] = un[2]; ux[wave * 4 + 3] = un[3]; }
    __syncthreads();
    unsigned U[4];
#pragma unroll
    for (int w = 0; w < 4; ++w) { unsigned u = 0;
#pragma unroll
        for (int v2 = 0; v2 < 8; ++v2) u |= ux[v2 * 4 + w];
        U[w] = __builtin_amdgcn_readfirstlane(u); }
    const int nsl = __builtin_popcount(U[0]) + __builtin_popcount(U[1]) + __builtin_popcount(U[2]) + __builtin_popcount(U[3]);
    if (tid < 128) { const int w = tid >> 5, bit = tid & 31; const unsigned uw = w == 0 ? U[0] : w == 1 ? U[1] : w == 2 ? U[2] : U[3];
        if ((uw >> bit) & 1u) { int pos = __builtin_popcount(uw & ((1u << bit) - 1u)); if (w > 0) pos += __builtin_popcount(U[0]); if (w > 1) pos += __builtin_popcount(U[1]); if (w > 2) pos += __builtin_popcount(U[2]); jl[pos] = (unsigned char)tid; } }
    __syncthreads();
    {
        const bf16* Ks = KROT + ((size_t)g * M + (size_t)b * T) * 64; const bf16* Vs = (const bf16*)(ws + WS_VTS) + (size_t)bg * 128 * 4096;
        float m = 0.f, l = 0.f; bool st = false; f32x4 Os[4];
#pragma unroll
        for (int dt = 0; dt < 4; ++dt) Os[dt] = (f32x4){0.f, 0.f, 0.f, 0.f};
        tile_loop<true>(nsl, [&](int i, const bf16*& Kg, int& kp, const bf16*& Vg, int& vp) { const int j = jl[i]; Kg = Ks + (size_t)(64 * j) * 64; kp = 64; Vg = Vs + (size_t)j * 4096; vp = 64; },
            [&](int i, const LAS unsigned char* buf) { const int j = __builtin_amdgcn_readfirstlane((int)jl[i]); const int w = j >> 5, bit = j & 31;
                const unsigned uw = w == 0 ? un[0] : w == 1 ? un[1] : w == 2 ? un[2] : un[3];
                if (!((uw >> bit) & 1u)) return;
                const unsigned swv = w == 0 ? sw[0] : w == 1 ? sw[1] : w == 2 ? sw[2] : sw[3]; const bool rowsel = (swv >> bit) & 1u;
                if (j < cur) attn_tile<1>(buf, qrot, m, st, l, Os, rowsel, [&](int) { return true; }, fr, fq);
                else attn_tile<2>(buf, qrot, m, st, l, Os, rowsel, [&](int kk) { return rowsel && (64 * j + kk <= trow); }, fr, fq); }, lds, tid);
        l += __shfl_xor(l, 16); l += __shfl_xor(l, 32);
        const float gs = sigmoidf_(gp[1]) * (l > 0.f ? 1.f / l : 0.f);
#pragma unroll
        for (int dt = 0; dt < 4; ++dt) Ot[dt] += Os[dt] * gs;
    }
    {
        const bf16* Kw = KROT + ((size_t)(2 + g) * M + (size_t)b * T) * 64; const bf16* Vw = (const bf16*)(ws + WS_VTW) + (size_t)bg * 128 * 4096;
        float m = 0.f, l = 0.f; bool st = false; f32x4 Ow[4];
#pragma unroll
        for (int dt = 0; dt < 4; ++dt) Ow[dt] = (f32x4){0.f, 0.f, 0.f, 0.f};
        const int jlo = (tb0 > 511 ? tb0 - 511 : 0) >> 6, jhi = (tb0 + 31) >> 6;
        tile_loop<true>(jhi - jlo + 1, [&](int i, const bf16*& Kg, int& kp, const bf16*& Vg, int& vp) { const int j = jlo + i; Kg = Kw + (size_t)(64 * j) * 64; kp = 64; Vg = Vw + (size_t)j * 4096; vp = 64; },
            [&](int i, const LAS unsigned char* buf) { const int j = jlo + i;
                if (64 * j + 63 + 511 < t0 || 64 * j > t0 + 3) return;
                if (64 * j + 511 >= t0 + 3 && 64 * j + 63 <= t0) attn_tile<0>(buf, qrot, m, st, l, Ow, true, [&](int) { return true; }, fr, fq);
                else attn_tile<2>(buf, qrot, m, st, l, Ow, true, [&](int kk) { const int key = 64 * j + kk; return key <= trow && key + 511 >= trow; }, fr, fq); }, lds, tid);
        l += __shfl_xor(l, 16); l += __shfl_xor(l, 32);
        const float gw = sigmoidf_(gp[2]) * (l > 0.f ? 1.f / l : 0.f);
#pragma unroll
        for (int dt = 0; dt < 4; ++dt) Ot[dt] += Ow[dt] * gw;
    }
#pragma unroll
    for (int dt = 0; dt < 4; ++dt) { u32x2 w; w.x = pk2(Ot[dt][0], Ot[dt][1]); w.y = pk2(Ot[dt][2], Ot[dt][3]); *(u32x2*)(OA + grow * 512 + (g * 4 + hh) * 64 + 16 * dt + 4 * fq) = w; }
    __syncthreads();
}

#define XB_TMO      128
#define XB_XCNT(j)  (256  + 64 * (j))
#define XB_XSUB(j)  (1280 + 64 * (j))
#define XB_XGEN(j)  (2304 + 64 * (j))
#define XB_TOP      3328
#define XB_TOPGEN   3392
#define XCD_BAR_WORDS 3456
#define XB_SPIN_CAP (1u << 18)

__device__ __forceinline__ unsigned xb_ld(unsigned* p)              { return __hip_atomic_load(p, __ATOMIC_RELAXED, __HIP_MEMORY_SCOPE_AGENT); }
__device__ __forceinline__ unsigned xb_add(unsigned* p, unsigned v) { return __hip_atomic_fetch_add(p, v, __ATOMIC_RELAXED, __HIP_MEMORY_SCOPE_AGENT); }
__device__ __forceinline__ unsigned xb_xcc_id() { return (unsigned)__builtin_amdgcn_s_getreg((3 << 11) | 20) & 0xFu; }
#define XB_SPIN(cond, bar) do { unsigned _sp = 0; while (cond) { __builtin_amdgcn_s_sleep(1); \
    if ((++_sp & 255u) == 0u) { if (xb_ld(&(bar)[XB_TMO])) break; if (_sp > XB_SPIN_CAP) { atomicAdd(&(bar)[XB_TMO], 1u); break; } } } } while (0)

struct XcdBarrier {
    unsigned* bar; unsigned x;
    volatile LAS unsigned* st;
};

__device__ __forceinline__ XcdBarrier xcd_barrier_post(unsigned* bar, volatile LAS unsigned* st) {
    XcdBarrier b; b.bar = bar; b.x = xb_xcc_id(); b.st = st;
    if (threadIdx.x == 0) (void)xb_add(&bar[XB_XCNT(b.x)], 1u);
    return b;
}
__device__ __forceinline__ void xcd_barrier_complete(unsigned* bar, unsigned x, unsigned& nloc, unsigned& nx) {
    const unsigned G = gridDim.x * gridDim.y * gridDim.z;
    unsigned sum, cnt, mine, sp = 0u;
    for (;;) {
        sum = 0u; cnt = 0u; mine = 0u;
#pragma unroll
        for (unsigned j = 0; j < 16; ++j) { const unsigned c = xb_ld(&bar[XB_XCNT(j)]); sum += c; cnt += (c > 0u) ? 1u : 0u; mine = (j == x) ? c : mine; }
        if (sum == G) break;
        __builtin_amdgcn_s_sleep(1);
        if ((++sp & 255u) == 0u) { if (xb_ld(&bar[XB_TMO])) break; if (sp > XB_SPIN_CAP) { atomicAdd(&bar[XB_TMO], 1u); break; } }
    }
    nloc = mine > 0u ? mine : 1u; nx = cnt > 0u ? cnt : 1u;
}

__device__ __forceinline__ void xcd_barrier(const XcdBarrier& b) {
    asm volatile("s_waitcnt vmcnt(0)" ::: "memory");
    __syncthreads();
    if (threadIdx.x == 0) {
        unsigned* bar = b.bar;
        __builtin_amdgcn_s_waitcnt(0);
        unsigned nloc = b.st[0], nx = b.st[1];
        if (nloc == 0u) { xcd_barrier_complete(bar, b.x, nloc, nx); b.st[0] = nloc; b.st[1] = nx; }
        const unsigned old = xb_add(&bar[XB_XSUB(b.x)], 1u);
        const unsigned gen = old / nloc;
        if (old + 1u == (gen + 1u) * nloc) {
            __builtin_amdgcn_fence(__ATOMIC_RELEASE, "agent");
            asm volatile("s_waitcnt vmcnt(0)" ::: "memory");
            const unsigned og = xb_add(&bar[XB_TOP], 1u);
            const unsigned tg = og / nx;
            if (og + 1u == (tg + 1u) * nx) xb_add(&bar[XB_TOPGEN], 1u);
            else XB_SPIN(xb_ld(&bar[XB_TOPGEN]) == tg, bar);
            __builtin_amdgcn_fence(__ATOMIC_ACQUIRE, "agent");
            xb_add(&bar[XB_XGEN(b.x)], 1u);
            asm volatile("s_waitcnt vmcnt(0)" ::: "memory");
        } else {
            XB_SPIN(xb_ld(&bar[XB_XGEN(b.x)]) == gen, bar);
            __builtin_amdgcn_fence(__ATOMIC_ACQUIRE, "agent");
            asm volatile("s_waitcnt vmcnt(0)" ::: "memory");
        }
    }
    __syncthreads();
}

__global__ void __launch_bounds__(NTHR, 2) fwd_megakernel(Args a) {
    extern __shared__ __attribute__((aligned(16))) unsigned char lds_raw[];
    cg::grid_group grid = cg::this_grid();
    unsigned bar_k_ = 0;
#define GRID_SYNC() do { asm volatile("s_waitcnt vmcnt(0) lgkmcnt(0)" ::: "memory"); __syncthreads(); \
    if (threadIdx.x == 0) { unsigned* bw_ = (unsigned*)(a.ws + WS_CTL) + 16384; const unsigned G_ = gridDim.x, k1_ = bar_k_ + 1u; \
        __builtin_amdgcn_fence(__ATOMIC_RELEASE, "agent"); asm volatile("s_waitcnt vmcnt(0)" ::: "memory"); \
        if (G_ % 16u) { __hip_atomic_fetch_add(bw_, 1u, __ATOMIC_RELAXED, __HIP_MEMORY_SCOPE_AGENT); while (__hip_atomic_load(bw_, __ATOMIC_RELAXED, __HIP_MEMORY_SCOPE_AGENT) < k1_ * G_) __builtin_amdgcn_s_sleep(1); } \
        else { const unsigned grp_ = blockIdx.x >> 4; unsigned* gc_ = bw_ + 64u * (1u + grp_); unsigned* gr_ = bw_ + 64u * (33u + grp_); \
            if (__hip_atomic_fetch_add(gc_, 1u, __ATOMIC_RELAXED, __HIP_MEMORY_SCOPE_AGENT) == k1_ * 16u - 1u) { __hip_atomic_fetch_add(bw_, 1u, __ATOMIC_RELAXED, __HIP_MEMORY_SCOPE_AGENT); \
                while (__hip_atomic_load(bw_, __ATOMIC_RELAXED, __HIP_MEMORY_SCOPE_AGENT) < k1_ * (G_ >> 4)) __builtin_amdgcn_s_sleep(1); \
                __hip_atomic_store(gr_, k1_, __ATOMIC_RELAXED, __HIP_MEMORY_SCOPE_AGENT); } \
            else { while (__hip_atomic_load(gr_, __ATOMIC_RELAXED, __HIP_MEMORY_SCOPE_AGENT) < k1_) __builtin_amdgcn_s_sleep(1); } } \
        __builtin_amdgcn_fence(__ATOMIC_ACQUIRE, "agent"); asm volatile("s_waitcnt vmcnt(0)" ::: "memory"); } \
    ++bar_k_; __syncthreads(); } while (0)
    grid.sync();
    LAS unsigned char* lds = (LAS unsigned char*)lds_raw;
    unsigned char* ws = a.ws;
    const int tid = threadIdx.x, lane = tid & 63, wave = __builtin_amdgcn_readfirstlane(tid >> 6);
    const int G = gridDim.x, bx = blockIdx.x;
    bf16* PROJ = (bf16*)(ws + WS_PROJ);
    float* ROWSQ1 = (float*)(ws + WS_RSQ1); float* ROWSQ2 = (float*)(ws + WS_RSQ2);

    { LAS unsigned* z_ = (LAS unsigned*)(lds + 131072 + 64); if (tid < 2) z_[tid] = 0u; }
    __syncthreads();
    int vb = bx;
    { LAS unsigned* cw = (LAS unsigned*)(lds + 131072);
      if (tid == 0) { const unsigned x = (unsigned)__builtin_amdgcn_s_getreg((3 << 11) | 20) & 0xFu; const unsigned r = __hip_atomic_fetch_add((unsigned*)(ws + WS_CTL) + 64 + 64 * x, 1u, __ATOMIC_RELAXED, __HIP_MEMORY_SCOPE_AGENT);
          cw[0] = (x < 8u && r < (unsigned)(G / 8) && (G % 8) == 0) ? (r * 8u + x) : 0xffffffffu; }
      __syncthreads();
      const unsigned v = cw[0]; vb = (v == 0xffffffffu) ? -1 : (int)v; }
    bf16* OA = (bf16*)((unsigned char*)a.out + DO_OA); bf16* OB = (bf16*)((unsigned char*)a.out + DO_OB);
#ifndef REPEAT_P
#define REPEAT_P -1
#endif
#define PHASE_REP(k) for (int rep_ = 0; rep_ < ((REPEAT_P == (k)) ? 2 : 1); ++rep_)
    p0_prologue(a, lds, wave, lane);
    if (vb < 0) { if (tid == 0) __hip_atomic_fetch_add((unsigned*)(ws + WS_CTL) + 32, 1u, __ATOMIC_RELAXED, __HIP_MEMORY_SCOPE_AGENT); }
    GRID_SYNC();
    if (__hip_atomic_load((unsigned*)(ws + WS_CTL) + 32, __ATOMIC_RELAXED, __HIP_MEMORY_SCOPE_AGENT) != 0u) vb = bx;
    PHASE_REP(1) { pg8::Gemm g{(const bf16*)(ws + WS_XN), (const bf16*)(ws + WS_WIN), M, NIN, D, D}; pg8::StaticOrder S; S.init(M, NIN, G, vb);
      EpiProj E{PROJ, (float*)(ws + WS_SMALL), (bf16*)(ws + WS_CSRC)};
      pg8::gemm_phase<EpiProj, pg8::StaticOrder, true, true>(lds, g, S, E);
    GRID_SYNC(); }
    PHASE_REP(2) {
    { const int vv_ = vb >= 0 ? vb : bx; const int grp_ = (vv_ & 7) * (G / 32) + (vv_ >> 5), sub_ = (vv_ >> 3) & 3;
      if (G == 256) compress_item(grp_, sub_, ws, lds, wave, lane); else if (bx < 64) for (int q_ = 0; q_ < 4; ++q_) compress_item(bx, q_, ws, lds, wave, lane); }
    for (int it = bx; it < 512; it += G) gla_local_pair(it, a, lds, tid, wave, lane);
    for (int it = (G - 1 - bx) * NWAVES + wave; it < 256 * 2; it += G * NWAVES) p2a_item(it, ws, lds + wave * 18432, lane);
    for (int it = bx * NWAVES + wave; it < M / 8; it += G * NWAVES) rope_item(it, ws, lane);
    GRID_SYNC(); }
    PHASE_REP(3) {
    gla_scan(ws, (unsigned char*)a.out, lds, tid);
    __syncthreads();
    { const int vv_ = vb >= 0 ? vb : bx; const int xcc_ = vv_ & 7, q_ = ((xcc_ >> 2) * (G / 8) + (vv_ >> 3)), nq_ = 2 * (G / 8);
      for (int r_ = 0; r_ * nq_ < 256; ++r_) { const int o_ = (r_ & 1) ? (nq_ - 1 - q_) : q_; const int tr_ = r_ * nq_ + o_; if (tr_ >= 256) continue;
        const int idx = (tr_ << 2) | (xcc_ & 3);
        nsa_block_item(idx, ws, OA, lds, tid, wave, lane); } }
    GRID_SYNC(); }
    PHASE_REP(4) {
    for (int it = bx; it < 512; it += G) gla_out_pair(it, a, lds, tid, wave, lane);
    GRID_SYNC(); }
    PHASE_REP(5) {
    { pg8::Gemm g{OA, (const bf16*)(ws + WS_WUPA), 2 * M, 2 * D, 512, 512}; UpOrder S; S.so.init(M, D, G, vb);
      EpiUp2 E{PROJ, PROJ, PLD};
      pg8::gemm_phase<EpiUp2, UpOrder, true, true>(lds, g, S, E); }
    { pg8::StaticOrder S; S.init(M, D, G, vb); pg8::Unit u; S.next(0, u);
      asm volatile("s_waitcnt vmcnt(0) lgkmcnt(0)" ::: "memory"); __syncthreads();
      if (tid == 0) { __builtin_amdgcn_fence(__ATOMIC_RELEASE, "agent"); asm volatile("s_waitcnt vmcnt(0)" ::: "memory");
          unsigned* c_ = (unsigned*)(ws + WS_CTL) + 12288 + 64 * u.pm; __hip_atomic_fetch_add(c_, 1u, __ATOMIC_RELAXED, __HIP_MEMORY_SCOPE_AGENT);
          while (__hip_atomic_load(c_, __ATOMIC_RELAXED, __HIP_MEMORY_SCOPE_AGENT) < 4u) __builtin_amdgcn_s_sleep(1);
          __builtin_amdgcn_fence(__ATOMIC_ACQUIRE, "agent"); asm volatile("s_waitcnt vmcnt(0)" ::: "memory"); }
      __syncthreads(); } }
    PHASE_REP(6) {
    { pg8::Gemm g{PROJ, (const bf16*)(ws + WS_WOUT), M, D, D, PLD}; pg8::StaticOrder S; S.init(M, D, G, vb);
      EpiRes<true> E{a.in[0], a.out, (bf16*)(ws + WS_XB), ROWSQ1};
      pg8::gemm_phase<EpiRes<true>, pg8::StaticOrder, false, true>(lds, g, S, E); }
    GRID_SYNC(); }
    PHASE_REP(7) {
    { pg8::Gemm g{(const bf16*)(ws + WS_XB), (const bf16*)(ws + WS_WGU), M, NGU, D, D}; pg8::StaticOrder S; S.init(M, NGU, G, vb);
      EpiFfn E{(bf16*)(ws + WS_H), ROWSQ1};
      pg8::gemm_phase<EpiFfn, pg8::StaticOrder, true, true>(lds, g, S, E); }
    GRID_SYNC(); }
    { pg8::Gemm g{(const bf16*)(ws + WS_H), (const bf16*)(ws + WS_WDN), M, D, DFF, DFF}; pg8::StaticOrder S; S.init(M, D, G, vb);
      EpiFinal E{(const bf16*)(ws + WS_XB), a.out, ROWSQ2, (unsigned*)(ws + WS_CTL) + 8192, a.in[19]};
      pg8::gemm_phase<EpiFinal, pg8::StaticOrder, false, true>(lds, g, S, E); }
}

extern "C" void kernel_launch(void* const* d_in, const int* in_sizes, int n_in, void* d_out, int out_size, void* d_ws, size_t ws_size, hipStream_t stream) {
    static int grid = 0;
    if (grid == 0) {
        if (n_in != 20 || in_sizes[0] != M * D || out_size != M * D || ws_size < WS_END) { fprintf(stderr, "kernel_launch: unexpected shapes (n_in %d, in0 %d, out %d, ws %zu)\n", n_in, n_in > 0 ? in_sizes[0] : -1, out_size, ws_size); grid = -1; return; }
        int dev = 0, cus = 0, per_cu = 0;
        hipGetDevice(&dev); hipDeviceGetAttribute(&cus, hipDeviceAttributeMultiprocessorCount, dev);
        hipFuncSetAttribute((const void*)fwd_megakernel, hipFuncAttributeMaxDynamicSharedMemorySize, LDS_BYTES);
        hipOccupancyMaxActiveBlocksPerMultiprocessor(&per_cu, (const void*)fwd_megakernel, NTHR, LDS_BYTES);
        if (per_cu < 1) { fprintf(stderr, "kernel_launch: occupancy query says %d blocks per CU\n", per_cu); per_cu = 1; }
        (void)hipGetLastError();
        grid = cus * per_cu; if (grid > 256) grid = 256;
        if (grid != 256) { fprintf(stderr, "kernel_launch: this kernel needs exactly 256 co-resident workgroups (one 256x256 output tile per workgroup in the fused epilogues); the device offers %d; nothing launched\n", grid); grid = -1; return; }
    }
    if (grid < 0) return;
    (void)hipMemsetAsync((char*)d_ws + WS_CTL, 0, 98304, stream);
    Args a{};
    for (int i = 0; i < 20; ++i) a.in[i] = (const float*)d_in[i];
    a.out = (float*)d_out; a.ws = (unsigned char*)d_ws;
    void* args[] = {&a};
    hipError_t e = hipLaunchCooperativeKernel((const void*)fwd_megakernel, dim3(grid), dim3(NTHR), args, LDS_BYTES, stream);
    if (e != hipSuccess) fprintf(stderr, "cooperative launch failed: %s (grid %d)\n", hipGetErrorString(e), grid);
}
```

```cpp
#include <hip/hip_runtime.h>
#include <hip/hip_cooperative_groups.h>
#include <cstdio>
#include <cstdint>
namespace cg = cooperative_groups;
namespace pg8 {
#define PG8_LAS __attribute__((address_space(3)))
typedef unsigned short bf16_t;
typedef short bf16x8 __attribute__((ext_vector_type(8)));
typedef float f32x4 __attribute__((ext_vector_type(4)));
typedef unsigned u32x4 __attribute__((ext_vector_type(4)));
constexpr int BM = 256, BK = 64, HALF = 128, HTB = HALF * BK * 2  , STAGE_BYTES = 8 * HTB, NXCD = 8, WGM = 8;

__host__ __device__ __forceinline__ int lds_byte(int r, int c) { const int st = (r >> 4) * 2 + (c >> 5), rr = r & 15, cc = c & 31, ob = rr * 64 + cc * 2; return st * 1024 + (ob ^ (((ob >> 9) & 1) << 5)); }
__host__ __device__ __forceinline__ void stage_rc(int b, int& R, int& C) { const int st = b / 1024, sb = b % 1024, swz = sb ^ (((sb >> 9) & 1) << 5); R = (st >> 1) * 16 + swz / 64; C = (st & 1) * 32 + (swz % 64) / 2; }
__host__ __device__ __forceinline__ int perm32(int rho) { const int n = rho >> 4, i = rho & 15; return 8 * (i >> 2) + 4 * n + (i & 3); }

struct Unit { int pm, pn; };
struct Gemm { const bf16_t* A; const bf16_t* Bt; int M, N, K, lda; };

struct StaticOrder {
    int nM, nN, nwg, G, c;
    __host__ __device__ void init(int M, int N, int G_, int c_) { nM = M / BM; nN = N / BM; nwg = nM * nN; G = G_; c = c_; }
    __host__ __device__ bool next(int i, Unit& u) const {
        const long L = (long)i * G + c; if (L >= nwg) return false;
        int wgid = (int)L; { const int q = nwg / NXCD, r = nwg % NXCD, xcd = wgid % NXCD, off = wgid / NXCD; wgid = (xcd < r ? xcd * (q + 1) : r * (q + 1) + (xcd - r) * q) + off; }
        const int nig = WGM * nN, gid = wgid / nig, fm = gid * WGM, gsz = (nM - fm) < WGM ? (nM - fm) : WGM;
        u.pm = fm + ((wgid % nig) % gsz); u.pn = (wgid % nig) / gsz; return true;
    }
    __device__ __forceinline__ void a_ready(const Unit&) const {}
    __device__ __forceinline__ void done(const Unit&) const {}
};

__device__ __forceinline__ unsigned cvt_pk_bf16(float lo, float hi) { unsigned r; asm volatile("v_cvt_pk_bf16_f32 %0, %1, %2" : "=v"(r) : "v"(lo), "v"(hi)); return r; }
template <class Epi, class Sched, bool ALIGN_EPI = false, bool SP2 = false>
__device__ __forceinline__ void gemm_phase(PG8_LAS unsigned char* lds, const Gemm g, const Sched& S, const Epi& E) {
    int tid_ = threadIdx.x; asm volatile("" : "+v"(tid_));
    const int tid = tid_, wid = __builtin_amdgcn_readfirstlane(tid >> 6), lane = tid & 63, wr = wid >> 2, wc = wid & 3, fr = lane & 15, fq = lane >> 4;
    const int K = g.K, nt = K / BK;
    unsigned voffA[2], voffB[2];
#pragma unroll
    for (int i = 0; i < 2; ++i) { int R, C; stage_rc(tid * 16 + i * 8192, R, C); const int Rb = Epi::PERM ? ((R & ~31) + perm32(R & 31)) : R;
        voffA[i] = (unsigned)(R * g.lda + C) * 2u; voffB[i] = (unsigned)(Rb * K + C) * 2u; }
    const size_t kstep = (size_t)(BK * 2);
    const size_t hstep = (size_t)HALF * K * 2;
    const size_t tstep = 2 * hstep; const size_t hstepA = (size_t)HALF * g.lda * 2, tstepA = 2 * hstepA;
    const unsigned ldsw = (unsigned)wid * 1024u;
    const int aoff = lds_byte(wr * 64 + fr, fq * 8), boff = lds_byte(wc * 32 + fr, fq * 8);
#define PG8_SA(b, h) (((b) * 2 + (h)) * HTB)
#define PG8_SB(b, h) ((4 + (b) * 2 + (h)) * HTB)
#define PG8_STAGE(bufoff, gbase, voff) do { _Pragma("unroll") for (int _i = 0; _i < 2; ++_i) \
        __builtin_amdgcn_global_load_lds((const unsigned*)((const char*)(gbase) + (voff)[_i]), (PG8_LAS unsigned*)(lds + (bufoff) + ldsw + _i * 8192), 16, 0, 0); } while (0)
#define PG8_LDA(dst, b, h) do { _Pragma("unroll") for (int m = 0; m < 4; ++m) _Pragma("unroll") for (int k = 0; k < 2; ++k) dst[m][k] = *(const PG8_LAS bf16x8*)(lds + PG8_SA(b, h) + aoff + m * 2048 + k * 1024); } while (0)
#define PG8_LDB(dst, b, h) do { _Pragma("unroll") for (int n = 0; n < 2; ++n) _Pragma("unroll") for (int k = 0; k < 2; ++k) dst[n][k] = *(const PG8_LAS bf16x8*)(lds + PG8_SB(b, h) + boff + n * 2048 + k * 1024); } while (0)
#define PG8_MMA(ai, bj, At, Bt) do { __builtin_amdgcn_s_setprio(1); _Pragma("unroll") for (int m = 0; m < 4; ++m) _Pragma("unroll") for (int n = 0; n < 2; ++n) _Pragma("unroll") for (int k = 0; k < 2; ++k) \
        acc[ai][bj][m][n] = __builtin_amdgcn_mfma_f32_16x16x32_bf16(Bt[n][k], At[m][k], acc[ai][bj][m][n], 0, 0, 0); __builtin_amdgcn_s_setprio(0); } while (0)
#define PG8_WAIT_V(n) asm volatile("s_waitcnt vmcnt(" #n ")" ::: "memory")
#define PG8_WAIT_L(n) asm volatile("s_waitcnt lgkmcnt(" #n ")" ::: "memory")
#define PG8_BAR __builtin_amdgcn_s_barrier()
#define PG8_SCHED __builtin_amdgcn_sched_barrier(0)
    Unit cur, nxt; int ui = 0;
    if (!S.next(0, cur)) return;
    f32x4 acc[2][2][4][2];
#pragma unroll
    for (int a = 0; a < 2; ++a)
#pragma unroll
        for (int b = 0; b < 2; ++b)
#pragma unroll
            for (int m = 0; m < 4; ++m)
#pragma unroll
                for (int n = 0; n < 2; ++n) acc[a][b][m][n] = (f32x4){0.f, 0.f, 0.f, 0.f};
    bf16x8 At[4][2], B0[2][2], B1[2][2];
    const char* cA = (const char*)g.A + (size_t)cur.pm * tstepA; const char* cB = (const char*)g.Bt + (size_t)cur.pn * tstep;
    S.a_ready(cur);
    if constexpr (SP2) {
        PG8_STAGE(PG8_SB(0, 0), cB, voffB); PG8_STAGE(PG8_SB(0, 1), cB + hstep, voffB); PG8_STAGE(PG8_SA(0, 0), cA, voffA); PG8_STAGE(PG8_SA(0, 1), cA + hstepA, voffA);
        if (wr == 1) PG8_BAR;
        PG8_WAIT_V(2); PG8_BAR;
        PG8_STAGE(PG8_SB(1, 0), cB + kstep, voffB); PG8_STAGE(PG8_SA(1, 0), cA + kstep, voffA); PG8_STAGE(PG8_SB(1, 1), cB + hstep + kstep, voffB);
        PG8_WAIT_V(6); PG8_BAR;
    } else {
        PG8_STAGE(PG8_SB(0, 0), cB, voffB); PG8_STAGE(PG8_SA(0, 0), cA, voffA); PG8_STAGE(PG8_SB(0, 1), cB + hstep, voffB); PG8_STAGE(PG8_SA(0, 1), cA + hstepA, voffA);
        if (wr == 1) PG8_BAR;
        PG8_WAIT_V(4); PG8_BAR;
        PG8_STAGE(PG8_SB(1, 0), cB + kstep, voffB); PG8_STAGE(PG8_SA(1, 0), cA + kstep, voffA); PG8_STAGE(PG8_SB(1, 1), cB + hstep + kstep, voffB);
        PG8_WAIT_V(6); PG8_BAR;
    }
    for (;;) {
        const bool has_next = S.next(ui + 1, nxt);
        const char* nA = has_next ? (const char*)g.A + (size_t)nxt.pm * tstepA : cA; const char* nB = has_next ? (const char*)g.Bt + (size_t)nxt.pn * tstep : cB;
        for (int t = 0; t < nt; t += 2) {
            const bool last = (t == nt - 2);
            const char* a1 = cA + (size_t)(t + 1) * kstep;
            const char* a2 = last ? nA : cA + (size_t)(t + 2) * kstep; const char* b2 = last ? nB : cB + (size_t)(t + 2) * kstep;
            const char* a3 = a2 + kstep; const char* b3 = b2 + kstep;
            if (last && has_next) S.a_ready(nxt);
            if constexpr (SP2) {
            PG8_LDB(B0, 0, 0); PG8_LDB(B1, 0, 1); PG8_SCHED; PG8_LDA(At, 0, 0); PG8_STAGE(PG8_SA(1, 1), a1 + hstepA, voffA);
            PG8_WAIT_V(8); PG8_WAIT_L(0); PG8_BAR; PG8_MMA(0, 0, At, B0); PG8_MMA(0, 1, At, B1); PG8_BAR; PG8_SCHED;
            PG8_LDA(At, 0, 1); PG8_STAGE(PG8_SB(0, 0), b2, voffB); PG8_STAGE(PG8_SB(0, 1), b2 + hstep, voffB); PG8_STAGE(PG8_SA(0, 0), a2, voffA);
            PG8_WAIT_V(8); PG8_WAIT_L(0); PG8_BAR; PG8_MMA(1, 0, At, B0); PG8_MMA(1, 1, At, B1); PG8_BAR; PG8_SCHED;
            PG8_LDB(B0, 1, 0); PG8_LDB(B1, 1, 1); PG8_SCHED; PG8_LDA(At, 1, 0); PG8_STAGE(PG8_SA(0, 1), a2 + hstepA, voffA);
            PG8_WAIT_V(8); PG8_WAIT_L(0); PG8_BAR; PG8_MMA(0, 0, At, B0); PG8_MMA(0, 1, At, B1); PG8_BAR; PG8_SCHED;
            PG8_LDA(At, 1, 1); PG8_STAGE(PG8_SB(1, 0), b3, voffB); PG8_STAGE(PG8_SB(1, 1), b3 + hstep, voffB); PG8_STAGE(PG8_SA(1, 0), a3, voffA);
            PG8_WAIT_V(8); PG8_WAIT_L(0); PG8_BAR; PG8_MMA(1, 0, At, B0); PG8_MMA(1, 1, At, B1); PG8_BAR; PG8_SCHED;
            } else {
            PG8_LDB(B0, 0, 0); PG8_SCHED; PG8_LDA(At, 0, 0); PG8_STAGE(PG8_SA(1, 1), a1 + hstepA, voffA);
            PG8_WAIT_L(8); PG8_BAR; PG8_WAIT_L(0); PG8_MMA(0, 0, At, B0); PG8_BAR; PG8_SCHED;
            PG8_LDB(B1, 0, 1); PG8_STAGE(PG8_SB(0, 0), b2, voffB);
            PG8_BAR; PG8_WAIT_L(0); PG8_MMA(0, 1, At, B1); PG8_BAR;
            PG8_LDA(At, 0, 1); PG8_STAGE(PG8_SA(0, 0), a2, voffA);
            PG8_BAR; PG8_WAIT_L(0); PG8_MMA(1, 0, At, B0); PG8_BAR; PG8_SCHED;
            PG8_STAGE(PG8_SB(0, 1), b2 + hstep, voffB);
            PG8_WAIT_V(6); PG8_BAR; PG8_MMA(1, 1, At, B1); PG8_BAR;
            PG8_LDB(B0, 1, 0); PG8_SCHED; PG8_LDA(At, 1, 0); PG8_STAGE(PG8_SA(0, 1), a2 + hstepA, voffA);
            PG8_WAIT_L(8); PG8_BAR; PG8_WAIT_L(0); PG8_MMA(0, 0, At, B0); PG8_BAR; PG8_SCHED;
            PG8_LDB(B1, 1, 1); PG8_STAGE(PG8_SB(1, 0), b3, voffB);
            PG8_BAR; PG8_WAIT_L(0); PG8_MMA(0, 1, At, B1); PG8_BAR;
            PG8_LDA(At, 1, 1); PG8_STAGE(PG8_SA(1, 0), a3, voffA);
            PG8_BAR; PG8_WAIT_L(0); PG8_MMA(1, 0, At, B0); PG8_BAR; PG8_SCHED;
            PG8_STAGE(PG8_SB(1, 1), b3 + hstep, voffB);
            PG8_WAIT_V(6); PG8_BAR; PG8_MMA(1, 1, At, B1); PG8_BAR;
            }
        }
        if constexpr (ALIGN_EPI) { if (wr == 0) PG8_BAR; }
        if constexpr (!Epi::AFTER_DRAIN) { E(acc, cur, wr, wc, fr, fq); S.done(cur); }
        if (!has_next) break;
#pragma unroll
        for (int a = 0; a < 2; ++a)
#pragma unroll
            for (int b = 0; b < 2; ++b)
#pragma unroll
                for (int m = 0; m < 4; ++m)
#pragma unroll
                    for (int n = 0; n < 2; ++n) acc[a][b][m][n] = (f32x4){0.f, 0.f, 0.f, 0.f};
        cur = nxt; cA = nA; cB = nB; ++ui;
        if constexpr (ALIGN_EPI) { if (wr == 1) PG8_BAR; }
    }
    PG8_WAIT_V(0);
    if constexpr (!ALIGN_EPI) { if (wr == 0) PG8_BAR; }
    PG8_BAR;
    if constexpr (Epi::AFTER_DRAIN) { E.fused(acc, cur, wr, wc, fr, fq, lds, wid, lane); S.done(cur); }
#undef PG8_SA
#undef PG8_SB
#undef PG8_STAGE
#undef PG8_LDA
#undef PG8_LDB
#undef PG8_MMA
#undef PG8_WAIT_V
#undef PG8_WAIT_L
#undef PG8_BAR
#undef PG8_SCHED
}
}

#define LAS __attribute__((address_space(3)))
typedef unsigned short bf16;
typedef short bf16x8 __attribute__((ext_vector_type(8)));
typedef float f32x4 __attribute__((ext_vector_type(4)));
typedef unsigned u32x4 __attribute__((ext_vector_type(4)));
typedef unsigned u32x2 __attribute__((ext_vector_type(2)));
constexpr int NWAVES = 8, NTHR = 512;
constexpr int BATCH = 2, T = 8192, D = 1024, M = BATCH * T, DFF = 2816;
constexpr int PLD = 4864;
constexpr int PC_QN = 0, PC_KV = 512, PC_QG = 1280, PC_KG = 1536, PC_VG = 1792, PC_RG = 2304, PC_GM = 2816;
constexpr int NIN = 5120, NGU = 5632;
constexpr float EPS = 1e-6f, NEGB = -1e30f;
constexpr size_t MiB = 1u << 20;
constexpr size_t WS_CTL = 0, CTL_BYTES = 1 * MiB;
constexpr size_t WS_WIN = 1 * MiB, WS_WGU = 11 * MiB, WS_WDN = 22 * MiB, WS_WOUT = 28 * MiB, WS_WUPA = 30 * MiB, WS_WUPB = 31 * MiB;
constexpr size_t WS_CW1K = 32 * MiB, WS_CW1V = 32 * MiB + 512 * 1024, WS_CW2K = 33 * MiB, WS_CW2V = 33 * MiB + 16384;
constexpr size_t WS_KCMP = 33 * MiB + 65536, WS_VCMPT = 33 * MiB + 65536 + 262144;
constexpr size_t WS_ROPE = 34 * MiB, WS_SMALL = 35 * MiB, WS_DEC = 39 * MiB, WS_RSQ1 = 39 * MiB + 262144, WS_RSQ2 = 39 * MiB + 524288;
constexpr size_t WS_XN = 40 * MiB, WS_XB = 40 * MiB;
constexpr size_t WS_PROJ = 72 * MiB, WS_H = 72 * MiB;
constexpr size_t WS_QROT = 224 * MiB, WS_CSRC = 228 * MiB, WS_KROT = 240 * MiB, WS_VTS = 248 * MiB, WS_VTW = 252 * MiB, WS_END = 256 * MiB;
constexpr size_t DO_L = 0, DO_S = 16 * MiB, DO_OA = 32 * MiB, DO_OB = 48 * MiB;
constexpr int LDS_BYTES = 147456;

__device__ __forceinline__ unsigned pk2(float lo, float hi) { return pg8::cvt_pk_bf16(lo, hi); }
__device__ __forceinline__ float bflo(unsigned w) { return __uint_as_float(w << 16); }
__device__ __forceinline__ float bfhi(unsigned w) { return __uint_as_float(w & 0xffff0000u); }
__device__ __forceinline__ float bf2f(short s) { return __uint_as_float(((unsigned)(unsigned short)s) << 16); }
__device__ __forceinline__ unsigned short f2bf(float f) { return (unsigned short)(pk2(f, 0.f) & 0xffffu); }
__device__ __forceinline__ float sigmoidf_(float x) { return __builtin_amdgcn_rcpf(1.f + __expf(-x)); }
__device__ __forceinline__ float siluf_(float x) { return x * __builtin_amdgcn_rcpf(1.f + __expf(-x)); }
__device__ __forceinline__ float wave_sum(float v) {
#pragma unroll
    for (int o = 1; o < 64; o <<= 1) v += __shfl_xor(v, o);
    return v;
}
#define LDS_WAIT() asm volatile("s_waitcnt lgkmcnt(0)" ::: "memory")
__device__ __forceinline__ float max3f_(float a, float b, float c) { float r; asm("v_max3_f32 %0, %1, %2, %3" : "=v"(r) : "v"(a), "v"(b), "v"(c)); return r; }
__device__ __forceinline__ float max16f_(const f32x4 (&s)[4]) {
    const float m1 = max3f_(s[0][0], s[0][1], s[0][2]), m2 = max3f_(s[0][3], s[1][0], s[1][1]), m3 = max3f_(s[1][2], s[1][3], s[2][0]), m4 = max3f_(s[2][1], s[2][2], s[2][3]), m5 = max3f_(s[3][0], s[3][1], s[3][2]);
    return max3f_(max3f_(m1, m2, s[3][3]), max3f_(m3, m4, m5), m1); }
__device__ __forceinline__ int perm32k(int w) { return 8 * ((w >> 2) & 3) + 4 * (w >> 4) + (w & 3); }
#define MFMA16(a, b, c) __builtin_amdgcn_mfma_f32_16x16x32_bf16((a), (b), (c), 0, 0, 0)

struct EpiProj {
    static constexpr bool PERM = true, AFTER_DRAIN = false; bf16* P; float* S; bf16* C;
    __device__ __forceinline__ void operator()(const f32x4 (&acc)[2][2][4][2], const pg8::Unit& u, int wr, int wc, int fr, int fq) const {
        const int row0 = u.pm * 256 + wr * 64 + fr;
        if (u.pn < 19) {
            const float sc = u.pn < 2 ? 0.125f * 1.44269504f : u.pn == 5 ? 0.125f : 1.f;     const int col0 = u.pn * 256 + wc * 32 + 8 * fq;
#pragma unroll
            for (int ai = 0; ai < 2; ++ai)
#pragma unroll
                for (int m = 0; m < 4; ++m) { bf16* rowp = P + (size_t)(row0 + ai * 128 + m * 16) * PLD + col0;
#pragma unroll
                    for (int bj = 0; bj < 2; ++bj) { const f32x4 v0 = acc[ai][bj][m][0] * sc, v1 = acc[ai][bj][m][1] * sc; u32x4 w;
                        w.x = pk2(v0[0], v0[1]); w.y = pk2(v0[2], v0[3]); w.z = pk2(v1[0], v1[1]); w.w = pk2(v1[2], v1[3]);
                        if (u.pn == 2) *(u32x4*)(C + ((size_t)(bj * 2 + (wc >> 1)) * M + (row0 + ai * 128 + m * 16)) * 64 + (wc & 1) * 32 + 8 * fq) = w;
                        else *(u32x4*)(rowp + bj * 128) = w; } }
        } else if (wc < 2) {
#pragma unroll
            for (int ai = 0; ai < 2; ++ai)
#pragma unroll
                for (int m = 0; m < 4; ++m) { float* rp = S + (size_t)(row0 + ai * 128 + m * 16) * 64 + wc * 32 + 8 * fq; *(f32x4*)rp = acc[ai][0][m][0]; *(f32x4*)(rp + 4) = acc[ai][0][m][1]; }
        }
    }
};
template <bool SECOND> struct EpiUp {
    static constexpr bool PERM = true, AFTER_DRAIN = false; const bf16* P; bf16* O; int ldo;
    __device__ __forceinline__ void operator()(const f32x4 (&acc)[2][2][4][2], const pg8::Unit& u, int wr, int wc, int fr, int fq) const {
        const int row0 = u.pm * 256 + wr * 64 + fr, col0 = u.pn * 256 + wc * 32 + 8 * fq;
#pragma unroll
        for (int ai = 0; ai < 2; ++ai) { u32x4 gwv[4][2], pwv[4][2];
#pragma unroll
            for (int m = 0; m < 4; ++m)
#pragma unroll
                for (int bj = 0; bj < 2; ++bj) { const size_t row = (size_t)(row0 + ai * 128 + m * 16); const int col = col0 + bj * 128;
                    gwv[m][bj] = *(const u32x4*)(P + row * PLD + PC_GM + (SECOND ? 1024 : 0) + col); if (SECOND) pwv[m][bj] = *(const u32x4*)(O + row * ldo + col); else pwv[m][bj] = (u32x4){0u, 0u, 0u, 0u}; }
#pragma unroll
            for (int m = 0; m < 4; ++m) { const size_t row = (size_t)(row0 + ai * 128 + m * 16);
#pragma unroll
                for (int bj = 0; bj < 2; ++bj) { const int col = col0 + bj * 128; const u32x4 gw = gwv[m][bj];
                    const f32x4 a0 = acc[ai][bj][m][0], a1 = acc[ai][bj][m][1];
                    float o[8] = { a0[0] * sigmoidf_(bflo(gw.x)), a0[1] * sigmoidf_(bfhi(gw.x)), a0[2] * sigmoidf_(bflo(gw.y)), a0[3] * sigmoidf_(bfhi(gw.y)),
                                   a1[0] * sigmoidf_(bflo(gw.z)), a1[1] * sigmoidf_(bfhi(gw.z)), a1[2] * sigmoidf_(bflo(gw.w)), a1[3] * sigmoidf_(bfhi(gw.w)) };
                    if (SECOND) { const u32x4 pw = pwv[m][bj];
                        o[0] += bflo(pw.x); o[1] += bfhi(pw.x); o[2] += bflo(pw.y); o[3] += bfhi(pw.y); o[4] += bflo(pw.z); o[5] += bfhi(pw.z); o[6] += bflo(pw.w); o[7] += bfhi(pw.w); }
                    u32x4 w; w.x = pk2(o[0], o[1]); w.y = pk2(o[2], o[3]); w.z = pk2(o[4], o[5]); w.w = pk2(o[6], o[7]); *(u32x4*)(O + row * ldo + col) = w; } } }
    }
};
struct UpOrder { pg8::StaticOrder so;
    __device__ bool next(int i, pg8::Unit& u) const { if (i > 1) return false; pg8::Unit b; if (!so.next(0, b)) return false; u.pm = b.pm + (i ? 64 : 0); u.pn = b.pn + (i ? 4 : 0); return true; }
    __device__ __forceinline__ void a_ready(const pg8::Unit&) const {}
    __device__ __forceinline__ void done(const pg8::Unit&) const {}
};
struct EpiUp2 { static constexpr bool PERM = true, AFTER_DRAIN = false; const bf16* P; bf16* O; int ldo;
    __device__ __forceinline__ void operator()(const f32x4 (&acc)[2][2][4][2], const pg8::Unit& u, int wr, int wc, int fr, int fq) const {
        if (u.pm < 64) { EpiUp<false> e{P, O, ldo}; e(acc, u, wr, wc, fr, fq); }
        else { EpiUp<true> e{P, O, ldo}; pg8::Unit v; v.pm = u.pm - 64; v.pn = u.pn - 4; e(acc, v, wr, wc, fr, fq); }
    }
};
template <bool WRITE_XB> struct EpiRes {
    static constexpr bool PERM = true, AFTER_DRAIN = true; const float* base; float* out; bf16* XB; float* rsq;
    __device__ __forceinline__ void fused(f32x4 (&acc)[2][2][4][2], const pg8::Unit& u, int wr, int wc, int fr, int fq, PG8_LAS unsigned char* lds, int wid, int lane) const {
        const int row0 = u.pm * 256 + wr * 64 + fr, col0 = u.pn * 256 + wc * 32 + 8 * fq;
        PG8_LAS float* rs = (PG8_LAS float*)lds;
#pragma unroll
        for (int ai = 0; ai < 2; ++ai) { f32x4 bb[4][2][2];
#pragma unroll
            for (int m = 0; m < 4; ++m)
#pragma unroll
                for (int bj = 0; bj < 2; ++bj) { const size_t off = (size_t)(row0 + ai * 128 + m * 16) * D + col0 + bj * 128; bb[m][bj][0] = *(const f32x4*)(base + off); bb[m][bj][1] = *(const f32x4*)(base + off + 4); }
#pragma unroll
            for (int m = 0; m < 4; ++m) { const size_t row = (size_t)(row0 + ai * 128 + m * 16); float ss = 0.f;
#pragma unroll
                for (int bj = 0; bj < 2; ++bj) { const size_t off = row * D + col0 + bj * 128;
                    const f32x4 v0 = bb[m][bj][0] + acc[ai][bj][m][0], v1 = bb[m][bj][1] + acc[ai][bj][m][1];
                    if (!WRITE_XB) { *(f32x4*)(out + off) = v0; *(f32x4*)(out + off + 4) = v1; }
                    ss += (v0[0] * v0[0] + v0[1] * v0[1]) + (v0[2] * v0[2] + v0[3] * v0[3]) + (v1[0] * v1[0] + v1[1] * v1[1]) + (v1[2] * v1[2] + v1[3] * v1[3]);
                    if (WRITE_XB) { u32x4 w; w.x = pk2(v0[0], v0[1]); w.y = pk2(v0[2], v0[3]); w.z = pk2(v1[0], v1[1]); w.w = pk2(v1[2], v1[3]); *(u32x4*)(XB + off) = w; } }
                ss += __shfl_xor(ss, 16); ss += __shfl_xor(ss, 32);
                if (fq == 0) rs[(ai * 128 + wr * 64 + m * 16 + fr) * 4 + wc] = ss; } }
        __syncthreads();
        const int t = wid * 64 + lane;
        if (t < 256) rsq[(size_t)u.pn * M + u.pm * 256 + t] = (rs[t * 4] + rs[t * 4 + 1]) + (rs[t * 4 + 2] + rs[t * 4 + 3]);
        __syncthreads();
    }
};
struct EpiFinal {
    static constexpr bool PERM = true, AFTER_DRAIN = true; const bf16* base; float* out; float* rsq; unsigned* cnt; const float* gain;
    __device__ __forceinline__ void fused(f32x4 (&acc)[2][2][4][2], const pg8::Unit& u, int wr, int wc, int fr, int fq, PG8_LAS unsigned char* lds, int wid, int lane) const {
        const int row0 = u.pm * 256 + wr * 64 + fr, col0 = u.pn * 256 + wc * 32 + 8 * fq;
        PG8_LAS float* rs = (PG8_LAS float*)lds;
        u32x4 bw[2][4][2];
#pragma unroll
        for (int ai = 0; ai < 2; ++ai)
#pragma unroll
            for (int m = 0; m < 4; ++m)
#pragma unroll
                for (int bj = 0; bj < 2; ++bj) bw[ai][m][bj] = *(const u32x4*)(base + (size_t)(row0 + ai * 128 + m * 16) * D + col0 + bj * 128);
#pragma unroll
        for (int ai = 0; ai < 2; ++ai)
#pragma unroll
            for (int m = 0; m < 4; ++m) { float ss = 0.f;
#pragma unroll
                for (int bj = 0; bj < 2; ++bj) { const u32x4 w = bw[ai][m][bj]; const f32x4 b0 = {bflo(w.x), bfhi(w.x), bflo(w.y), bfhi(w.y)}, b1 = {bflo(w.z), bfhi(w.z), bflo(w.w), bfhi(w.w)};
                    const f32x4 v0 = b0 + acc[ai][bj][m][0], v1 = b1 + acc[ai][bj][m][1]; acc[ai][bj][m][0] = v0; acc[ai][bj][m][1] = v1;
                    ss += (v0[0] * v0[0] + v0[1] * v0[1]) + (v0[2] * v0[2] + v0[3] * v0[3]) + (v1[0] * v1[0] + v1[1] * v1[1]) + (v1[2] * v1[2] + v1[3] * v1[3]); }
                ss += __shfl_xor(ss, 16); ss += __shfl_xor(ss, 32);
                if (fq == 0) rs[(ai * 128 + wr * 64 + m * 16 + fr) * 4 + wc] = ss; }
        __syncthreads();
        const int t = wid * 64 + lane;
        if (t < 256) rsq[(size_t)u.pn * M + u.pm * 256 + t] = (rs[t * 4] + rs[t * 4 + 1]) + (rs[t * 4 + 2] + rs[t * 4 + 3]);
        asm volatile("s_waitcnt vmcnt(0)" ::: "memory");
        __syncthreads();
        if (t == 0) { __builtin_amdgcn_fence(__ATOMIC_RELEASE, "agent"); asm volatile("s_waitcnt vmcnt(0)" ::: "memory");
            unsigned* c = cnt + 64 * u.pm; __hip_atomic_fetch_add(c, 1u, __ATOMIC_RELAXED, __HIP_MEMORY_SCOPE_AGENT);
            while (__hip_atomic_load(c, __ATOMIC_RELAXED, __HIP_MEMORY_SCOPE_AGENT) < 4u) __builtin_amdgcn_s_sleep(2);
            __builtin_amdgcn_fence(__ATOMIC_ACQUIRE, "agent"); asm volatile("s_waitcnt vmcnt(0)" ::: "memory"); }
        __syncthreads();
        PG8_LAS float* rstd = (PG8_LAS float*)(lds + 4096);
        if (t < 256) { const size_t row = (size_t)u.pm * 256 + t; rstd[t] = rsqrtf(((rsq[row] + rsq[(size_t)M + row]) + (rsq[(size_t)2 * M + row] + rsq[(size_t)3 * M + row])) * (1.f / D) + EPS); }
        __syncthreads();
#pragma unroll
        for (int ai = 0; ai < 2; ++ai)
#pragma unroll
            for (int m = 0; m < 4; ++m) { const int rl = ai * 128 + wr * 64 + m * 16 + fr; const float r = rstd[rl]; const size_t row = (size_t)u.pm * 256 + rl;
#pragma unroll
                for (int bj = 0; bj < 2; ++bj) { const size_t off = row * D + col0 + bj * 128; const f32x4 g0 = *(const f32x4*)(gain + col0 + bj * 128), g1 = *(const f32x4*)(gain + col0 + bj * 128 + 4); *(f32x4*)(out + off) = acc[ai][bj][m][0] * r * g0; *(f32x4*)(out + off + 4) = acc[ai][bj][m][1] * r * g1; } }
        __syncthreads();
    }
};
struct EpiFfn {
    static constexpr bool PERM = true, AFTER_DRAIN = false; bf16* H; const float* rsq;
    __device__ __forceinline__ void operator()(const f32x4 (&acc)[2][2][4][2], const pg8::Unit& u, int wr, int wc, int fr, int fq) const {
        const int row0 = u.pm * 256 + wr * 64 + fr, f0 = u.pn * 128 + wc * 16 + 4 * fq;
        float rq[2][4][4];
#pragma unroll
        for (int ai = 0; ai < 2; ++ai)
#pragma unroll
            for (int m = 0; m < 4; ++m) { const size_t row = (size_t)(row0 + ai * 128 + m * 16);
#pragma unroll
                for (int p = 0; p < 4; ++p) rq[ai][m][p] = rsq[(size_t)p * M + row]; }
#pragma unroll
        for (int ai = 0; ai < 2; ++ai)
#pragma unroll
            for (int m = 0; m < 4; ++m) { const size_t row = (size_t)(row0 + ai * 128 + m * 16);
                const float rstd = rsqrtf(((rq[ai][m][0] + rq[ai][m][1]) + (rq[ai][m][2] + rq[ai][m][3])) * (1.f / D) + EPS);
#pragma unroll
                for (int bj = 0; bj < 2; ++bj) { const f32x4 gv = acc[ai][bj][m][0] * rstd, uv = acc[ai][bj][m][1] * rstd;
                    u32x2 w; w.x = pk2(siluf_(gv[0]) * uv[0], siluf_(gv[1]) * uv[1]); w.y = pk2(siluf_(gv[2]) * uv[2], siluf_(gv[3]) * uv[3]);
                    *(u32x2*)(H + row * DFF + f0 + bj * 64) = w; } }
    }
};

template <int MODE> __device__ __forceinline__ void tr_item(const float* W0, const float* W1, int K, int Nsrc, bf16* WT, int item, int nblk, const float* kscale, LAS float* scr, int lane) {
    const int kb = item / nblk, nb = item % nblk, k0 = 64 * kb, n0 = 32 * nb, nn = n0 + (lane & 31);
    const float* src = W0; int sc = nn;
    if (MODE == 1) sc = nn < 1280 ? nn : nn < 2304 ? nn + 24 : nn < 4864 ? nn + 40 : nn < 4888 ? nn - 4864 + 1280 : nn < 4904 ? nn - 4888 + 2328 : -1;
    if (MODE == 2) { const int q = nn >> 3, e = nn & 7; src = (e < 4) ? W0 : W1; sc = 4 * q + (e & 3); }
    float tv[32];
#pragma unroll
    for (int i = 0; i < 32; ++i) { const int kk = 2 * i + (lane >> 5); tv[i] = sc >= 0 ? src[(size_t)(k0 + kk) * Nsrc + sc] : 0.f; }
#pragma unroll
    for (int i = 0; i < 32; ++i) { const int kk = 2 * i + (lane >> 5); float v = tv[i]; if (kscale) v *= kscale[k0 + kk]; scr[kk * 33 + (lane & 31)] = v; }
    LDS_WAIT();
    const int c = lane & 7;
#pragma unroll
    for (int j = 0; j < 4; ++j) { const int n = (lane >> 3) + 8 * j; const LAS float* s = scr + (8 * c) * 33 + n;
        u32x4 o; o.x = pk2(s[0 * 33], s[1 * 33]); o.y = pk2(s[2 * 33], s[3 * 33]); o.z = pk2(s[4 * 33], s[5 * 33]); o.w = pk2(s[6 * 33], s[7 * 33]);
        *(u32x4*)(WT + (size_t)(n0 + n) * K + k0 + 8 * c) = o; }
    LDS_WAIT();
}
__device__ __forceinline__ void rms_row_to_bf16(const float* xrow, const float* gain, bf16* orow, int lane) {
    const f32x4* xr = (const f32x4*)xrow + lane; const f32x4* gr = (const f32x4*)gain + lane;
    f32x4 v[4]; float s = 0.f;
#pragma unroll
    for (int j = 0; j < 4; ++j) { v[j] = xr[64 * j]; s += (v[j].x * v[j].x + v[j].y * v[j].y) + (v[j].z * v[j].z + v[j].w * v[j].w); }
    const float rstd = rsqrtf(wave_sum(s) * (1.f / D) + EPS);
    u32x2* o8 = (u32x2*)orow + lane;
#pragma unroll
    for (int j = 0; j < 4; ++j) { const f32x4 g = gr[64 * j]; u32x2 w; w.x = pk2(v[j].x * rstd * g.x, v[j].y * rstd * g.y); w.y = pk2(v[j].z * rstd * g.z, v[j].w * rstd * g.w); o8[64 * j] = w; }
}
struct Args { const float* in[20]; float* out; unsigned char* ws; };

__device__ __forceinline__ void p0_prologue(const Args& a, LAS unsigned char* lds, int wave, int lane) {
    unsigned char* ws = a.ws;
    LAS float* scr = (LAS float*)(lds + wave * 16384);
    const int gw = blockIdx.x * NWAVES + wave, NGW = gridDim.x * NWAVES;
    constexpr int I_IN = 16 * (NIN / 32), I_GU = 16 * (NGU / 32), I_DN = 44 * 32, I_OUT = 16 * 32, I_UP = 8 * 32, I_C1 = 32 * 4, I_C2 = 2 * 2;
    constexpr int NITEMS = I_IN + I_GU + I_DN + I_OUT + 2 * I_UP + 2 * I_C1 + 2 * I_C2;
    for (int it = gw; it < NITEMS; it += NGW) {
        int r = it;
        if (r < I_IN) { tr_item<1>(a.in[2], nullptr, 1024, 4904, (bf16*)(ws + WS_WIN), r, NIN / 32, nullptr, scr, lane); continue; } r -= I_IN;
        if (r < I_GU) { tr_item<2>(a.in[16], a.in[17], 1024, DFF, (bf16*)(ws + WS_WGU), r, NGU / 32, a.in[15], scr, lane); continue; } r -= I_GU;
        if (r < I_DN) { tr_item<0>(a.in[18], nullptr, DFF, 1024, (bf16*)(ws + WS_WDN), r, 32, nullptr, scr, lane); continue; } r -= I_DN;
        if (r < I_OUT) { tr_item<0>(a.in[14], nullptr, 1024, 1024, (bf16*)(ws + WS_WOUT), r, 32, nullptr, scr, lane); continue; } r -= I_OUT;
        if (r < I_UP) { tr_item<0>(a.in[12], nullptr, 512, 1024, (bf16*)(ws + WS_WUPA), r, 32, nullptr, scr, lane); continue; } r -= I_UP;
        if (r < I_UP) { tr_item<0>(a.in[13], nullptr, 512, 1024, (bf16*)(ws + WS_WUPB), r, 32, nullptr, scr, lane); continue; } r -= I_UP;
        if (r < I_C1) { tr_item<0>(a.in[5], nullptr, 2048, 128, (bf16*)(ws + WS_CW1K), r, 4, nullptr, scr, lane); continue; } r -= I_C1;
        if (r < I_C1) { tr_item<0>(a.in[7], nullptr, 2048, 128, (bf16*)(ws + WS_CW1V), r, 4, nullptr, scr, lane); continue; } r -= I_C1;
        if (r < I_C2) { tr_item<0>(a.in[6], nullptr, 128, 64, (bf16*)(ws + WS_CW2K), r, 2, nullptr, scr, lane); continue; } r -= I_C2;
        tr_item<0>(a.in[8], nullptr, 128, 64, (bf16*)(ws + WS_CW2V), r, 2, nullptr, scr, lane);
    }
    for (int m0 = gw; m0 < M; m0 += 4 * NGW) {
        f32x4 v[4][4]; float ss[4];
#pragma unroll
        for (int r = 0; r < 4; ++r) { const int m = m0 + r * NGW < M ? m0 + r * NGW : m0; const f32x4* xr = (const f32x4*)(a.in[0] + (size_t)m * D) + lane;
#pragma unroll
            for (int j = 0; j < 4; ++j) v[r][j] = xr[64 * j]; }
#pragma unroll
        for (int r = 0; r < 4; ++r) { float s_ = 0.f;
#pragma unroll
            for (int j = 0; j < 4; ++j) s_ += (v[r][j].x * v[r][j].x + v[r][j].y * v[r][j].y) + (v[r][j].z * v[r][j].z + v[r][j].w * v[r][j].w);
            ss[r] = rsqrtf(wave_sum(s_) * (1.f / D) + EPS); }
#pragma unroll
        for (int r = 0; r < 4; ++r) { const int m = m0 + r * NGW; if (m < M) { u32x2* o8 = (u32x2*)((bf16*)(ws + WS_XN) + (size_t)m * D) + lane; const f32x4* gr = (const f32x4*)a.in[1] + lane;
#pragma unroll
            for (int j = 0; j < 4; ++j) { const f32x4 g = gr[64 * j]; u32x2 w; w.x = pk2(v[r][j].x * ss[r] * g.x, v[r][j].y * ss[r] * g.y); w.y = pk2(v[r][j].z * ss[r] * g.z, v[r][j].w * ss[r] * g.w); o8[64 * j] = w; } } } }
    for (int e = blockIdx.x * NTHR + threadIdx.x; e < T * 8; e += gridDim.x * NTHR) {
        const int t = e >> 3, i = e & 7;
        const float f = i == 0 ? 1.0f : i == 1 ? 0.19392274f : i == 2 ? 0.03760603f : i == 3 ? 0.0072926646f : i == 4 ? 0.0014142136f : i == 5 ? 0.0002742482f : i == 6 ? 5.3182957e-05f : 1.0313385e-05f;
        const float ang = (float)t * f;
        const float p = ang * 0.15915494f; const float er = fmaf(ang, 0.15915494f, -p) + ang * 6.4206382e-09f; const float fr = (p - rintf(p)) + er;
        ((float*)(ws + WS_ROPE))[e] = __builtin_amdgcn_cosf(fr); ((float*)(ws + WS_ROPE))[T * 8 + e] = __builtin_amdgcn_sinf(fr);
    }
    if (gw >= NGW - 32) { const int g2 = gw - (NGW - 32), kv = g2 >> 4, q = g2 & 15; const float* pe = a.in[3 + kv] + 128 * q; const float* w1 = a.in[kv ? 7 : 5] + (size_t)(128 * q) * 128;
        float s0 = 0.f, s1 = 0.f;
#pragma unroll 32
        for (int k = 0; k < 128; ++k) { const float p = pe[k]; s0 += p * w1[k * 128 + lane]; s1 += p * w1[k * 128 + 64 + lane]; }
        float* b1 = (float*)(ws + WS_CTL) + 2048 + (kv * 16 + q) * 128; b1[lane] = s0; b1[64 + lane] = s1; }
}

__device__ __forceinline__ u32x4 rope_unit(u32x4 x, const u32x4 y, const float* RC, const float* RS, int t, float sg) {
    const f32x4 c0 = *(const f32x4*)(RC + t * 8), c1 = *(const f32x4*)(RC + t * 8 + 4), s0 = *(const f32x4*)(RS + t * 8), s1 = *(const f32x4*)(RS + t * 8 + 4);
    x.x = pk2(bflo(x.x) * c0[0] + sg * bflo(y.x) * s0[0], bfhi(x.x) * c0[1] + sg * bfhi(y.x) * s0[1]); x.y = pk2(bflo(x.y) * c0[2] + sg * bflo(y.y) * s0[2], bfhi(x.y) * c0[3] + sg * bfhi(y.y) * s0[3]);
    x.z = pk2(bflo(x.z) * c1[0] + sg * bflo(y.z) * s1[0], bfhi(x.z) * c1[1] + sg * bfhi(y.z) * s1[1]); x.w = pk2(bflo(x.w) * c1[2] + sg * bflo(y.w) * s1[2], bfhi(x.w) * c1[3] + sg * bfhi(y.w) * s1[3]);
    return x;
}
__device__ __forceinline__ void rope_item(int item, unsigned char* ws, int lane) {
    const bf16* PROJ = (const bf16*)(ws + WS_PROJ); const float* RC = (const float*)(ws + WS_ROPE); const float* RS = RC + T * 8; bf16* QROT = (bf16*)(ws + WS_QROT); bf16* KROT = (bf16*)(ws + WS_KROT);
    const size_t row0 = (size_t)item * 8; const int tq0 = (int)(row0 & (T - 1));
    { const int sub = lane & 7; const float sg = sub == 0 ? -1.f : 1.f; u32x4 x[8], y[8];
#pragma unroll
      for (int tt = 0; tt < 8; ++tt) { const bf16* src = PROJ + (row0 + tt) * PLD + PC_QN; x[tt] = *(const u32x4*)(src + 8 * lane); y[tt] = *(const u32x4*)(src + 8 * (lane ^ 1)); }
#pragma unroll
      for (int tt = 0; tt < 8; ++tt) { if (sub < 2) { x[tt] = rope_unit(x[tt], y[tt], RC, RS, tq0 + tt, sg); *(u32x4*)(QROT + (row0 + tt) * 128 + (lane >> 3) * 16 + 8 * sub) = x[tt]; } } }
    { u32x4 x[4], y[4];
#pragma unroll
      for (int it = 0; it < 4; ++it) { const int id = it * 64 + lane, tt = id >> 5, w = id & 31, tensor = w >> 4, g = (w >> 3) & 1, u8 = w & 7;
          const bf16* p = PROJ + (row0 + tt) * PLD + PC_KV + (2 + 2 * tensor) * 128 + g * 64; x[it] = *(const u32x4*)(p + 8 * u8); y[it] = *(const u32x4*)(p + 8 * (u8 ^ 1)); }
#pragma unroll
      for (int it = 0; it < 4; ++it) { const int id = it * 64 + lane, tt = id >> 5, w = id & 31, u8 = w & 7;
          if (u8 < 2) x[it] = rope_unit(x[it], y[it], RC, RS, tq0 + tt, u8 == 0 ? -1.f : 1.f);
          *(u32x4*)(KROT + ((size_t)(w >> 3) * M + row0 + tt) * 64 + 8 * u8) = x[it]; } }
}
__device__ __forceinline__ void p2a_item(int item, unsigned char* ws, LAS unsigned char* wl, int lane) {
    const bf16* PROJ = (const bf16*)(ws + WS_PROJ);
    const int part = item & 1, tile = item >> 1, b = tile >> 7, t0 = (tile & 127) * 64;
    int csrc; bf16* dst; int nc, cdst;
    if (part == 0) { csrc = PC_KV + 3 * 128; dst = (bf16*)(ws + WS_VTS); nc = 128; cdst = 0; }
    else { csrc = PC_KV + 5 * 128; dst = (bf16*)(ws + WS_VTW); nc = 128; cdst = 0; }
    LAS unsigned char* tb = wl;
#pragma unroll
    for (int it = 0; it < 16; ++it) { const int id = it * 64 + lane, tt = id >> 4, uu = id & 15;
        const u32x4 v = *(const u32x4*)(PROJ + ((size_t)b * T + t0 + tt) * PLD + csrc + 8 * uu);
        *(LAS u32x2*)(tb + tt * 264 + uu * 16) = (u32x2){v.x, v.y}; *(LAS u32x2*)(tb + tt * 264 + uu * 16 + 8) = (u32x2){v.z, v.w}; }
    LDS_WAIT();
#pragma unroll
    for (int pass = 0; pass < 2; ++pass) { const int c = pass * 64 + lane;
        bf16* dp = dst + ((((size_t)(b * 2 + pass)) * 128 + (t0 >> 6)) * 64 + lane) * 64;
#pragma unroll
        for (int hb = 0; hb < 2; ++hb) { unsigned wv[16];
#pragma unroll
            for (int p2 = 0; p2 < 16; ++p2) { unsigned lo, hi;
                { const int p = 2 * p2, fqq = p >> 3, e = p & 7, key = 32 * hb + (e < 4 ? 4 * fqq + e : 16 + 4 * fqq + (e - 4)); lo = *(const LAS unsigned short*)(tb + key * 264 + c * 2); }
                { const int p = 2 * p2 + 1, fqq = p >> 3, e = p & 7, key = 32 * hb + (e < 4 ? 4 * fqq + e : 16 + 4 * fqq + (e - 4)); hi = *(const LAS unsigned short*)(tb + key * 264 + c * 2); }
                wv[p2] = lo | (hi << 16); }
#pragma unroll
            for (int q = 0; q < 4; ++q) *(u32x4*)(dp + 32 * hb + 8 * q) = (u32x4){wv[4 * q], wv[4 * q + 1], wv[4 * q + 2], wv[4 * q + 3]}; } }
    LDS_WAIT();
}

__device__ __forceinline__ void compress_item(int item, int sub, unsigned char* ws, LAS unsigned char* lds, int wave, int lane) {
    const int kv = item >> 5, g = (item >> 4) & 1, rt = item & 15, fr = lane & 15, fq = lane >> 4;
    const int rbase = rt * 64 + sub * 16;
    const bf16* Ap; { const int rowidx = rbase + fr, b = rowidx >> 9, ii = rowidx & 511; int tok0 = b * T + 16 * ii; if (tok0 > M - 32) tok0 = M - 32;
        Ap = (const bf16*)(ws + WS_CSRC) + ((size_t)(kv * 2 + g) * M + tok0) * 64 + 8 * fq; }
    const bf16* Bp = (const bf16*)(ws + (kv ? WS_CW1V : WS_CW1K)) + (size_t)(16 * wave + fr) * 2048 + 8 * fq;
    f32x4 acc = {0.f, 0.f, 0.f, 0.f};
    for (int kb = 0; kb < 64; kb += 16) {
        bf16x8 bv[16], av[16];
#pragma unroll
        for (int k2 = 0; k2 < 16; ++k2) { bv[k2] = *(const bf16x8*)(Bp + 32 * (kb + k2)); av[k2] = *(const bf16x8*)(Ap + 32 * (kb + k2)); }
#pragma unroll
        for (int k2 = 0; k2 < 16; ++k2) acc = MFMA16(av[k2], bv[k2], acc); }
    float bias = 0.f;
#pragma unroll
    for (int q = 0; q < 16; ++q) bias += ((const float*)(ws + WS_CTL))[2048 + (kv * 16 + q) * 128 + 16 * wave + fr];
    LAS bf16* H1 = (LAS bf16*)lds;
#pragma unroll
    for (int i = 0; i < 4; ++i) H1[(4 * fq + i) * 136 + 16 * wave + fr] = f2bf(siluf_(acc[i] + bias));
    __syncthreads();
    if (wave < 4) { const int ct = wave; const bf16* W2 = (const bf16*)(ws + (kv ? WS_CW2V : WS_CW2K)) + (size_t)(16 * ct + fr) * 128 + 8 * fq; f32x4 a2 = {0.f, 0.f, 0.f, 0.f};
#pragma unroll
        for (int ks = 0; ks < 4; ++ks) { const bf16x8 av = *(const LAS bf16x8*)(H1 + fr * 136 + 32 * ks + 8 * fq); const bf16x8 bv = *(const bf16x8*)(W2 + 32 * ks); a2 = MFMA16(av, bv, a2); }
        const int c = 16 * ct + fr;
        float vv[4];
#pragma unroll
        for (int i = 0; i < 4; ++i) { const int i2 = (rbase + 4 * fq + i) & 511; vv[i] = (i2 == 511) ? 0.f : a2[i]; }
        const int r0 = rbase + 4 * fq, b2 = r0 >> 9, i20 = r0 & 511;
        if (kv == 0) {
#pragma unroll
            for (int i = 0; i < 4; ++i) { const float nb = __shfl_xor(vv[i], 1); if (!(fr & 1)) *(unsigned*)((bf16*)(ws + WS_KCMP) + ((size_t)(b2 * 2 + g) * 512 + i20 + i) * 64 + c) = pk2(vv[i], nb); }
        } else { u32x2 w; w.x = pk2(vv[0], vv[1]); w.y = pk2(vv[2], vv[3]);
            *(u32x2*)((bf16*)(ws + WS_VCMPT) + ((size_t)(b2 * 2 + g) * 64 + c) * 512 + (i20 & ~31) + perm32k(i20 & 31)) = w; } }
    __syncthreads();
}

__device__ __forceinline__ void gla_cum(LAS float* cum, LAS float* tot, const float* SM, const float* w2, const float* gb, int b, int h, int c, int tid) {
    const int dk = tid & 63, tg = __builtin_amdgcn_readfirstlane(tid >> 6);
    float wcol[16];
#pragma unroll
    for (int r = 0; r < 16; ++r) wcol[r] = w2[r * 256 + h * 64 + dk];
    const float bias = gb[h * 64 + dk]; float run = 0.f, vals[8];
    LAS float* lrs = tot + 7680;
    if (tid < 256) *(LAS f32x4*)(lrs + (tid >> 2) * 16 + 4 * (tid & 3)) = *(const f32x4*)(SM + ((size_t)b * T + 64 * c + (tid >> 2)) * 64 + 24 + 4 * (tid & 3));
    __syncthreads();
#pragma unroll
    for (int j = 0; j < 8; ++j) { const LAS float* lr = lrs + (8 * tg + j) * 16; float z = bias;
#pragma unroll
        for (int r4 = 0; r4 < 4; ++r4) { const f32x4 v = *(const LAS f32x4*)(lr + 4 * r4); z += v[0] * wcol[4 * r4] + v[1] * wcol[4 * r4 + 1] + v[2] * wcol[4 * r4 + 2] + v[3] * wcol[4 * r4 + 3]; }
        const float la = (fminf(z, 0.f) - __logf(1.f + __expf(-fabsf(z)))) * (1.f / 16.f); run += la; vals[j] = run; }
    tot[tg * 64 + dk] = run;
    __syncthreads();
    float pre = 0.f;
#pragma unroll
    for (int g2 = 0; g2 < 7; ++g2) pre += (g2 < tg) ? tot[g2 * 64 + dk] : 0.f;
#pragma unroll
    for (int j = 0; j < 8; ++j) cum[(8 * tg + j) * 65 + dk] = vals[j] + pre;
    __syncthreads();
}
constexpr int GL_CUM = 0, GL_TOT = 16640, GL_KT = 18688, GL_VT = 27904, GL_SSQ = 46336;
__device__ __forceinline__ void gla_local_item(int item, const Args& a, LAS unsigned char* lds, int tid, int wave, int lane) {
    unsigned char* ws = a.ws; const bf16* PROJ = (const bf16*)(ws + WS_PROJ);
    const int b = item >> 9, h = (item >> 7) & 3, c = item & 127, fr = lane & 15, fq = lane >> 4;
    LAS float* cum = (LAS float*)(lds + GL_CUM); LAS float* tot = (LAS float*)(lds + GL_TOT); LAS bf16* KT = (LAS bf16*)(lds + GL_KT); LAS bf16* VT = (LAS bf16*)(lds + GL_VT);
    gla_cum(cum, tot, (const float*)(ws + WS_SMALL), a.in[9], a.in[10], b, h, c, tid);
    { const int s = tid >> 3, u = tid & 7; const size_t row = (size_t)b * T + 64 * c + s; const bf16x8 kr = *(const bf16x8*)(PROJ + row * PLD + PC_KG + h * 64 + 8 * u);
      const int pos = (s & 32) + perm32k(s & 31);
#pragma unroll
      for (int e = 0; e < 8; ++e) { const int dk = 8 * u + e; KT[dk * 72 + pos] = f2bf(bf2f(kr[e]) * __expf(cum[63 * 65 + dk] - cum[s * 65 + dk])); } }
#pragma unroll
    for (int it = 0; it < 2; ++it) { const int id = tid + 512 * it, s = id >> 4, u = id & 15; const size_t row = (size_t)b * T + 64 * c + s;
        const bf16x8 vr = *(const bf16x8*)(PROJ + row * PLD + PC_VG + h * 128 + 8 * u); const int pos = (s & 32) + perm32k(s & 31);
#pragma unroll
        for (int e = 0; e < 8; ++e) VT[(8 * u + e) * 72 + pos] = (bf16)vr[e]; }
    if (tid < 64) ((float*)(ws + WS_DEC))[(size_t)item * 64 + tid] = __expf(cum[63 * 65 + tid]);
    __syncthreads();
    bf16* LS = (bf16*)((unsigned char*)a.out + DO_L);
#pragma unroll
    for (int dkt = 0; dkt < 4; ++dkt) { f32x4 acc = {0.f, 0.f, 0.f, 0.f};
#pragma unroll
        for (int ks = 0; ks < 2; ++ks) { const bf16x8 av = *(const LAS bf16x8*)(VT + (16 * wave + fr) * 72 + 32 * ks + 8 * fq); const bf16x8 bv = *(const LAS bf16x8*)(KT + (16 * dkt + fr) * 72 + 32 * ks + 8 * fq); acc = MFMA16(av, bv, acc); }
#pragma unroll
        for (int i = 0; i < 4; ++i) { const float nb = __shfl_xor(acc[i], 1); if (!(fr & 1)) *(unsigned*)(LS + ((size_t)item * 128 + 16 * wave + 4 * fq + i) * 64 + 16 * dkt + fr) = pk2(acc[i], nb); } }
    __syncthreads();
}
__device__ __forceinline__ void gla_out_item(int item, const Args& a, LAS unsigned char* lds, int tid, int wave, int lane) {
    unsigned char* ws = a.ws; const bf16* PROJ = (const bf16*)(ws + WS_PROJ);
    const int b = item >> 9, h = (item >> 7) & 3, c = item & 127, fr = lane & 15, fq = lane >> 4, tt = wave & 3, hh = wave >> 2;
    LAS bf16* VT = (LAS bf16*)(lds + GL_VT);
    LAS float* cum = (LAS float*)(lds + GL_CUM); LAS float* tot = (LAS float*)(lds + GL_TOT); LAS float* ssqb = (LAS float*)(lds + GL_SSQ);
    gla_cum(cum, tot, (const float*)(ws + WS_SMALL), a.in[9], a.in[10], b, h, c, tid);
#pragma unroll
    for (int it = 0; it < 2; ++it) { const int id = tid + 512 * it, s = id >> 4, u = id & 15; const size_t row = (size_t)b * T + 64 * c + s;
        const bf16x8 vr = *(const bf16x8*)(PROJ + row * PLD + PC_VG + h * 128 + 8 * u); const int pos = (s & 32) + perm32k(s & 31);
#pragma unroll
        for (int e = 0; e < 8; ++e) VT[(8 * u + e) * 72 + pos] = (bf16)vr[e]; }
    __syncthreads();
    const int tokq = 16 * tt + fr; const size_t rowq = (size_t)b * T + 64 * c + tokq;
    bf16x8 qf[2];
#pragma unroll
    for (int ks = 0; ks < 2; ++ks) { const bf16x8 raw = *(const bf16x8*)(PROJ + rowq * PLD + PC_QG + h * 64 + 32 * ks + 8 * fq);
#pragma unroll
        for (int e = 0; e < 8; ++e) qf[ks][e] = (short)f2bf(bf2f(raw[e]) * __expf(cum[tokq * 65 + 32 * ks + 8 * fq + e])); }
    f32x4 at[4];
#pragma unroll
    for (int st = 0; st < 4; ++st) { at[st] = (f32x4){0.f, 0.f, 0.f, 0.f};
        if (st <= tt) { const int s = 16 * st + fr; const size_t rows = (size_t)b * T + 64 * c + s; bf16x8 kf[2];
#pragma unroll
            for (int ks = 0; ks < 2; ++ks) { const bf16x8 raw = *(const bf16x8*)(PROJ + rows * PLD + PC_KG + h * 64 + 32 * ks + 8 * fq);
#pragma unroll
                for (int e = 0; e < 8; ++e) kf[ks][e] = (short)f2bf(bf2f(raw[e]) * __expf(-cum[s * 65 + 32 * ks + 8 * fq + e])); }
            at[st] = MFMA16(kf[0], qf[0], at[st]); at[st] = MFMA16(kf[1], qf[1], at[st]);
            if (st == tt) {
#pragma unroll
                for (int i = 0; i < 4; ++i) if (4 * fq + i > fr) at[st][i] = 0.f; } } }
    bf16x8 pf[2];
#pragma unroll
    for (int k2 = 0; k2 < 2; ++k2) { const u32x4 w = {pk2(at[2 * k2][0], at[2 * k2][1]), pk2(at[2 * k2][2], at[2 * k2][3]), pk2(at[2 * k2 + 1][0], at[2 * k2 + 1][1]), pk2(at[2 * k2 + 1][2], at[2 * k2 + 1][3])}; pf[k2] = __builtin_bit_cast(bf16x8, w); }
    const bf16* LS = (const bf16*)((const unsigned char*)a.out + DO_S);
    f32x4 o[4]; float ssq = 0.f;
#pragma unroll
    for (int j = 0; j < 4; ++j) { const int dv0 = 64 * hh + 16 * j; f32x4 acc = {0.f, 0.f, 0.f, 0.f};
#pragma unroll
        for (int ks = 0; ks < 2; ++ks) { const bf16x8 sf = *(const bf16x8*)(LS + ((size_t)item * 128 + dv0 + fr) * 64 + 32 * ks + 8 * fq); acc = MFMA16(sf, qf[ks], acc); }
#pragma unroll
        for (int k2 = 0; k2 < 2; ++k2) { const bf16x8 vf = *(const LAS bf16x8*)(VT + (dv0 + fr) * 72 + 32 * k2 + 8 * fq); acc = MFMA16(vf, pf[k2], acc); }
        o[j] = acc; ssq += (acc[0] * acc[0] + acc[1] * acc[1]) + (acc[2] * acc[2] + acc[3] * acc[3]); }
    ssq += __shfl_xor(ssq, 16); ssq += __shfl_xor(ssq, 32);
    if (fq == 0) ssqb[hh * 64 + tokq] = ssq;
    __syncthreads();
    const float rstd = rsqrtf((ssqb[tokq] + ssqb[64 + tokq]) * (1.f / 128.f) + EPS);
#pragma unroll
    for (int j = 0; j < 4; ++j) { const int dvb = 64 * hh + 16 * j + 4 * fq; const f32x4 gn = *(const f32x4*)(a.in[11] + dvb); const bf16* rp = PROJ + rowq * PLD + PC_RG + h * 128 + dvb; bf16* op = (bf16*)((unsigned char*)a.out + DO_OB) + rowq * 512 + h * 128 + dvb;
        const u32x2 rw = *(const u32x2*)rp; const float r0 = bflo(rw.x), r1 = bfhi(rw.x), r2 = bflo(rw.y), r3 = bfhi(rw.y);
        u32x2 w; w.x = pk2(o[j][0] * rstd * gn[0] * siluf_(r0), o[j][1] * rstd * gn[1] * siluf_(r1)); w.y = pk2(o[j][2] * rstd * gn[2] * siluf_(r2), o[j][3] * rstd * gn[3] * siluf_(r3));
        *(u32x2*)op = w; }
    __syncthreads();
}

constexpr int GL2_STRIDE = 53248;
__device__ __forceinline__ void gla_cum2(LAS float* cum, LAS float* tot, LAS float* lrs, const float* SM, const float* w2, const float* gb, int b, int h, int c, int th) {
    const int dk = th & 63, tg = __builtin_amdgcn_readfirstlane(th >> 6);
    float wcol[16];
#pragma unroll
    for (int r = 0; r < 16; ++r) wcol[r] = w2[r * 256 + h * 64 + dk];
    const float bias = gb[h * 64 + dk]; float run = 0.f, vals[16];
    *(LAS f32x4*)(lrs + (th >> 2) * 16 + 4 * (th & 3)) = *(const f32x4*)(SM + ((size_t)b * T + 64 * c + (th >> 2)) * 64 + 24 + 4 * (th & 3));
    __syncthreads();
#pragma unroll
    for (int j = 0; j < 16; ++j) { const LAS float* lr = lrs + (16 * tg + j) * 16; float z = bias;
#pragma unroll
        for (int r4 = 0; r4 < 4; ++r4) { const f32x4 v = *(const LAS f32x4*)(lr + 4 * r4); z += v[0] * wcol[4 * r4] + v[1] * wcol[4 * r4 + 1] + v[2] * wcol[4 * r4 + 2] + v[3] * wcol[4 * r4 + 3]; }
        const float la = (fminf(z, 0.f) - __logf(1.f + __expf(-fabsf(z)))) * (1.f / 16.f); run += la; vals[j] = run; }
    tot[tg * 64 + dk] = run;
    __syncthreads();
    float pre = 0.f;
#pragma unroll
    for (int g2 = 0; g2 < 3; ++g2) pre += (g2 < tg) ? tot[g2 * 64 + dk] : 0.f;
#pragma unroll
    for (int j = 0; j < 16; ++j) cum[(16 * tg + j) * 65 + dk] = vals[j] + pre;
    __syncthreads();
}
__device__ __forceinline__ void gla_local_pair(int pair, const Args& a, LAS unsigned char* lds0, int tid, int wave, int lane) {
    unsigned char* ws = a.ws; const bf16* PROJ = (const bf16*)(ws + WS_PROJ);
    const int half = tid >> 8, th = tid & 255, wv = wave & 3, item = 2 * pair + half;
    LAS unsigned char* lds = lds0 + half * GL2_STRIDE;
    const int b = item >> 9, h = (item >> 7) & 3, c = item & 127, fr = lane & 15, fq = lane >> 4;
    LAS float* cum = (LAS float*)(lds + GL_CUM); LAS float* tot = (LAS float*)(lds + GL_TOT); LAS bf16* KT = (LAS bf16*)(lds + GL_KT); LAS bf16* VT = (LAS bf16*)(lds + GL_VT);
    gla_cum2(cum, tot, (LAS float*)(lds + 47360), (const float*)(ws + WS_SMALL), a.in[9], a.in[10], b, h, c, th);
#pragma unroll
    for (int it = 0; it < 2; ++it) { const int id = th + 256 * it, s = id >> 3, u = id & 7; const size_t row = (size_t)b * T + 64 * c + s; const bf16x8 kr = *(const bf16x8*)(PROJ + row * PLD + PC_KG + h * 64 + 8 * u);
        const int pos = (s & 32) + perm32k(s & 31);
#pragma unroll
        for (int e = 0; e < 8; ++e) { const int dk = 8 * u + e; KT[dk * 72 + pos] = f2bf(bf2f(kr[e]) * __expf(cum[63 * 65 + dk] - cum[s * 65 + dk])); } }
#pragma unroll
    for (int it = 0; it < 4; ++it) { const int id = th + 256 * it, s = id >> 4, u = id & 15; const size_t row = (size_t)b * T + 64 * c + s;
        const bf16x8 vr = *(const bf16x8*)(PROJ + row * PLD + PC_VG + h * 128 + 8 * u); const int pos = (s & 32) + perm32k(s & 31);
#pragma unroll
        for (int e = 0; e < 8; ++e) VT[(8 * u + e) * 72 + pos] = (bf16)vr[e]; }
    if (th < 64) ((float*)(ws + WS_DEC))[(size_t)item * 64 + th] = __expf(cum[63 * 65 + th]);
    __syncthreads();
    bf16* LS = (bf16*)((unsigned char*)a.out + DO_L);
#pragma unroll
    for (int q2 = 0; q2 < 2; ++q2) { const int dvt = 2 * wv + q2;
#pragma unroll
      for (int dkt = 0; dkt < 4; ++dkt) { f32x4 acc = {0.f, 0.f, 0.f, 0.f};
#pragma unroll
        for (int ks = 0; ks < 2; ++ks) { const bf16x8 av = *(const LAS bf16x8*)(VT + (16 * dvt + fr) * 72 + 32 * ks + 8 * fq); const bf16x8 bv = *(const LAS bf16x8*)(KT + (16 * dkt + fr) * 72 + 32 * ks + 8 * fq); acc = MFMA16(av, bv, acc); }
#pragma unroll
        for (int i = 0; i < 4; ++i) { const float nb = __shfl_xor(acc[i], 1); if (!(fr & 1)) *(unsigned*)(LS + ((size_t)item * 128 + 16 * dvt + 4 * fq + i) * 64 + 16 * dkt + fr) = pk2(acc[i], nb); } } }
    __syncthreads();
}
__device__ __forceinline__ void gla_out_pair(int pair, const Args& a, LAS unsigned char* lds0, int tid, int wave, int lane) {
    unsigned char* ws = a.ws; const bf16* PROJ = (const bf16*)(ws + WS_PROJ);
    const int half = tid >> 8, th = tid & 255, tt = wave & 3, item = 2 * pair + half;
    LAS unsigned char* lds = lds0 + half * GL2_STRIDE;
    const int b = item >> 9, h = (item >> 7) & 3, c = item & 127, fr = lane & 15, fq = lane >> 4;
    LAS bf16* VT = (LAS bf16*)(lds + GL_VT); LAS float* cum = (LAS float*)(lds + GL_CUM); LAS float* tot = (LAS float*)(lds + GL_TOT);
    const bf16* LSp = (const bf16*)((const unsigned char*)a.out + DO_S); bf16x8 sfr[8][2];
#pragma unroll
    for (int j = 0; j < 8; ++j)
#pragma unroll
        for (int ks = 0; ks < 2; ++ks) sfr[j][ks] = *(const bf16x8*)(LSp + ((size_t)item * 128 + 16 * j + fr) * 64 + 32 * ks + 8 * fq);
    gla_cum2(cum, tot, (LAS float*)(lds + 47360), (const float*)(ws + WS_SMALL), a.in[9], a.in[10], b, h, c, th);
#pragma unroll
    for (int it = 0; it < 4; ++it) { const int id = th + 256 * it, s = id >> 4, u = id & 15; const size_t row = (size_t)b * T + 64 * c + s;
        const bf16x8 vr = *(const bf16x8*)(PROJ + row * PLD + PC_VG + h * 128 + 8 * u); const int pos = (s & 32) + perm32k(s & 31);
#pragma unroll
        for (int e = 0; e < 8; ++e) VT[(8 * u + e) * 72 + pos] = (bf16)vr[e]; }
    LAS bf16* KE = (LAS bf16*)(lds + GL_KT);
    { const int s = th >> 2, qd = th & 3; const bf16* kp = PROJ + ((size_t)b * T + 64 * c + s) * PLD + PC_KG + h * 64 + 16 * qd; const bf16x8 r0 = *(const bf16x8*)kp, r1 = *(const bf16x8*)(kp + 8);
      float f[16];
#pragma unroll
      for (int e = 0; e < 8; ++e) { f[e] = bf2f(r0[e]) * __expf(-cum[s * 65 + 16 * qd + e]); f[8 + e] = bf2f(r1[e]) * __expf(-cum[s * 65 + 16 * qd + 8 + e]); }
      *(LAS u32x4*)(KE + s * 72 + 16 * qd) = (u32x4){pk2(f[0], f[1]), pk2(f[2], f[3]), pk2(f[4], f[5]), pk2(f[6], f[7])};
      *(LAS u32x4*)(KE + s * 72 + 16 * qd + 8) = (u32x4){pk2(f[8], f[9]), pk2(f[10], f[11]), pk2(f[12], f[13]), pk2(f[14], f[15])}; }
    __syncthreads();
    const int tokq = 16 * tt + fr; const size_t rowq = (size_t)b * T + 64 * c + tokq;
    bf16x8 qf[2];
#pragma unroll
    for (int ks = 0; ks < 2; ++ks) { const bf16x8 raw = *(const bf16x8*)(PROJ + rowq * PLD + PC_QG + h * 64 + 32 * ks + 8 * fq);
#pragma unroll
        for (int e = 0; e < 8; ++e) qf[ks][e] = (short)f2bf(bf2f(raw[e]) * __expf(cum[tokq * 65 + 32 * ks + 8 * fq + e])); }
    f32x4 at[4];
#pragma unroll
    for (int st = 0; st < 4; ++st) { at[st] = (f32x4){0.f, 0.f, 0.f, 0.f};
        if (st <= tt) { const int s = 16 * st + fr; bf16x8 kf[2];
#pragma unroll
            for (int ks = 0; ks < 2; ++ks) kf[ks] = *(const LAS bf16x8*)(KE + s * 72 + 32 * ks + 8 * fq);
            at[st] = MFMA16(kf[0], qf[0], at[st]); at[st] = MFMA16(kf[1], qf[1], at[st]);
            if (st == tt) {
#pragma unroll
                for (int i = 0; i < 4; ++i) if (4 * fq + i > fr) at[st][i] = 0.f; } } }
    bf16x8 pf[2];
#pragma unroll
    for (int k2 = 0; k2 < 2; ++k2) { const u32x4 w = {pk2(at[2 * k2][0], at[2 * k2][1]), pk2(at[2 * k2][2], at[2 * k2][3]), pk2(at[2 * k2 + 1][0], at[2 * k2 + 1][1]), pk2(at[2 * k2 + 1][2], at[2 * k2 + 1][3])}; pf[k2] = __builtin_bit_cast(bf16x8, w); }
    f32x4 o[8]; float ssq = 0.f;
#pragma unroll
    for (int j = 0; j < 8; ++j) { const int dv0 = 16 * j; f32x4 acc = {0.f, 0.f, 0.f, 0.f};
#pragma unroll
        for (int ks = 0; ks < 2; ++ks) acc = MFMA16(sfr[j][ks], qf[ks], acc);
#pragma unroll
        for (int k2 = 0; k2 < 2; ++k2) { const bf16x8 vf = *(const LAS bf16x8*)(VT + (dv0 + fr) * 72 + 32 * k2 + 8 * fq); acc = MFMA16(vf, pf[k2], acc); }
        o[j] = acc; ssq += (acc[0] * acc[0] + acc[1] * acc[1]) + (acc[2] * acc[2] + acc[3] * acc[3]); }
    ssq += __shfl_xor(ssq, 16); ssq += __shfl_xor(ssq, 32);
    const float rstd = rsqrtf(ssq * (1.f / 128.f) + EPS);
#pragma unroll
    for (int j = 0; j < 8; ++j) { const int dvb = 16 * j + 4 * fq; const f32x4 gn = *(const f32x4*)(a.in[11] + dvb); const bf16* rp = PROJ + rowq * PLD + PC_RG + h * 128 + dvb; bf16* op = (bf16*)((unsigned char*)a.out + DO_OB) + rowq * 512 + h * 128 + dvb;
        const u32x2 rw = *(const u32x2*)rp; const float r0 = bflo(rw.x), r1 = bfhi(rw.x), r2 = bflo(rw.y), r3 = bfhi(rw.y);
        u32x2 w; w.x = pk2(o[j][0] * rstd * gn[0] * siluf_(r0), o[j][1] * rstd * gn[1] * siluf_(r1)); w.y = pk2(o[j][2] * rstd * gn[2] * siluf_(r2), o[j][3] * rstd * gn[3] * siluf_(r3));
        *(u32x2*)op = w; }
    __syncthreads();
}

__device__ __forceinline__ void gla_scan(unsigned char* ws, unsigned char* dout, LAS unsigned char* lds, int tid) {
    LAS float* sx = (LAS float*)lds;
    const int seg = tid >> 7, el = tid & 127;
    for (int e0 = blockIdx.x * 128; e0 < 8 * 128 * 32; e0 += gridDim.x * 128) { const int e = e0 + el;
        const int bh = e >> 12, dv = (e >> 5) & 127, dkp = e & 31;
        const size_t eo = (((size_t)bh * 128 * 128 + dv) * 64) / 2 + dkp; const unsigned* p = (const unsigned*)(dout + DO_L) + eo + (size_t)(32 * seg) * 4096; unsigned* ps = (unsigned*)(dout + DO_S) + eo + (size_t)(32 * seg) * 4096;
        const float* dp = (const float*)(ws + WS_DEC) + (size_t)bh * 128 * 64 + 2 * dkp + (32 * seg) * 64;
        float r0 = 0.f, r1 = 0.f, D0 = 1.f, D1 = 1.f;
#pragma unroll 16
        for (int c = 0; c < 32; ++c) { const unsigned w = p[(size_t)c * 4096]; const float d0 = dp[c * 64], d1 = dp[c * 64 + 1]; r0 = d0 * r0 + bflo(w); r1 = d1 * r1 + bfhi(w); D0 *= d0; D1 *= d1; }
        *(LAS f32x4*)(sx + (seg * 128 + el) * 4) = (f32x4){r0, r1, D0, D1};
        __syncthreads();
        r0 = 0.f; r1 = 0.f;
        for (int k = 0; k < seg; ++k) { const f32x4 v = *(const LAS f32x4*)(sx + (k * 128 + el) * 4); r0 = v[2] * r0 + v[0]; r1 = v[3] * r1 + v[1]; }
#pragma unroll 16
        for (int c = 0; c < 32; ++c) { const unsigned w = p[(size_t)c * 4096]; const float d0 = dp[c * 64], d1 = dp[c * 64 + 1]; ps[(size_t)c * 4096] = pk2(r0, r1); r0 = d0 * r0 + bflo(w); r1 = d1 * r1 + bfhi(w); }
        __syncthreads();
    }
}
constexpr int NT_TILE = 16384, NT_V = 8192, NT_TPS = 3, NT_R = 2 * NT_TPS, NS_WAVE = NT_R * NT_TILE, NS_WSZ = 2176, NS_UX = NS_WAVE + 8 * NS_WSZ, NS_JL = NS_UX + 128;
template <bool LOADV, class DescF, class CompF>
__device__ __forceinline__ void tile_loop(int n, DescF desc, CompF comp, LAS unsigned char* tb, int tid) {
    if (n <= 0) return;
#define NT_BAR() asm volatile("s_waitcnt lgkmcnt(0)\n\ts_barrier" ::: "memory")
    const int row = tid >> 3, unit = tid & 7, ns = (n + NT_TPS - 1) / NT_TPS;
    u32x4 kr[NT_TPS], vr[NT_TPS];
#define NT_GL(j) do { _Pragma("unroll") for (int u_ = 0; u_ < NT_TPS; ++u_) { int i_ = NT_TPS * (j) + u_; i_ = i_ < n ? i_ : n - 1; const bf16 *Kg_, *Vg_; int kp_, vp_; desc(i_, Kg_, kp_, Vg_, vp_); \
        kr[u_] = *(const u32x4*)(Kg_ + (size_t)row * kp_ + unit * 8); if (LOADV) vr[u_] = *(const u32x4*)(Vg_ + (size_t)row * vp_ + unit * 8); else vr[u_] = (u32x4){0u, 0u, 0u, 0u}; } } while (0)
#define NT_LS(half) do { _Pragma("unroll") for (int u_ = 0; u_ < NT_TPS; ++u_) { LAS unsigned char* p_ = tb + ((half) * NT_TPS + u_) * NT_TILE + row * 128 + ((unit ^ (row & 7)) * 16); \
        *(LAS u32x4*)p_ = kr[u_]; if (LOADV) *(LAS u32x4*)(p_ + NT_V) = vr[u_]; } } while (0)
    NT_GL(0); NT_LS(0);
    NT_BAR();
    for (int j = 0; j < ns; ++j) {
        if (j + 1 < ns) NT_GL(j + 1);
#pragma unroll
        for (int u = 0; u < NT_TPS; ++u) { const int i = NT_TPS * j + u; if (i < n) comp(i, tb + ((j & 1) * NT_TPS + u) * NT_TILE); }
        if (j + 1 < ns) NT_LS((j + 1) & 1);
        NT_BAR();
    }
#undef NT_GL
#undef NT_BAR
#undef NT_LS
}
__device__ __forceinline__ void lds_scores(f32x4 (&s)[4], const LAS unsigned char* buf, const bf16x8 (&q)[2], int fr, int fq, float cinit = 0.f) {
    const f32x4 c4 = {cinit, cinit, cinit, cinit};
#pragma unroll
    for (int h2 = 0; h2 < 2; ++h2) { bf16x8 kf[2][2];
#pragma unroll
        for (int t2 = 0; t2 < 2; ++t2) { const LAS unsigned char* kp = buf + (16 * (2 * h2 + t2) + fr) * 128; kf[t2][0] = *(const LAS bf16x8*)(kp + ((fq ^ (fr & 7)) * 16)); kf[t2][1] = *(const LAS bf16x8*)(kp + (((fq + 4) ^ (fr & 7)) * 16)); }
        asm volatile("" ::: "memory");
        __builtin_amdgcn_s_setprio(1);
#pragma unroll
        for (int t2 = 0; t2 < 2; ++t2) { s[2 * h2 + t2] = MFMA16(kf[t2][0], q[0], c4); s[2 * h2 + t2] = MFMA16(kf[t2][1], q[1], s[2 * h2 + t2]); }
        __builtin_amdgcn_s_setprio(0); }
}
__device__ __forceinline__ void lds_pv(f32x4 (&O)[4], const LAS unsigned char* buf, const f32x4 (&p)[4], int fr, int fq) {
    bf16x8 pf[2];
#pragma unroll
    for (int k2 = 0; k2 < 2; ++k2) { const u32x4 w = {pk2(p[2 * k2][0], p[2 * k2][1]), pk2(p[2 * k2][2], p[2 * k2][3]), pk2(p[2 * k2 + 1][0], p[2 * k2 + 1][1]), pk2(p[2 * k2 + 1][2], p[2 * k2 + 1][3])}; pf[k2] = __builtin_bit_cast(bf16x8, w); }
#pragma unroll
    for (int h2 = 0; h2 < 2; ++h2) { bf16x8 vf[2][2];
#pragma unroll
        for (int d2 = 0; d2 < 2; ++d2) { const LAS unsigned char* vp = buf + NT_V + (16 * (2 * h2 + d2) + fr) * 128; vf[d2][0] = *(const LAS bf16x8*)(vp + ((fq ^ (fr & 7)) * 16)); vf[d2][1] = *(const LAS bf16x8*)(vp + (((fq + 4) ^ (fr & 7)) * 16)); }
        asm volatile("" ::: "memory");
        __builtin_amdgcn_s_setprio(1);
#pragma unroll
        for (int d2 = 0; d2 < 2; ++d2) { O[2 * h2 + d2] = MFMA16(vf[d2][0], pf[0], O[2 * h2 + d2]); O[2 * h2 + d2] = MFMA16(vf[d2][1], pf[1], O[2 * h2 + d2]); }
        __builtin_amdgcn_s_setprio(0); }
}
template <int MODE, class MaskF>
__device__ __forceinline__ void attn_tile(const LAS unsigned char* buf, const bf16x8 (&q)[2], float& m, bool& st, float& l, f32x4 (&O)[4], bool rowsel, MaskF mask, int fr, int fq) {
    f32x4 s[4]; lds_scores(s, buf, q, fr, fq, (MODE == 1 && !rowsel) ? -INFINITY : -m);
    if (MODE == 2) {
#pragma unroll
        for (int t = 0; t < 4; ++t)
#pragma unroll
            for (int i = 0; i < 4; ++i) s[t][i] = mask(16 * t + 4 * fq + i) ? s[t][i] : -INFINITY; }
    float mx = max16f_(s);
    if (__builtin_amdgcn_ballot_w64(mx > 8.f || (!st && mx > -INFINITY)) != 0ull) {
        mx = fmaxf(mx, __shfl_xor(mx, 16)); mx = fmaxf(mx, __shfl_xor(mx, 32));
        const float dl = st ? fmaxf(mx, 0.f) : (mx > -INFINITY ? mx : 0.f), alpha = st ? __builtin_amdgcn_exp2f(-dl) : 1.f; st = st || (mx > -INFINITY); m += dl; l *= alpha;
#pragma unroll
        for (int dt = 0; dt < 4; ++dt) O[dt] = O[dt] * alpha;
#pragma unroll
        for (int t = 0; t < 4; ++t)
#pragma unroll
            for (int i = 0; i < 4; ++i) s[t][i] -= dl; }
    float rs = 0.f;
#pragma unroll
    for (int t = 0; t < 4; ++t)
#pragma unroll
        for (int i = 0; i < 4; ++i) { const float p = __builtin_amdgcn_exp2f(s[t][i]); s[t][i] = p; rs += p; }
    l += rs;
    lds_pv(O, buf, s, fr, fq);
}
__device__ __forceinline__ void nsa_block_item(int idx, unsigned char* ws, bf16* OA, LAS unsigned char* lds, int tid, int wave, int lane) {
    const bf16* PROJ = (const bf16*)(ws + WS_PROJ); const bf16* KROT = (const bf16*)(ws + WS_KROT);
    const int fr = lane & 15, fq = lane >> 4;
    const int ti = 255 - (idx >> 2), bg = idx & 3, b = bg >> 1, g = bg & 1, tb0 = 32 * ti, t0 = tb0 + 4 * wave;
    const int tokj = fr >> 2, hh = fr & 3, trow = t0 + tokj; const size_t grow = (size_t)b * T + trow;
    LAS unsigned char* wl = lds + NS_WAVE + wave * NS_WSZ;
    LAS float* imp = (LAS float*)wl; LAS unsigned* selw = (LAS unsigned*)(wl + 2112);
    LAS unsigned* ux = (LAS unsigned*)(lds + NS_UX); LAS unsigned char* jl = lds + NS_JL;
    bf16x8 qraw[2], qrot[2];
#pragma unroll
    for (int ks = 0; ks < 2; ++ks) { qraw[ks] = *(const bf16x8*)(PROJ + grow * PLD + PC_QN + (g * 4 + hh) * 64 + 32 * ks + 8 * fq);
        qrot[ks] = qraw[ks]; }
    if (fq < 2) qrot[0] = *(const bf16x8*)((const bf16*)(ws + WS_QROT) + grow * 128 + (g * 4 + hh) * 16 + 8 * fq);
    for (int i = lane; i < 528; i += 64) imp[i] = 0.f;
    f32x4 Ot[4];
#pragma unroll
    for (int dt = 0; dt < 4; ++dt) Ot[dt] = (f32x4){0.f, 0.f, 0.f, 0.f};
    const float* gp = (const float*)(ws + WS_SMALL) + grow * 64 + (g * 4 + hh) * 3;
    {
        const int nvr = trow >= 31 ? ((trow - 31) >> 4) + 1 : 0; const int nv0 = t0 >= 31 ? ((t0 - 31) >> 4) + 1 : 0; const int tl = tb0 + 31; const int nvm = tl >= 31 ? ((tl - 31) >> 4) + 1 : 0; const int ntile = (nvm + 63) >> 6;
        const bf16* Kc = (const bf16*)(ws + WS_KCMP) + (size_t)bg * 512 * 64; const bf16* Vc = (const bf16*)(ws + WS_VCMPT) + (size_t)bg * 64 * 512;
        auto desc = [&](int i, const bf16*& Kg, int& kp, const bf16*& Vg, int& vp) { Kg = Kc + (size_t)(64 * i) * 64; kp = 64; Vg = Vc + 64 * i; vp = 512; };
        float m = NEGB, l = 0.f;
        tile_loop<false>(ntile, desc, [&](int kt, const LAS unsigned char* buf) {
            f32x4 s[4]; lds_scores(s, buf, qraw, fr, fq);
            if (64 * kt + 64 > nv0) {
#pragma unroll
                for (int t = 0; t < 4; ++t)
#pragma unroll
                    for (int i = 0; i < 4; ++i) s[t][i] = (64 * kt + 16 * t + 4 * fq + i) < nvr ? s[t][i] : -INFINITY; }
            float mx = max16f_(s);
            if (__builtin_amdgcn_ballot_w64(mx > m + 8.f) != 0ull) { mx = fmaxf(mx, __shfl_xor(mx, 16)); mx = fmaxf(mx, __shfl_xor(mx, 32)); const float mn = fmaxf(m, mx); l *= __builtin_amdgcn_exp2f(m - mn); m = mn; }
            float rs = 0.f;
#pragma unroll
            for (int t = 0; t < 4; ++t)
#pragma unroll
                for (int i = 0; i < 4; ++i) rs += __builtin_amdgcn_exp2f(s[t][i] - m);
            l += rs; }, lds, tid);
        l += __shfl_xor(l, 16); l += __shfl_xor(l, 32);
        const float invl = l > 0.f ? 1.f / l : 0.f;
        f32x4 Oc[4];
#pragma unroll
        for (int dt = 0; dt < 4; ++dt) Oc[dt] = (f32x4){0.f, 0.f, 0.f, 0.f};
        tile_loop<true>(ntile, desc, [&](int kt, const LAS unsigned char* buf) {
            f32x4 s[4]; lds_scores(s, buf, qraw, fr, fq);
#pragma unroll
            for (int t = 0; t < 4; ++t)
#pragma unroll
                for (int i = 0; i < 4; ++i) { const bool okk = (64 * kt + 16 * t + 4 * fq + i) < nvr; s[t][i] = okk ? __builtin_amdgcn_exp2f(s[t][i] - m) * invl : 0.f; }
            lds_pv(Oc, buf, s, fr, fq);
#pragma unroll
            for (int t = 0; t < 4; ++t) { float s3 = (s[t][0] + s[t][1]) + (s[t][2] + s[t][3]), p3 = s[t][3];
                s3 += __shfl_xor(s3, 1); s3 += __shfl_xor(s3, 2); p3 += __shfl_xor(p3, 1); p3 += __shfl_xor(p3, 2);
                const int q = 16 * kt + 4 * t + fq;
                if (hh == 0) imp[tokj * 132 + q] += s3;
                asm volatile("s_waitcnt lgkmcnt(0)" ::: "memory");
                if (hh == 0) imp[tokj * 132 + q + 1] += p3;
                asm volatile("s_waitcnt lgkmcnt(0)" ::: "memory"); } }, lds, tid);
        const float gc = sigmoidf_(gp[0]);
#pragma unroll
        for (int dt = 0; dt < 4; ++dt) Ot[dt] = Oc[dt] * gc;
    }
    const int cur = tb0 >> 6;
    { const int tok = lane >> 4, sub = lane & 15; unsigned key[8]; bool cand[8];
#define ROW_SUM(x) do { x += __builtin_amdgcn_update_dpp(0, x, 0xB1, 0xF, 0xF, true); x += __builtin_amdgcn_update_dpp(0, x, 0x4E, 0xF, 0xF, true); \
        x += __builtin_amdgcn_update_dpp(0, x, 0x141, 0xF, 0xF, true); x += __builtin_amdgcn_update_dpp(0, x, 0x140, 0xF, 0xF, true); } while (0)
#pragma unroll
        for (int e = 0; e < 8; ++e) { const int j = 8 * sub + e; cand[e] = (j >= 1 && j <= cur - 2); key[e] = cand[e] ? __float_as_uint(imp[tok * 132 + j]) : 0u; }
        unsigned selb = 0;
        if (cur - 2 > 13) {
            unsigned tau = 0u;
            for (int bit = 30; bit >= 0; --bit) { const unsigned t = tau | (1u << bit); int c = 0;
#pragma unroll
                for (int e = 0; e < 8; ++e) c += (key[e] >= t) ? 1 : 0;
                ROW_SUM(c); tau = (c >= 13) ? t : tau; }
            int cg = 0, tc = 0;
#pragma unroll
            for (int e = 0; e < 8; ++e) { cg += (cand[e] && key[e] > tau) ? 1 : 0; tc += (cand[e] && key[e] == tau) ? 1 : 0; }
            ROW_SUM(cg); const int need = 13 - cg;
            int inc = tc; inc += __builtin_amdgcn_update_dpp(0, inc, 0x111, 0xF, 0xF, true); inc += __builtin_amdgcn_update_dpp(0, inc, 0x112, 0xF, 0xF, true);
            inc += __builtin_amdgcn_update_dpp(0, inc, 0x114, 0xF, 0xF, true); inc += __builtin_amdgcn_update_dpp(0, inc, 0x118, 0xF, 0xF, true);
            int before = inc - tc;
#pragma unroll
            for (int e = 0; e < 8; ++e) { const bool tie = cand[e] && key[e] == tau; const bool sl = cand[e] && (key[e] > tau || (tie && before < need)); before += tie ? 1 : 0; selb |= sl ? (1u << e) : 0u; }
        } else {
#pragma unroll
            for (int e = 0; e < 8; ++e) selb |= cand[e] ? (1u << e) : 0u; }
#undef ROW_SUM
        unsigned bits = 0;
#pragma unroll
        for (int e = 0; e < 8; ++e) { const int j = 8 * sub + e; const bool sel = (j <= cur) && (j == 0 || j >= cur - 1 || ((selb >> e) & 1u)); bits |= sel ? (1u << e) : 0u; }
        ((LAS unsigned char*)selw)[tok * 16 + sub] = (unsigned char)bits; }
    asm volatile("s_waitcnt lgkmcnt(0)" ::: "memory");
    unsigned sw[4], un[4];
#pragma unroll
    for (int w = 0; w < 4; ++w) { sw[w] = selw[tokj * 4 + w]; un[w] = __builtin_amdgcn_readfirstlane(selw[w] | selw[4 + w] | selw[8 + w] | selw[12 + w]); }
    if (lane == 0) { ux[wave * 4 + 0] = un[0]; ux[wave * 4 + 1] = un[1]; ux[wave * 4 + 2] = un[2]; ux[wave * 4 + 3] = un[3]; }
    __syncthreads();
    unsigned U[4];
#pragma unroll
    for (int w = 0; w < 4; ++w) { unsigned u = 0;
#pragma unroll
        for (int v2 = 0; v2 < 8; ++v2) u |= ux[v2 * 4 + w];
        U[w] = __builtin_amdgcn_readfirstlane(u); }
    const int nsl = __builtin_popcount(U[0]) + __builtin_popcount(U[1]) + __builtin_popcount(U[2]) + __builtin_popcount(U[3]);
    if (tid < 128) { const int w = tid >> 5, bit = tid & 31; const unsigned uw = w == 0 ? U[0] : w == 1 ? U[1] : w == 2 ? U[2] : U[3];
        if ((uw >> bit) & 1u) { int pos = __builtin_popcount(uw & ((1u << bit) - 1u)); if (w > 0) pos += __builtin_popcount(U[0]); if (w > 1) pos += __builtin_popcount(U[1]); if (w > 2) pos += __builtin_popcount(U[2]); jl[pos] = (unsigned char)tid; } }
    __syncthreads();
    {
        const bf16* Ks = KROT + ((size_t)g * M + (size_t)b * T) * 64; const bf16* Vs = (const bf16*)(ws + WS_VTS) + (size_t)bg * 128 * 4096;
        float m = 0.f, l = 0.f; bool st = false; f32x4 Os[4];
#pragma unroll
        for (int dt = 0; dt < 4; ++dt) Os[dt] = (f32x4){0.f, 0.f, 0.f, 0.f};
        tile_loop<true>(nsl, [&](int i, const bf16*& Kg, int& kp, const bf16*& Vg, int& vp) { const int j = jl[i]; Kg = Ks + (size_t)(64 * j) * 64; kp = 64; Vg = Vs + (size_t)j * 4096; vp = 64; },
            [&](int i, const LAS unsigned char* buf) { const int j = __builtin_amdgcn_readfirstlane((int)jl[i]); const int w = j >> 5, bit = j & 31;
                const unsigned uw = w == 0 ? un[0] : w == 1 ? un[1] : w == 2 ? un[2] : un[3];
                if (!((uw >> bit) & 1u)) return;
                const unsigned swv = w == 0 ? sw[0] : w == 1 ? sw[1] : w == 2 ? sw[2] : sw[3]; const bool rowsel = (swv >> bit) & 1u;
                if (j < cur) attn_tile<1>(buf, qrot, m, st, l, Os, rowsel, [&](int) { return true; }, fr, fq);
                else attn_tile<2>(buf, qrot, m, st, l, Os, rowsel, [&](int kk) { return rowsel && (64 * j + kk <= trow); }, fr, fq); }, lds, tid);
        l += __shfl_xor(l, 16); l += __shfl_xor(l, 32);
        const float gs = sigmoidf_(gp[1]) * (l > 0.f ? 1.f / l : 0.f);
#pragma unroll
        for (int dt = 0; dt < 4; ++dt) Ot[dt] += Os[dt] * gs;
    }
    {
        const bf16* Kw = KROT + ((size_t)(2 + g) * M + (size_t)b * T) * 64; const bf16* Vw = (const bf16*)(ws + WS_VTW) + (size_t)bg * 128 * 4096;
        float m = 0.f, l = 0.f; bool st = false; f32x4 Ow[4];
#pragma unroll
        for (int dt = 0; dt < 4; ++dt) Ow[dt] = (f32x4){0.f, 0.f, 0.f, 0.f};
        const int jlo = (tb0 > 511 ? tb0 - 511 : 0) >> 6, jhi = (tb0 + 31) >> 6;
        tile_loop<true>(jhi - jlo + 1, [&](int i, const bf16*& Kg, int& kp, const bf16*& Vg, int& vp) { const int j = jlo + i; Kg = Kw + (size_t)(64 * j) * 64; kp = 64; Vg = Vw + (size_t)j * 4096; vp = 64; },
            [&](int i, const LAS unsigned char* buf) { const int j = jlo + i;
                if (64 * j + 63 + 511 < t0 || 64 * j > t0 + 3) return;
                if (64 * j + 511 >= t0 + 3 && 64 * j + 63 <= t0) attn_tile<0>(buf, qrot, m, st, l, Ow, true, [&](int) { return true; }, fr, fq);
                else attn_tile<2>(buf, qrot, m, st, l, Ow, true, [&](int kk) { const int key = 64 * j + kk; return key <= trow && key + 511 >= trow; }, fr, fq); }, lds, tid);
        l += __shfl_xor(l, 16); l += __shfl_xor(l, 32);
        const float gw = sigmoidf_(gp[2]) * (l > 0.f ? 1.f / l : 0.f);
#pragma unroll
        for (int dt = 0; dt < 4; ++dt) Ot[dt] += Ow[dt] * gw;
    }
#pragma unroll
    for (int dt = 0; dt < 4; ++dt) { u32x2 w; w.x = pk2(Ot[dt][0], Ot[dt][1]); w.y = pk2(Ot[dt][2], Ot[dt][3]); *(u32x2*)(OA + grow * 512 + (g * 4 + hh) * 64 + 16 * dt + 4 * fq) = w; }
    __syncthreads();
}

#define XB_TMO      128
#define XB_XCNT(j)  (256  + 64 * (j))
#define XB_XSUB(j)  (1280 + 64 * (j))
#define XB_XGEN(j)  (2304 + 64 * (j))
#define XB_TOP      3328
#define XB_TOPGEN   3392
#define XCD_BAR_WORDS 3456
#define XB_SPIN_CAP (1u << 18)

__device__ __forceinline__ unsigned xb_ld(unsigned* p)              { return __hip_atomic_load(p, __ATOMIC_RELAXED, __HIP_MEMORY_SCOPE_AGENT); }
__device__ __forceinline__ unsigned xb_add(unsigned* p, unsigned v) { return __hip_atomic_fetch_add(p, v, __ATOMIC_RELAXED, __HIP_MEMORY_SCOPE_AGENT); }
__device__ __forceinline__ unsigned xb_xcc_id() { return (unsigned)__builtin_amdgcn_s_getreg((3 << 11) | 20) & 0xFu; }
#define XB_SPIN(cond, bar) do { unsigned _sp = 0; while (cond) { __builtin_amdgcn_s_sleep(1); \
    if ((++_sp & 255u) == 0u) { if (xb_ld(&(bar)[XB_TMO])) break; if (_sp > XB_SPIN_CAP) { atomicAdd(&(bar)[XB_TMO], 1u); break; } } } } while (0)

struct XcdBarrier {
    unsigned* bar; unsigned x;
    volatile LAS unsigned* st;
};

__device__ __forceinline__ XcdBarrier xcd_barrier_post(unsigned* bar, volatile LAS unsigned* st) {
    XcdBarrier b; b.bar = bar; b.x = xb_xcc_id(); b.st = st;
    if (threadIdx.x == 0) (void)xb_add(&bar[XB_XCNT(b.x)], 1u);
    return b;
}
__device__ __forceinline__ void xcd_barrier_complete(unsigned* bar, unsigned x, unsigned& nloc, unsigned& nx) {
    const unsigned G = gridDim.x * gridDim.y * gridDim.z;
    unsigned sum, cnt, mine, sp = 0u;
    for (;;) {
        sum = 0u; cnt = 0u; mine = 0u;
#pragma unroll
        for (unsigned j = 0; j < 16; ++j) { const unsigned c = xb_ld(&bar[XB_XCNT(j)]); sum += c; cnt += (c > 0u) ? 1u : 0u; mine = (j == x) ? c : mine; }
        if (sum == G) break;
        __builtin_amdgcn_s_sleep(1);
        if ((++sp & 255u) == 0u) { if (xb_ld(&bar[XB_TMO])) break; if (sp > XB_SPIN_CAP) { atomicAdd(&bar[XB_TMO], 1u); break; } }
    }
    nloc = mine > 0u ? mine : 1u; nx = cnt > 0u ? cnt : 1u;
}

__device__ __forceinline__ void xcd_barrier(const XcdBarrier& b) {
    asm volatile("s_waitcnt vmcnt(0)" ::: "memory");
    __syncthreads();
    if (threadIdx.x == 0) {
        unsigned* bar = b.bar;
        __builtin_amdgcn_s_waitcnt(0);
        unsigned nloc = b.st[0], nx = b.st[1];
        if (nloc == 0u) { xcd_barrier_complete(bar, b.x, nloc, nx); b.st[0] = nloc; b.st[1] = nx; }
        const unsigned old = xb_add(&bar[XB_XSUB(b.x)], 1u);
        const unsigned gen = old / nloc;
        if (old + 1u == (gen + 1u) * nloc) {
            __builtin_amdgcn_fence(__ATOMIC_RELEASE, "agent");
            asm volatile("s_waitcnt vmcnt(0)" ::: "memory");
            const unsigned og = xb_add(&bar[XB_TOP], 1u);
            const unsigned tg = og / nx;
            if (og + 1u == (tg + 1u) * nx) xb_add(&bar[XB_TOPGEN], 1u);
            else XB_SPIN(xb_ld(&bar[XB_TOPGEN]) == tg, bar);
            __builtin_amdgcn_fence(__ATOMIC_ACQUIRE, "agent");
            xb_add(&bar[XB_XGEN(b.x)], 1u);
            asm volatile("s_waitcnt vmcnt(0)" ::: "memory");
        } else {
            XB_SPIN(xb_ld(&bar[XB_XGEN(b.x)]) == gen, bar);
            __builtin_amdgcn_fence(__ATOMIC_ACQUIRE, "agent");
            asm volatile("s_waitcnt vmcnt(0)" ::: "memory");
        }
    }
    __syncthreads();
}

__global__ void __launch_bounds__(NTHR, 2) fwd_megakernel(Args a) {
    extern __shared__ __attribute__((aligned(16))) unsigned char lds_raw[];
    cg::grid_group grid = cg::this_grid();
    unsigned bar_k_ = 0;
#define GRID_SYNC() do { asm volatile("s_waitcnt vmcnt(0) lgkmcnt(0)" ::: "memory"); __syncthreads(); \
    if (threadIdx.x == 0) { unsigned* bw_ = (unsigned*)(a.ws + WS_CTL) + 16384; const unsigned G_ = gridDim.x, k1_ = bar_k_ + 1u; \
        __builtin_amdgcn_fence(__ATOMIC_RELEASE, "agent"); asm volatile("s_waitcnt vmcnt(0)" ::: "memory"); \
        if (G_ % 16u) { __hip_atomic_fetch_add(bw_, 1u, __ATOMIC_RELAXED, __HIP_MEMORY_SCOPE_AGENT); while (__hip_atomic_load(bw_, __ATOMIC_RELAXED, __HIP_MEMORY_SCOPE_AGENT) < k1_ * G_) __builtin_amdgcn_s_sleep(1); } \
        else { const unsigned grp_ = blockIdx.x >> 4; unsigned* gc_ = bw_ + 64u * (1u + grp_); unsigned* gr_ = bw_ + 64u * (33u + grp_); \
            if (__hip_atomic_fetch_add(gc_, 1u, __ATOMIC_RELAXED, __HIP_MEMORY_SCOPE_AGENT) == k1_ * 16u - 1u) { __hip_atomic_fetch_add(bw_, 1u, __ATOMIC_RELAXED, __HIP_MEMORY_SCOPE_AGENT); \
                while (__hip_atomic_load(bw_, __ATOMIC_RELAXED, __HIP_MEMORY_SCOPE_AGENT) < k1_ * (G_ >> 4)) __builtin_amdgcn_s_sleep(1); \
                __hip_atomic_store(gr_, k1_, __ATOMIC_RELAXED, __HIP_MEMORY_SCOPE_AGENT); } \
            else { while (__hip_atomic_load(gr_, __ATOMIC_RELAXED, __HIP_MEMORY_SCOPE_AGENT) < k1_) __builtin_amdgcn_s_sleep(1); } } \
        __builtin_amdgcn_fence(__ATOMIC_ACQUIRE, "agent"); asm volatile("s_waitcnt vmcnt(0)" ::: "memory"); } \
    ++bar_k_; __syncthreads(); } while (0)
    grid.sync();
    LAS unsigned char* lds = (LAS unsigned char*)lds_raw;
    unsigned char* ws = a.ws;
    const int tid = threadIdx.x, lane = tid & 63, wave = __builtin_amdgcn_readfirstlane(tid >> 6);
    const int G = gridDim.x, bx = blockIdx.x;
    bf16* PROJ = (bf16*)(ws + WS_PROJ);
    float* ROWSQ1 = (float*)(ws + WS_RSQ1); float* ROWSQ2 = (float*)(ws + WS_RSQ2);

    { LAS unsigned* z_ = (LAS unsigned*)(lds + 131072 + 64); if (tid < 2) z_[tid] = 0u; }
    __syncthreads();
    int vb = bx;
    { LAS unsigned* cw = (LAS unsigned*)(lds + 131072);
      if (tid == 0) { const unsigned x = (unsigned)__builtin_amdgcn_s_getreg((3 << 11) | 20) & 0xFu; const unsigned r = __hip_atomic_fetch_add((unsigned*)(ws + WS_CTL) + 64 + 64 * x, 1u, __ATOMIC_RELAXED, __HIP_MEMORY_SCOPE_AGENT);
          cw[0] = (x < 8u && r < (unsigned)(G / 8) && (G % 8) == 0) ? (r * 8u + x) : 0xffffffffu; }
      __syncthreads();
      const unsigned v = cw[0]; vb = (v == 0xffffffffu) ? -1 : (int)v; }
    bf16* OA = (bf16*)((unsigned char*)a.out + DO_OA); bf16* OB = (bf16*)((unsigned char*)a.out + DO_OB);
#ifndef REPEAT_P
#define REPEAT_P -1
#endif
#define PHASE_REP(k) for (int rep_ = 0; rep_ < ((REPEAT_P == (k)) ? 2 : 1); ++rep_)
    p0_prologue(a, lds, wave, lane);
    if (vb < 0) { if (tid == 0) __hip_atomic_fetch_add((unsigned*)(ws + WS_CTL) + 32, 1u, __ATOMIC_RELAXED, __HIP_MEMORY_SCOPE_AGENT); }
    GRID_SYNC();
    if (__hip_atomic_load((unsigned*)(ws + WS_CTL) + 32, __ATOMIC_RELAXED, __HIP_MEMORY_SCOPE_AGENT) != 0u) vb = bx;
    PHASE_REP(1) { pg8::Gemm g{(const bf16*)(ws + WS_XN), (const bf16*)(ws + WS_WIN), M, NIN, D, D}; pg8::StaticOrder S; S.init(M, NIN, G, vb);
      EpiProj E{PROJ, (float*)(ws + WS_SMALL), (bf16*)(ws + WS_CSRC)};
      pg8::gemm_phase<EpiProj, pg8::StaticOrder, true, true>(lds, g, S, E);
    GRID_SYNC(); }
    PHASE_REP(2) {
    { const int vv_ = vb >= 0 ? vb : bx; const int grp_ = (vv_ & 7) * (G / 32) + (vv_ >> 5), sub_ = (vv_ >> 3) & 3;
      if (G == 256) compress_item(grp_, sub_, ws, lds, wave, lane); else if (bx < 64) for (int q_ = 0; q_ < 4; ++q_) compress_item(bx, q_, ws, lds, wave, lane); }
    for (int it = bx; it < 512; it += G) gla_local_pair(it, a, lds, tid, wave, lane);
    for (int it = (G - 1 - bx) * NWAVES + wave; it < 256 * 2; it += G * NWAVES) p2a_item(it, ws, lds + wave * 18432, lane);
    for (int it = bx * NWAVES + wave; it < M / 8; it += G * NWAVES) rope_item(it, ws, lane);
    GRID_SYNC(); }
    PHASE_REP(3) {
    gla_scan(ws, (unsigned char*)a.out, lds, tid);
    __syncthreads();
    { const int vv_ = vb >= 0 ? vb : bx; const int xcc_ = vv_ & 7, q_ = ((xcc_ >> 2) * (G / 8) + (vv_ >> 3)), nq_ = 2 * (G / 8);
      for (int r_ = 0; r_ * nq_ < 256; ++r_) { const int o_ = (r_ & 1) ? (nq_ - 1 - q_) : q_; const int tr_ = r_ * nq_ + o_; if (tr_ >= 256) continue;
        const int idx = (tr_ << 2) | (xcc_ & 3);
        nsa_block_item(idx, ws, OA, lds, tid, wave, lane); } }
    GRID_SYNC(); }
    PHASE_REP(4) {
    for (int it = bx; it < 512; it += G) gla_out_pair(it, a, lds, tid, wave, lane);
    GRID_SYNC(); }
    PHASE_REP(5) {
    { pg8::Gemm g{OA, (const bf16*)(ws + WS_WUPA), 2 * M, 2 * D, 512, 512}; UpOrder S; S.so.init(M, D, G, vb);
      EpiUp2 E{PROJ, PROJ, PLD};
      pg8::gemm_phase<EpiUp2, UpOrder, true, true>(lds, g, S, E); }
    { pg8::StaticOrder S; S.init(M, D, G, vb); pg8::Unit u; S.next(0, u);
      asm volatile("s_waitcnt vmcnt(0) lgkmcnt(0)" ::: "memory"); __syncthreads();
      if (tid == 0) { __builtin_amdgcn_fence(__ATOMIC_RELEASE, "agent"); asm volatile("s_waitcnt vmcnt(0)" ::: "memory");
          unsigned* c_ = (unsigned*)(ws + WS_CTL) + 12288 + 64 * u.pm; __hip_atomic_fetch_add(c_, 1u, __ATOMIC_RELAXED, __HIP_MEMORY_SCOPE_AGENT);
          while (__hip_atomic_load(c_, __ATOMIC_RELAXED, __HIP_MEMORY_SCOPE_AGENT) < 4u) __builtin_amdgcn_s_sleep(1);
          __builtin_amdgcn_fence(__ATOMIC_ACQUIRE, "agent"); asm volatile("s_waitcnt vmcnt(0)" ::: "memory"); }
      __syncthreads(); } }
    PHASE_REP(6) {
    { pg8::Gemm g{PROJ, (const bf16*)(ws + WS_WOUT), M, D, D, PLD}; pg8::StaticOrder S; S.init(M, D, G, vb);
      EpiRes<true> E{a.in[0], a.out, (bf16*)(ws + WS_XB), ROWSQ1};
      pg8::gemm_phase<EpiRes<true>, pg8::StaticOrder, false, true>(lds, g, S, E); }
    GRID_SYNC(); }
    PHASE_REP(7) {
    { pg8::Gemm g{(const bf16*)(ws + WS_XB), (const bf16*)(ws + WS_WGU), M, NGU, D, D}; pg8::StaticOrder S; S.init(M, NGU, G, vb);
      EpiFfn E{(bf16*)(ws + WS_H), ROWSQ1};
      pg8::gemm_phase<EpiFfn, pg8::StaticOrder, true, true>(lds, g, S, E); }
    GRID_SYNC(); }
    { pg8::Gemm g{(const bf16*)(ws + WS_H), (const bf16*)(ws + WS_WDN), M, D, DFF, DFF}; pg8::StaticOrder S; S.init(M, D, G, vb);
      EpiFinal E{(const bf16*)(ws + WS_XB), a.out, ROWSQ2, (unsigned*)(ws + WS_CTL) + 8192, a.in[19]};
      pg8::gemm_phase<EpiFinal, pg8::StaticOrder, false, true>(lds, g, S, E); }
}

extern "C" void kernel_launch(void* const* d_in, const int* in_sizes, int n_in, void* d_out, int out_size, void* d_ws, size_t ws_size, hipStream_t stream) {
    static int grid = 0;
    if (grid == 0) {
        if (n_in != 20 || in_sizes[0] != M * D || out_size != M * D || ws_size < WS_END) { fprintf(stderr, "kernel_launch: unexpected shapes (n_in %d, in0 %d, out %d, ws %zu)\n", n_in, n_in > 0 ? in_sizes[0] : -1, out_size, ws_size); grid = -1; return; }
        int dev = 0, cus = 0, per_cu = 0;
        hipGetDevice(&dev); hipDeviceGetAttribute(&cus, hipDeviceAttributeMultiprocessorCount, dev);
        hipFuncSetAttribute((const void*)fwd_megakernel, hipFuncAttributeMaxDynamicSharedMemorySize, LDS_BYTES);
        hipOccupancyMaxActiveBlocksPerMultiprocessor(&per_cu, (const void*)fwd_megakernel, NTHR, LDS_BYTES);
        if (per_cu < 1) { fprintf(stderr, "kernel_launch: occupancy query says %d blocks per CU\n", per_cu); per_cu = 1; }
        (void)hipGetLastError();
        grid = cus * per_cu; if (grid > 256) grid = 256;
        if (grid != 256) { fprintf(stderr, "kernel_launch: this kernel needs exactly 256 co-resident workgroups (one 256x256 output tile per workgroup in the fused epilogues); the device offers %d; nothing launched\n", grid); grid = -1; return; }
    }
    if (grid < 0) return;
    (void)hipMemsetAsync((char*)d_ws + WS_CTL, 0, 98304, stream);
    Args a{};
    for (int i = 0; i < 20; ++i) a.in[i] = (const float*)d_in[i];
    a.out = (float*)d_out; a.ws = (unsigned char*)d_ws;
    void* args[] = {&a};
    hipError_t e = hipLaunchCooperativeKernel((const void*)fwd_megakernel, dim3(grid), dim3(NTHR), args, LDS_BYTES, stream);
    if (e != hipSuccess) fprintf(stderr, "cooperative launch failed: %s (grid %d)\n", hipGetErrorString(e), grid);
}
```
